# Optimizing an MI355X kernel written in HIP

```python
import jax, jax.numpy as jnp
from jax import lax
import numpy as np

D_MODEL = 1024
BATCH = 16
SEQ = 4096
DEPTH = 4

D_SGU = 1024
SGU_CHUNK = 128
SGU_GROUPS = 8
SGU_GROUP_DIM = D_SGU // SGU_GROUPS
D_RNN = 1024
RG_HEADS = 8
RG_HEAD_DIM = D_RNN // RG_HEADS
CONV_WIDTH = 4
RG_C = 8.0
IN_WIDTH = 2 * D_SGU + 2 * D_RNN + 2 * D_MODEL
IN_SPLITS = (D_SGU, 2 * D_SGU, 2 * D_SGU + D_RNN, 2 * D_SGU + 2 * D_RNN, 2 * D_SGU + 2 * D_RNN + D_MODEL)
N_EXPERTS = 64
TOP_K = 8
N_GROUPS = 8
TOPK_GROUPS = 4
D_EXPERT = 256
D_SHARED = 256
ROUTED_SCALE = 2.5
MOE_BLOCK = 128
DEEPNORM_ALPHA = (2 * DEPTH) ** 0.25
DEEPNORM_BETA = (8 * DEPTH) ** -0.25
LN_EPS = 1e-5

kernel_name = 'hybrid_sgu_rglru_moe_deepnorm_adaln'


def _layer_norm(x, g, b):
    xf = x.astype(jnp.float32)
    mu = jnp.mean(xf, axis=-1, keepdims=True)
    var = jnp.mean(jnp.square(xf - mu), axis=-1, keepdims=True)
    return ((xf - mu) * lax.rsqrt(var + LN_EPS)).astype(x.dtype) * g + b


def _chunk_spatial(v, w_s, b_s):
    B, S, C = v.shape
    vc = v.reshape(B, S // SGU_CHUNK, SGU_CHUNK, SGU_GROUPS, SGU_GROUP_DIM)
    w = w_s * jnp.tril(jnp.ones((SGU_CHUNK, SGU_CHUNK), w_s.dtype))
    out = jnp.einsum('gts,bnsgc->bntgc', w, vc) + b_s.T[:, :, None]
    return out.reshape(B, S, C)


def _causal_conv(x, w, b):
    S = x.shape[1]
    xp = jnp.pad(x, ((0, 0), (CONV_WIDTH - 1, 0), (0, 0)))
    return sum(xp[:, k:k + S] * w[k] for k in range(CONV_WIDTH)) + b


def _rg_lru(xb, wa, ba, wx, bx, lam):
    B, S, _ = xb.shape
    xh = xb.reshape(B, S, RG_HEADS, RG_HEAD_DIM)
    r = jax.nn.sigmoid(jnp.einsum('bshi,hij->bshj', xh, wa).reshape(B, S, D_RNN) + ba)
    i = jax.nn.sigmoid(jnp.einsum('bshi,hij->bshj', xh, wx).reshape(B, S, D_RNN) + bx)
    log_a = -RG_C * r.astype(jnp.float32) * jax.nn.softplus(-lam.astype(jnp.float32))
    a = jnp.exp(log_a)
    inp = jnp.sqrt(-jnp.expm1(2.0 * log_a)) * (i * xb).astype(jnp.float32)

    def combine(left, right):
        a1, b1 = left
        a2, b2 = right
        return a1 * a2, a2 * b1 + b2

    _, h = lax.associative_scan(combine, (a, inp), axis=1)
    return h.astype(xb.dtype)


def _route(h, w_r, b_r):
    B, S, _ = h.shape
    scores = jax.nn.sigmoid(jnp.einsum('bsd,de->bse', h.astype(jnp.float32), w_r.astype(jnp.float32)))
    biased = scores + b_r.astype(jnp.float32)
    grouped = biased.reshape(B, S, N_GROUPS, N_EXPERTS // N_GROUPS)
    group_score = lax.top_k(grouped, 2)[0].sum(-1)
    _, top_groups = lax.top_k(group_score, TOPK_GROUPS)
    group_keep = jax.nn.one_hot(top_groups, N_GROUPS, dtype=jnp.float32).sum(-2) > 0
    expert_keep = jnp.repeat(group_keep, N_EXPERTS // N_GROUPS, axis=-1)
    _, idx = lax.top_k(jnp.where(expert_keep, biased, -jnp.inf), TOP_K)
    w = jnp.take_along_axis(scores, idx, axis=-1)
    w = w / jnp.sum(w, axis=-1, keepdims=True) * ROUTED_SCALE
    return idx, w.astype(h.dtype)


def _moe_row(xs, idx, wts, w1, w3, w2):
    T, D = xs.shape
    K = idx.shape[1]
    E = w1.shape[0]
    n_blocks = -(-(T * K) // MOE_BLOCK) + E
    flat_e = idx.reshape(-1)
    order = jnp.argsort(flat_e)
    e_sorted = flat_e[order]
    tok_sorted = order // K
    counts = jnp.bincount(flat_e, length=E)
    padded = (counts + MOE_BLOCK - 1) // MOE_BLOCK * MOE_BLOCK
    pad_end = jnp.cumsum(padded)
    pad_start = pad_end - padded
    grp_start = jnp.cumsum(counts) - counts
    pos = jnp.arange(T * K) - grp_start[e_sorted] + pad_start[e_sorted]
    buf = jnp.zeros((n_blocks * MOE_BLOCK, D), xs.dtype).at[pos].set(xs[tok_sorted])
    block_e = jnp.minimum(jnp.searchsorted(pad_end, jnp.arange(n_blocks) * MOE_BLOCK, side='right'), E - 1)

    def expert_block(args):
        xb, e = args
        hid = jax.nn.silu(xb @ w1[e]) * (xb @ w3[e])
        return hid @ w2[e]

    yb = lax.map(expert_block, (buf.reshape(n_blocks, MOE_BLOCK, D), block_e))
    y = yb.reshape(-1, D)[pos] * wts.reshape(-1)[order][:, None]
    return jax.ops.segment_sum(y, tok_sorted, num_segments=T)


def setup_inputs(seed: int = 0) -> dict:
    key = jax.random.key(seed)
    ks = iter(jax.random.split(key, 40))
    L, D = DEPTH, D_MODEL
    beta = DEEPNORM_BETA

    def nrm(shape, scale):
        return jax.random.normal(next(ks), shape, jnp.float32) * scale

    a0 = jax.random.uniform(next(ks), (L, D_RNN), jnp.float32, minval=0.9, maxval=0.999)
    rg_lambda = jnp.log(a0) - jnp.log1p(-a0)
    return {
        'x': nrm((BATCH, SEQ, D), 1.0),
        'c': nrm((BATCH, D), 1.0),
        'ada_w': nrm((L, D, 6 * D), 0.5 * D ** -0.5),
        'ada_b': nrm((L, 6 * D), 0.02),
        'w_in': nrm((L, D, IN_WIDTH), D ** -0.5),
        'sgu_ln_g': 1.0 + nrm((L, D_SGU), 0.02),
        'sgu_ln_b': nrm((L, D_SGU), 0.02),
        'sgu_w': nrm((L, SGU_GROUPS, SGU_CHUNK, SGU_CHUNK), SGU_CHUNK ** -0.5),
        'sgu_b': 1.0 + nrm((L, SGU_GROUPS, SGU_CHUNK), 0.02),
        'conv_w': nrm((L, CONV_WIDTH, D_RNN), CONV_WIDTH ** -0.5),
        'conv_b': nrm((L, D_RNN), 0.02),
        'rg_wa': nrm((L, RG_HEADS, RG_HEAD_DIM, RG_HEAD_DIM), RG_HEAD_DIM ** -0.5),
        'rg_ba': nrm((L, D_RNN), 0.02),
        'rg_wx': nrm((L, RG_HEADS, RG_HEAD_DIM, RG_HEAD_DIM), RG_HEAD_DIM ** -0.5),
        'rg_bx': nrm((L, D_RNN), 0.02),
        'rg_lambda': rg_lambda,
        'w_branch_a': nrm((L, D_SGU, D), beta * D_SGU ** -0.5),
        'w_branch_b': nrm((L, D_RNN, D), beta * D_RNN ** -0.5),
        'w_out': nrm((L, D, D), beta * D ** -0.5),
        'ln1_g': 1.0 + nrm((L, D), 0.02),
        'ln1_b': nrm((L, D), 0.02),
        'router_w': nrm((L, D, N_EXPERTS), D ** -0.5),
        'router_b': nrm((L, N_EXPERTS), 0.01),
        'exp_w1': nrm((L, N_EXPERTS, D, D_EXPERT), D ** -0.5),
        'exp_w3': nrm((L, N_EXPERTS, D, D_EXPERT), D ** -0.5),
        'exp_w2': nrm((L, N_EXPERTS, D_EXPERT, D), beta * D_EXPERT ** -0.5),
        'sh_w1': nrm((L, D, D_SHARED), D ** -0.5),
        'sh_w3': nrm((L, D, D_SHARED), D ** -0.5),
        'sh_w2': nrm((L, D_SHARED, D), beta * D_SHARED ** -0.5),
        'ln2_g': 1.0 + nrm((L, D), 0.02),
        'ln2_b': nrm((L, D), 0.02),
    }


def reference(x, c, ada_w, ada_b, w_in, sgu_ln_g, sgu_ln_b, sgu_w, sgu_b, conv_w, conv_b,
              rg_wa, rg_ba, rg_wx, rg_bx, rg_lambda, w_branch_a, w_branch_b, w_out, ln1_g, ln1_b,
              router_w, router_b, exp_w1, exp_w3, exp_w2, sh_w1, sh_w3, sh_w2, ln2_g, ln2_b):
    c_act = jax.nn.silu(c)
    for l in range(DEPTH):
        ada = c_act @ ada_w[l] + ada_b[l]
        shift1, scale1, gate1, shift2, scale2, gate2 = [t[:, None, :] for t in jnp.split(ada, 6, axis=-1)]

        h = x * (1.0 + scale1) + shift1
        z = h @ w_in[l]
        u, v, rnn_gate, rnn_in, gate_a, gate_b = jnp.split(z, IN_SPLITS, axis=-1)
        v = _layer_norm(jax.nn.gelu(v), sgu_ln_g[l], sgu_ln_b[l])
        y_a = jax.nn.gelu(u) * _chunk_spatial(v, sgu_w[l], sgu_b[l])
        r_in = _causal_conv(rnn_in, conv_w[l], conv_b[l])
        y_b = jax.nn.gelu(rnn_gate) * _rg_lru(r_in, rg_wa[l], rg_ba[l], rg_wx[l], rg_bx[l], rg_lambda[l])
        merged = jax.nn.sigmoid(gate_a) * (y_a @ w_branch_a[l]) + jax.nn.sigmoid(gate_b) * (y_b @ w_branch_b[l])
        mix = merged @ w_out[l]
        x = _layer_norm(DEEPNORM_ALPHA * x + gate1 * mix, ln1_g[l], ln1_b[l])

        h2 = x * (1.0 + scale2) + shift2
        idx, wts = _route(h2, router_w[l], router_b[l])
        w1, w3, w2 = exp_w1[l], exp_w3[l], exp_w2[l]
        routed = lax.map(lambda a: _moe_row(a[0], a[1], a[2], w1, w3, w2), (h2, idx, wts))
        shared = (jax.nn.silu(h2 @ sh_w1[l]) * (h2 @ sh_w3[l])) @ sh_w2[l]
        x = _layer_norm(DEEPNORM_ALPHA * x + gate2 * (routed + shared), ln2_g[l], ln2_b[l])
    return x
```

```cpp
#include <hip/hip_runtime.h>
#include <cstdio>
#include <cstdint>

#ifndef MK_MULTI
#define MK_MULTI 0
#endif

#define GAS __attribute__((address_space(1)))
#define LAS __attribute__((address_space(3)))
typedef unsigned short bf16_t;
typedef short bf16x8 __attribute__((ext_vector_type(8)));
typedef float f32x4 __attribute__((ext_vector_type(4)));
typedef float f32x2 __attribute__((ext_vector_type(2)));
typedef unsigned u32x4 __attribute__((ext_vector_type(4)));
typedef unsigned u32x2 __attribute__((ext_vector_type(2)));

constexpr int D = 1024, BATCH = 16, SEQ = 4096, T = BATCH * SEQ, DEPTH = 4;
constexpr int NIN = 6144, NE = 64, DE = 256;
constexpr int SLAB_T = T / 2;
constexpr int ECAP = SLAB_T;
constexpr float LN_EPS = 1e-5f;
constexpr float ALPHA = 1.6817928305074290f;
constexpr float LOG2E = 1.4426950408889634f;
constexpr int NPH = 2 + 12 * DEPTH;

constexpr size_t MiB = 1u << 20;
constexpr size_t WS_CTL = 0, CTL_BYTES = 1 * MiB;
constexpr size_t WS_ADA = 1 * MiB;
constexpr size_t WS_MISC = 3 * MiB;
constexpr size_t WS_VSTAT = 4 * MiB;
constexpr size_t WS_PSTAT = 5 * MiB;
constexpr size_t WS_CARRY = 13 * MiB;
constexpr size_t WS_POS = 17 * MiB;
constexpr size_t WS_TOKE = 19 * MiB;
constexpr size_t WS_WTE = 35 * MiB;
constexpr size_t WS_W = 51 * MiB;
constexpr size_t W_IN = WS_W;
constexpr size_t W_A = W_IN + 12 * MiB;
constexpr size_t W_B = W_A + 2 * MiB;
constexpr size_t W_O = W_B + 2 * MiB;
constexpr size_t W_E13 = W_O + 2 * MiB;
constexpr size_t W_E2 = W_E13 + 65 * MiB;
constexpr size_t W_RGA = W_E2 + 33 * MiB;
constexpr size_t W_RGX = W_RGA + 256 * 1024;
constexpr size_t W_SG = W_RGX + 256 * 1024;
constexpr size_t W_RH = W_SG + 256 * 1024;
constexpr size_t W_RL = W_RH + 128 * 1024;
constexpr size_t WS_BIG = 171 * MiB;
constexpr size_t BIGSZ = 128 * MiB;
constexpr size_t WS_END = WS_BIG + 8 * BIGSZ;
static_assert(W_RL + 128 * 1024 <= WS_BIG, "weights region");
constexpr size_t HID_ROWS_MAX = (size_t)SLAB_T * 9 + 65 * 256;
static_assert(HID_ROWS_MAX * 512 <= 2 * BIGSZ && HID_ROWS_MAX * 2048 <= 5 * BIGSZ, "MoE overlay");

constexpr int CW_BAR = 4096;
constexpr int CW_CNT = 16384;

constexpr int SCR_BYTES = 147456;
constexpr int L_MISC = SCR_BYTES;
constexpr int L_TBASE = L_MISC + 128;
constexpr int L_CNT = L_TBASE + 384;
constexpr int L_TMAP = L_CNT + 512;
constexpr int LDS_BYTES = SCR_BYTES + 4096;
static_assert(L_TMAP + 2560 <= LDS_BYTES, "LDS map");

#define LDS_WAIT() asm volatile("s_waitcnt lgkmcnt(0)" ::: "memory")
#define VM_WAIT() asm volatile("s_waitcnt vmcnt(0)" ::: "memory")
__device__ __forceinline__ unsigned cvt_pk_bf16(float lo, float hi) { unsigned r; asm("v_cvt_pk_bf16_f32 %0, %1, %2" : "=v"(r) : "v"(lo), "v"(hi)); return r; }
__device__ __forceinline__ float bf_lo(unsigned w) { return __uint_as_float(w << 16); }
__device__ __forceinline__ float bf_hi(unsigned w) { return __uint_as_float(w & 0xffff0000u); }
__device__ __forceinline__ float fsigmoid(float x) { return __builtin_amdgcn_rcpf(1.0f + __builtin_amdgcn_exp2f(-LOG2E * x)); }
__device__ __forceinline__ float wave_sum(float v) {
#pragma unroll
    for (int o = 1; o < 64; o <<= 1) v += __shfl_xor(v, o);
    return v;
}
__device__ __forceinline__ f32x2 gelu_pk(f32x2 v) {
    const f32x2 av = __builtin_elementwise_abs(v), d = av * 0.2316418882f + 1.0f;
    f32x2 t; t.x = __builtin_amdgcn_rcpf(d.x); t.y = __builtin_amdgcn_rcpf(d.y);
    f32x2 q = t * 0.5307027145f + (-0.7265760135f); q = q * t + 0.7107068705f; q = q * t + (-0.142248368f); q = q * t + 0.127414796f; q = q * t;
    const f32x2 s = (v * v) * (-0.72134752044f);
    f32x2 e; e.x = __builtin_amdgcn_exp2f(s.x); e.y = __builtin_amdgcn_exp2f(s.y);
    const f32x2 m = v * (q * e), r = v - m;
    f32x2 o; o.x = v.x < 0.f ? m.x : r.x; o.y = v.y < 0.f ? m.y : r.y; return o;
}
__device__ __forceinline__ float gelu1(float x) { f32x2 r = gelu_pk((f32x2){x, x}); return r.x; }

#define XB_TMO      128
#define XB_XCNT(j)  (256  + 64 * (j))
#define XB_XSUB(j)  (1280 + 64 * (j))
#define XB_XGEN(j)  (2304 + 64 * (j))
#define XB_TOP      3328
#define XB_TOPGEN   3392
#define XCD_BAR_WORDS 3456
#define XB_SPIN_CAP (1u << 20)
__device__ __forceinline__ unsigned xb_ld(GAS unsigned* p)              { return __hip_atomic_load(p, __ATOMIC_RELAXED, __HIP_MEMORY_SCOPE_AGENT); }
__device__ __forceinline__ unsigned xb_add(GAS unsigned* p, unsigned v) { return __hip_atomic_fetch_add(p, v, __ATOMIC_RELAXED, __HIP_MEMORY_SCOPE_AGENT); }
__device__ __forceinline__ unsigned xb_xcc_id() { return (unsigned)__builtin_amdgcn_s_getreg((3 << 11) | 20) & 0xFu; }
#define XB_SPIN(cond, bar) do { unsigned _sp = 0; while (cond) { __builtin_amdgcn_s_sleep(1); \
    if ((++_sp & 255u) == 0u) { if (xb_ld(&(bar)[XB_TMO])) break; if (_sp > XB_SPIN_CAP) { (void)xb_add(&(bar)[XB_TMO], 1u); break; } } } } while (0)
struct XcdBarrier { GAS unsigned* bar; unsigned x; volatile LAS unsigned* st; };
__device__ __forceinline__ XcdBarrier xcd_barrier_post(GAS unsigned* bar, volatile LAS unsigned* st) {
    XcdBarrier b; b.bar = bar; b.x = xb_xcc_id(); b.st = st;
    if (threadIdx.x == 0) (void)xb_add(&bar[XB_XCNT(b.x)], 1u);
    return b;
}
__device__ __forceinline__ void xcd_barrier_complete(GAS unsigned* bar, unsigned x, unsigned& nloc, unsigned& nx) {
    const unsigned G = gridDim.x * gridDim.y * gridDim.z;
    unsigned sum, cnt, mine, sp = 0u;
    for (;;) {
        sum = 0u; cnt = 0u; mine = 0u;
#pragma unroll
        for (unsigned j = 0; j < 16; ++j) { const unsigned c = xb_ld(&bar[XB_XCNT(j)]); sum += c; cnt += (c > 0u) ? 1u : 0u; mine = (j == x) ? c : mine; }
        if (sum == G) break;
        __builtin_amdgcn_s_sleep(1);
        if ((++sp & 255u) == 0u) { if (xb_ld(&bar[XB_TMO])) break; if (sp > XB_SPIN_CAP) { (void)xb_add(&bar[XB_TMO], 1u); break; } }
    }
    nloc = mine > 0u ? mine : 1u; nx = cnt > 0u ? cnt : 1u;
}
__device__ __forceinline__ void xcd_barrier(const XcdBarrier& b) {
    asm volatile("s_waitcnt vmcnt(0)" ::: "memory");
    __syncthreads();
    if (threadIdx.x == 0) {
        GAS unsigned* bar = b.bar; unsigned bx_ = b.x; asm volatile("" : "+s"(bar), "+s"(bx_));
        __builtin_amdgcn_s_waitcnt(0);
        unsigned nloc = b.st[0], nx = b.st[1];
        if (nloc == 0u) { xcd_barrier_complete(bar, bx_, nloc, nx); b.st[0] = nloc; b.st[1] = nx; }
        const unsigned old = xb_add(&bar[XB_XSUB(bx_)], 1u);
        const unsigned gen = old / nloc;
        if (old + 1u == (gen + 1u) * nloc) {
            __builtin_amdgcn_fence(__ATOMIC_RELEASE, "agent");
            asm volatile("s_waitcnt vmcnt(0)" ::: "memory");
            const unsigned og = xb_add(&bar[XB_TOP], 1u);
            const unsigned tg = og / nx;
            if (og + 1u == (tg + 1u) * nx) xb_add(&bar[XB_TOPGEN], 1u);
            else XB_SPIN(xb_ld(&bar[XB_TOPGEN]) == tg, bar);
            __builtin_amdgcn_fence(__ATOMIC_ACQUIRE, "agent");
            xb_add(&bar[XB_XGEN(bx_)], 1u);
            asm volatile("s_waitcnt vmcnt(0)" ::: "memory");
        } else {
            XB_SPIN(xb_ld(&bar[XB_XGEN(bx_)]) == gen, bar);
            __builtin_amdgcn_fence(__ATOMIC_ACQUIRE, "agent");
            asm volatile("s_waitcnt vmcnt(0)" ::: "memory");
        }
    }
    __syncthreads();
}

namespace pg8 {
constexpr int BM = 256, BK = 64, HALF = 128, HTB = HALF * BK * 2, STAGE_BYTES = 8 * HTB, NXCD = 8, WGM = 8;
__device__ __forceinline__ int lds_byte(int r, int c) { const int st = (r >> 4) * 2 + (c >> 5), rr = r & 15, cc = c & 31, ob = rr * 64 + cc * 2; return st * 1024 + (ob ^ (((ob >> 9) & 1) << 5)); }
__device__ __forceinline__ void stage_rc(int b, int& R, int& C) { const int st = b / 1024, sb = b % 1024, swz = sb ^ (((sb >> 9) & 1) << 5); R = (st >> 1) * 16 + swz / 64; C = (st & 1) * 32 + (swz % 64) / 2; }
__device__ __forceinline__ int perm32(int rho) { const int n = rho >> 4, i = rho & 15; return 8 * (i >> 2) + 4 * n + (i & 3); }

struct Unit { int pm, pn, aux, j; };

__device__ __forceinline__ void tile_of(int wgid, int nM, int nN, int& pm, int& pn) {
    const int nwg = nM * nN; { const int q = nwg / NXCD, r = nwg % NXCD, xcd = wgid % NXCD, off = wgid / NXCD; wgid = (xcd < r ? xcd * (q + 1) : r * (q + 1) + (xcd - r) * q) + off; }
    const int nig = WGM * nN, gid = wgid / nig, fm = gid * WGM, gsz = (nM - fm) < WGM ? (nM - fm) : WGM;
    pm = fm + ((wgid % nig) % gsz); pn = (wgid % nig) / gsz;
}
struct SchedStatic {
    int nM, nN, G, c;
    __device__ __forceinline__ bool next(int i, Unit& u) const { const long L = (long)i * G + c; if (L >= (long)nM * nN) return false; tile_of((int)L, nM, nN, u.pm, u.pn); u.aux = 0; u.j = 0; return true; }
};
struct SchedPair {
    int nM, nN, G, c;
    __device__ __forceinline__ bool next(int i, Unit& u) const { const long L = (long)(i >> 1) * G + c; if (L >= (long)nM * nN) return false; tile_of((int)L, nM, nN, u.pm, u.pn); u.aux = i & 1; u.j = 0; return true; }
};
template <int NCT> struct SchedMoe {
    int ntiles, G, c; const LAS unsigned short* tmap; const LAS int* tbase;
    __device__ __forceinline__ bool next(int i, Unit& u) const {
        const long L = (long)i * G + c; const int tile = (int)(L / NCT); if (tile >= ntiles) return false;
        u.pm = tile; u.pn = (int)(L % NCT); u.aux = __builtin_amdgcn_readfirstlane((int)tmap[tile]); u.j = tile - __builtin_amdgcn_readfirstlane(tbase[u.aux]); return true;
    }
};

struct ProbPlain {
    static constexpr bool GATHER = false;
    const GAS char* A; const GAS char* Bt; int K;
    __device__ __forceinline__ const GAS char* a_base(const Unit& u) const { return A + (size_t)u.pm * 256 * K * 2; }
    __device__ __forceinline__ const GAS char* b_base(const Unit& u) const { return Bt + (size_t)u.pn * 256 * K * 2; }
    __device__ __forceinline__ void gather(const Unit&, const int (&)[2], const int (&)[2], unsigned (&)[2][2]) const {}
};
struct ProbPair {
    static constexpr bool GATHER = false;
    const GAS char* A0; const GAS char* A1; const GAS char* B0; const GAS char* B1; int K;
    __device__ __forceinline__ const GAS char* a_base(const Unit& u) const { return (u.aux ? A1 : A0) + (size_t)u.pm * 256 * K * 2; }
    __device__ __forceinline__ const GAS char* b_base(const Unit& u) const { return (u.aux ? B1 : B0) + (size_t)u.pn * 256 * K * 2; }
    __device__ __forceinline__ void gather(const Unit&, const int (&)[2], const int (&)[2], unsigned (&)[2][2]) const {}
};
struct ProbMoe1 {
    static constexpr bool GATHER = true;
    const GAS char* A; const GAS char* W; const GAS unsigned* tok; const LAS int* cnt; int K;
    __device__ __forceinline__ const GAS char* a_base(const Unit&) const { return A; }
    __device__ __forceinline__ const GAS char* b_base(const Unit& u) const { return W + (size_t)u.aux * (512 * 1024 * 2) + (size_t)u.pn * 256 * 2048; }
    __device__ __forceinline__ void gather(const Unit& u, const int (&R)[2], const int (&C2)[2], unsigned (&vo)[2][2]) const {
        const int c = cnt[u.aux];
#pragma unroll
        for (int h = 0; h < 2; ++h)
#pragma unroll
            for (int i = 0; i < 2; ++i) { const int p = u.j * 256 + h * 128 + R[i]; unsigned tk = 0u;
                if (p < c) tk = (u.aux == 64) ? (unsigned)p : __builtin_nontemporal_load(tok + (size_t)u.aux * ECAP + p);
                vo[h][i] = tk * 2048u + (unsigned)C2[i]; }
    }
};
struct ProbMoe2 {
    static constexpr bool GATHER = false;
    const GAS char* A; const GAS char* W; int K;
    __device__ __forceinline__ const GAS char* a_base(const Unit& u) const { return A + (size_t)u.pm * 256 * 512; }
    __device__ __forceinline__ const GAS char* b_base(const Unit& u) const { return W + (size_t)u.aux * (1024 * 256 * 2) + (size_t)u.pn * 256 * 512; }
    __device__ __forceinline__ void gather(const Unit&, const int (&)[2], const int (&)[2], unsigned (&)[2][2]) const {}
};

typedef f32x4 Acc[2][2][4][2];

struct EpiZ {
    static constexpr bool PERM = true;
    GAS bf16_t* out0;
    __device__ __forceinline__ bool keep(const Unit&) const { return false; }
    template <int ACT> __device__ __forceinline__ void run(const Acc& acc, GAS bf16_t* base, int row0, int col0) const {
#pragma unroll
        for (int ai = 0; ai < 2; ++ai)
#pragma unroll
            for (int m = 0; m < 4; ++m) { GAS bf16_t* rowp = base + (size_t)(row0 + ai * HALF + m * 16) * D + col0;
#pragma unroll
                for (int bj = 0; bj < 2; ++bj) { f32x4 v0 = acc[ai][bj][m][0], v1 = acc[ai][bj][m][1];
                    if (ACT == 1) { f32x2 a = gelu_pk((f32x2){v0[0], v0[1]}), b = gelu_pk((f32x2){v0[2], v0[3]}), c = gelu_pk((f32x2){v1[0], v1[1]}), d = gelu_pk((f32x2){v1[2], v1[3]});
                        v0 = (f32x4){a.x, a.y, b.x, b.y}; v1 = (f32x4){c.x, c.y, d.x, d.y}; }
                    if (ACT == 2) {
#pragma unroll
                        for (int j = 0; j < 4; ++j) { v0[j] = fsigmoid(v0[j]); v1[j] = fsigmoid(v1[j]); } }
                    u32x4 w; w.x = cvt_pk_bf16(v0[0], v0[1]); w.y = cvt_pk_bf16(v0[2], v0[3]); w.z = cvt_pk_bf16(v1[0], v1[1]); w.w = cvt_pk_bf16(v1[2], v1[3]);
                    *(GAS u32x4*)(rowp + bj * HALF) = w; } }
    }
    __device__ __forceinline__ void operator()(Acc& acc, const Unit& u, int wr, int wc, int fr, int fq) const {
        const int part = u.pn >> 2; GAS bf16_t* base = out0 + (size_t)part * ((size_t)T * D);
        const int row0 = u.pm * BM + wr * 64 + fr, col0 = (u.pn & 3) * BM + wc * 32 + 8 * fq;
        if (part < 3) run<1>(acc, base, row0, col0); else if (part == 3) run<0>(acc, base, row0, col0); else run<2>(acc, base, row0, col0);
    }
};
struct EpiPair {
    static constexpr bool PERM = true;
    GAS bf16_t* GA; const GAS bf16_t* GB;
    __device__ __forceinline__ bool keep(const Unit& u) const { return u.aux == 0; }
    __device__ __forceinline__ void operator()(Acc& acc, const Unit& u, int wr, int wc, int fr, int fq) const {
        const int row0 = u.pm * BM + wr * 64 + fr, col0 = u.pn * BM + wc * 32 + 8 * fq;
#pragma unroll
        for (int ai = 0; ai < 2; ++ai)
#pragma unroll
            for (int m = 0; m < 4; ++m) { const size_t off = (size_t)(row0 + ai * HALF + m * 16) * D + col0;
#pragma unroll
                for (int bj = 0; bj < 2; ++bj) {
                    const u32x4 gb = *(const GAS u32x4*)(GB + off + bj * HALF);
                    float sb[8] = {bf_lo(gb.x), bf_hi(gb.x), bf_lo(gb.y), bf_hi(gb.y), bf_lo(gb.z), bf_hi(gb.z), bf_lo(gb.w), bf_hi(gb.w)};
#pragma unroll
                    for (int j = 0; j < 8; ++j) sb[j] = fmaxf(sb[j], 1e-12f);
                    if (u.aux == 0) {
                        const u32x4 ga = *(const GAS u32x4*)(GA + off + bj * HALF);
                        const float sa[8] = {bf_lo(ga.x), bf_hi(ga.x), bf_lo(ga.y), bf_hi(ga.y), bf_lo(ga.z), bf_hi(ga.z), bf_lo(ga.w), bf_hi(ga.w)};
#pragma unroll
                        for (int j = 0; j < 4; ++j) { acc[ai][bj][m][0][j] *= sa[j] * __builtin_amdgcn_rcpf(sb[j]); acc[ai][bj][m][1][j] *= sa[4 + j] * __builtin_amdgcn_rcpf(sb[4 + j]); }
                    } else {
                        f32x4 v0 = acc[ai][bj][m][0], v1 = acc[ai][bj][m][1];
#pragma unroll
                        for (int j = 0; j < 4; ++j) { v0[j] *= sb[j]; v1[j] *= sb[4 + j]; }
                        u32x4 w; w.x = cvt_pk_bf16(v0[0], v0[1]); w.y = cvt_pk_bf16(v0[2], v0[3]); w.z = cvt_pk_bf16(v1[0], v1[1]); w.w = cvt_pk_bf16(v1[2], v1[3]);
                        *(GAS u32x4*)(GA + off + bj * HALF) = w; } }
                asm volatile("" ::: "memory"); }
    }
};
struct EpiOut {
    static constexpr bool PERM = false;
    const GAS float* xsrc; GAS float* xdst; const GAS float* ada_l; GAS float* pstat;
    __device__ __forceinline__ bool keep(const Unit&) const { return false; }
    __device__ __forceinline__ void operator()(Acc& acc, const Unit& u, int wr, int wc, int fr, int fq) const {
        const int row0 = u.pm * BM + wr * 64 + fr, col0 = u.pn * BM + wc * 32 + 4 * fq; const int b = u.pm >> 4;
        const GAS float* gate = ada_l + (size_t)b * NIN + 2 * D + col0;
        f32x4 g[2][2];
#pragma unroll
        for (int bj = 0; bj < 2; ++bj)
#pragma unroll
            for (int n = 0; n < 2; ++n) g[bj][n] = *(const GAS f32x4*)(gate + bj * HALF + n * 16);
#pragma unroll
        for (int ai = 0; ai < 2; ++ai)
#pragma unroll
            for (int m = 0; m < 4; ++m) { const int row = row0 + ai * HALF + m * 16; const size_t off = (size_t)row * D + col0; float s = 0.f, q = 0.f;
#pragma unroll
                for (int bj = 0; bj < 2; ++bj)
#pragma unroll
                    for (int n = 0; n < 2; ++n) { const f32x4 xv = *(const GAS f32x4*)(xsrc + off + bj * HALF + n * 16); const f32x4 v = xv * ALPHA + g[bj][n] * acc[ai][bj][m][n];
                        *(GAS f32x4*)(xdst + off + bj * HALF + n * 16) = v; s += (v[0] + v[1]) + (v[2] + v[3]); q += (v[0] * v[0] + v[1] * v[1]) + (v[2] * v[2] + v[3] * v[3]); }
                s += __shfl_xor(s, 16); s += __shfl_xor(s, 32); q += __shfl_xor(q, 16); q += __shfl_xor(q, 32);
                if (fq == 0) *(GAS f32x2*)(pstat + ((size_t)row * 16 + u.pn * 4 + wc) * 2) = (f32x2){s, q};
                asm volatile("" ::: "memory"); }
    }
};
struct EpiMoe1 {
    static constexpr bool PERM = true;
    GAS bf16_t* hid; const GAS float* wts; const LAS int* cnt;
    __device__ __forceinline__ bool keep(const Unit&) const { return false; }
    __device__ __forceinline__ void operator()(Acc& acc, const Unit& u, int wr, int wc, int fr, int fq) const {
        const int e = u.aux, c = cnt[e]; const int hc0 = u.pn * 128 + wc * 16 + 4 * fq;
#pragma unroll
        for (int ai = 0; ai < 2; ++ai)
#pragma unroll
            for (int m = 0; m < 4; ++m) { const int r = ai * HALF + wr * 64 + m * 16 + fr, p = u.j * 256 + r;
                float w = 0.f; if (p < c) w = (e == 64) ? 1.0f : wts[(size_t)e * ECAP + p];
                GAS bf16_t* rowp = hid + (size_t)(u.pm * 256 + r) * DE + hc0;
#pragma unroll
                for (int bj = 0; bj < 2; ++bj) { const f32x4 v0 = acc[ai][bj][m][0], v1 = acc[ai][bj][m][1];
                    const float h0 = v0[0] * fsigmoid(v0[0]) * v0[1] * w, h1 = v0[2] * fsigmoid(v0[2]) * v0[3] * w, h2 = v1[0] * fsigmoid(v1[0]) * v1[1] * w, h3 = v1[2] * fsigmoid(v1[2]) * v1[3] * w;
                    u32x2 o; o.x = cvt_pk_bf16(h0, h1); o.y = cvt_pk_bf16(h2, h3); *(GAS u32x2*)(rowp + bj * 64) = o; } }
    }
};
struct EpiMoe2 {
    static constexpr bool PERM = true;
    GAS bf16_t* y;
    __device__ __forceinline__ bool keep(const Unit&) const { return false; }
    __device__ __forceinline__ void operator()(Acc& acc, const Unit& u, int wr, int wc, int fr, int fq) const {
        const int row0 = u.pm * BM + wr * 64 + fr, col0 = u.pn * BM + wc * 32 + 8 * fq;
#pragma unroll
        for (int ai = 0; ai < 2; ++ai)
#pragma unroll
            for (int m = 0; m < 4; ++m) { GAS bf16_t* rowp = y + (size_t)(row0 + ai * HALF + m * 16) * D + col0;
#pragma unroll
                for (int bj = 0; bj < 2; ++bj) { const f32x4 v0 = acc[ai][bj][m][0], v1 = acc[ai][bj][m][1];
                    u32x4 w; w.x = cvt_pk_bf16(v0[0], v0[1]); w.y = cvt_pk_bf16(v0[2], v0[3]); w.z = cvt_pk_bf16(v1[0], v1[1]); w.w = cvt_pk_bf16(v1[2], v1[3]);
                    *(GAS u32x4*)(rowp + bj * HALF) = w; } }
    }
};

__device__ __forceinline__ void stage2(LAS unsigned char* dst, const GAS char* g0, const GAS char* g1) {
    __builtin_amdgcn_global_load_lds((const GAS unsigned*)g0, (LAS unsigned*)dst, 16, 0, 0);
    __builtin_amdgcn_global_load_lds((const GAS unsigned*)g1, (LAS unsigned*)(dst + 8192), 16, 0, 0);
}

template <class Prob, class Epi, class Sched>
__device__ __forceinline__ void gemm_phase(LAS unsigned char* lds, const int tid, const Prob& P, const Sched& S, const Epi& E) {
    constexpr bool GATHER = Prob::GATHER;
    const int wid = __builtin_amdgcn_readfirstlane(tid >> 6), lane = tid & 63, wr = wid >> 2, wc = wid & 3, fr = lane & 15, fq = lane >> 4;
    const int K = P.K, nt = K / BK;
    unsigned voffA[2], voffB[2]; int RA[2], CA2[2];
#pragma unroll
    for (int i = 0; i < 2; ++i) { int R, C; stage_rc(tid * 16 + i * 8192, R, C); const int Rb = Epi::PERM ? ((R & ~31) + perm32(R & 31)) : R;
        voffA[i] = (unsigned)(R * K + C) * 2u; voffB[i] = (unsigned)(Rb * K + C) * 2u; RA[i] = R; CA2[i] = C * 2; }
    const size_t kstep = (size_t)(BK * 2);
    const size_t hstep = (size_t)HALF * K * 2;
    const unsigned ldsw = (unsigned)wid * 1024u;
    const int aoff = lds_byte(wr * 64 + fr, fq * 8), boff = lds_byte(wc * 32 + fr, fq * 8);
#define PG8_SA(b, h) (((b) * 2 + (h)) * HTB)
#define PG8_SB(b, h) ((4 + (b) * 2 + (h)) * HTB)
#define PG8_STG_B(bufoff, pb) stage2(lds + (bufoff) + ldsw, (pb) + voffB[0], (pb) + voffB[1])
#define PG8_STG_A(bufoff, NXT, h, kb) do { const GAS char* _b = ((NXT) ? nA : cA) + (kb) + (GATHER ? (size_t)0 : (size_t)(h) * hstep); \
        const unsigned _o0 = GATHER ? ((NXT) ? nvA[h][0] : vA[h][0]) : voffA[0], _o1 = GATHER ? ((NXT) ? nvA[h][1] : vA[h][1]) : voffA[1]; \
        stage2(lds + (bufoff) + ldsw, _b + _o0, _b + _o1); } while (0)
#define PG8_LDA(dst, b, h) do { _Pragma("unroll") for (int m = 0; m < 4; ++m) _Pragma("unroll") for (int k = 0; k < 2; ++k) dst[m][k] = *(const LAS bf16x8*)(lds + PG8_SA(b, h) + aoff + m * 2048 + k * 1024); } while (0)
#define PG8_LDB(dst, b, h) do { _Pragma("unroll") for (int n = 0; n < 2; ++n) _Pragma("unroll") for (int k = 0; k < 2; ++k) dst[n][k] = *(const LAS bf16x8*)(lds + PG8_SB(b, h) + boff + n * 2048 + k * 1024); } while (0)
#define PG8_MMA(ai, bj, At, Bt) do { __builtin_amdgcn_s_setprio(1); _Pragma("unroll") for (int m = 0; m < 4; ++m) _Pragma("unroll") for (int n = 0; n < 2; ++n) _Pragma("unroll") for (int k = 0; k < 2; ++k) \
        acc[ai][bj][m][n] = __builtin_amdgcn_mfma_f32_16x16x32_bf16(Bt[n][k], At[m][k], acc[ai][bj][m][n], 0, 0, 0); __builtin_amdgcn_s_setprio(0); } while (0)
#define PG8_WAIT_V(n) asm volatile("s_waitcnt vmcnt(" #n ")" ::: "memory")
#define PG8_WAIT_L(n) asm volatile("s_waitcnt lgkmcnt(" #n ")" ::: "memory")
#define PG8_BAR __builtin_amdgcn_s_barrier()
#define PG8_SCHED __builtin_amdgcn_sched_barrier(0)
    Unit cur, nxt; int ui = 0;
    if (!S.next(0, cur)) return;
    Acc acc;
#pragma unroll
    for (int a = 0; a < 2; ++a)
#pragma unroll
        for (int b = 0; b < 2; ++b)
#pragma unroll
            for (int m = 0; m < 4; ++m)
#pragma unroll
                for (int n = 0; n < 2; ++n) acc[a][b][m][n] = (f32x4){0.f, 0.f, 0.f, 0.f};
    bf16x8 At[4][2], B0[2][2], B1[2][2];
    unsigned vA[2][2] = {{0u, 0u}, {0u, 0u}}, nvA[2][2] = {{0u, 0u}, {0u, 0u}};
    const GAS char* cA = P.a_base(cur); const GAS char* cB = P.b_base(cur);
    const GAS char* nA = cA;
    if (GATHER) { P.gather(cur, RA, CA2, vA); }
    {
        const bool F = false;
        PG8_STG_B(PG8_SB(0, 0), cB); PG8_STG_B(PG8_SB(0, 1), cB + hstep); PG8_STG_A(PG8_SA(0, 0), F, 0, (size_t)0); PG8_STG_A(PG8_SA(0, 1), F, 1, (size_t)0);
        if (wr == 1) PG8_BAR;
        PG8_WAIT_V(2); PG8_BAR;
        PG8_STG_B(PG8_SB(1, 0), cB + kstep); PG8_STG_A(PG8_SA(1, 0), F, 0, kstep); PG8_STG_B(PG8_SB(1, 1), cB + hstep + kstep);
        PG8_WAIT_V(6); PG8_BAR;
    }
    for (;;) {
        const bool has_next = S.next(ui + 1, nxt);
        nA = has_next ? P.a_base(nxt) : cA; const GAS char* nB = has_next ? P.b_base(nxt) : cB;
        if (GATHER && !has_next) {
#pragma unroll
            for (int h = 0; h < 2; ++h) { nvA[h][0] = vA[h][0]; nvA[h][1] = vA[h][1]; } }
        for (int t = 0; t < nt; t += 2) {
            const bool last = (t == nt - 2);
            const size_t kb1 = (size_t)(t + 1) * kstep;
            const size_t kb2 = last ? (size_t)0 : (size_t)(t + 2) * kstep, kb3 = kb2 + kstep;
            const GAS char* b2 = (last ? nB : cB) + kb2; const GAS char* b3 = b2 + kstep;
            if (GATHER && last && has_next) P.gather(nxt, RA, CA2, nvA);
            PG8_LDB(B0, 0, 0); PG8_LDB(B1, 0, 1); PG8_SCHED; PG8_LDA(At, 0, 0); PG8_STG_A(PG8_SA(1, 1), false, 1, kb1);
            PG8_WAIT_V(8); PG8_WAIT_L(0); PG8_BAR; PG8_MMA(0, 0, At, B0); PG8_MMA(0, 1, At, B1); PG8_BAR; PG8_SCHED;
            PG8_LDA(At, 0, 1); PG8_STG_B(PG8_SB(0, 0), b2); PG8_STG_B(PG8_SB(0, 1), b2 + hstep); PG8_STG_A(PG8_SA(0, 0), last, 0, kb2);
            PG8_WAIT_V(8); PG8_WAIT_L(0); PG8_BAR; PG8_MMA(1, 0, At, B0); PG8_MMA(1, 1, At, B1); PG8_BAR; PG8_SCHED;
            PG8_LDB(B0, 1, 0); PG8_LDB(B1, 1, 1); PG8_SCHED; PG8_LDA(At, 1, 0); PG8_STG_A(PG8_SA(0, 1), last, 1, kb2);
            PG8_WAIT_V(8); PG8_WAIT_L(0); PG8_BAR; PG8_MMA(0, 0, At, B0); PG8_MMA(0, 1, At, B1); PG8_BAR; PG8_SCHED;
            PG8_LDA(At, 1, 1); PG8_STG_B(PG8_SB(1, 0), b3); PG8_STG_B(PG8_SB(1, 1), b3 + hstep); PG8_STG_A(PG8_SA(1, 0), last, 0, kb3);
            PG8_WAIT_V(8); PG8_WAIT_L(0); PG8_BAR; PG8_MMA(1, 0, At, B0); PG8_MMA(1, 1, At, B1); PG8_BAR; PG8_SCHED;
        }
        if (wr == 0) PG8_BAR;
        E(acc, cur, wr, wc, fr, fq);
        if (!has_next) break;
        if (!E.keep(cur)) {
#pragma unroll
            for (int a = 0; a < 2; ++a)
#pragma unroll
                for (int b = 0; b < 2; ++b)
#pragma unroll
                    for (int m = 0; m < 4; ++m)
#pragma unroll
                        for (int n = 0; n < 2; ++n) acc[a][b][m][n] = (f32x4){0.f, 0.f, 0.f, 0.f};
        }
        cur = nxt; cA = nA; cB = nB; ++ui;
        if (GATHER) {
#pragma unroll
            for (int h = 0; h < 2; ++h) { vA[h][0] = nvA[h][0]; vA[h][1] = nvA[h][1]; } }
        if (wr == 1) PG8_BAR;
    }
    PG8_WAIT_V(0);
    PG8_BAR;
#undef PG8_SA
#undef PG8_SB
#undef PG8_STG_A
#undef PG8_STG_B
#undef PG8_LDA
#undef PG8_LDB
#undef PG8_MMA
#undef PG8_WAIT_V
#undef PG8_WAIT_L
#undef PG8_BAR
#undef PG8_SCHED
}
}

struct Args { const float* in[31]; float* out; unsigned char* ws; int ph_lo, ph_hi; };
struct Frame {
    LAS unsigned char* lds; int tid, lane, wave, vcu, G;
    GAS unsigned char* ws;
};
#define NWAVES 8

__device__ __forceinline__ void transpose_item(const GAS float* W, int N, GAS bf16_t* WT, int ldo, int row_mul, int row_add, LAS float* scr, int item, int lane) {
    const int nblk = N / 32, kb = item / nblk, nb = item % nblk, k0 = 64 * kb, n0 = 32 * nb;
#pragma unroll 8
    for (int i = 0; i < 32; ++i) { const int kk = 2 * i + (lane >> 5); scr[kk * 33 + (lane & 31)] = W[(size_t)(k0 + kk) * N + n0 + (lane & 31)]; }
    LDS_WAIT(); asm volatile("" ::: "memory");
    const int c = lane & 7;
#pragma unroll
    for (int j = 0; j < 4; ++j) { const int n = (lane >> 3) + 8 * j; const LAS float* s = scr + (8 * c) * 33 + n;
        u32x4 o; o.x = cvt_pk_bf16(s[0 * 33], s[1 * 33]); o.y = cvt_pk_bf16(s[2 * 33], s[3 * 33]); o.z = cvt_pk_bf16(s[4 * 33], s[5 * 33]); o.w = cvt_pk_bf16(s[6 * 33], s[7 * 33]);
        *(GAS u32x4*)(WT + (size_t)((n0 + n) * row_mul + row_add) * ldo + k0 + 8 * c) = o; }
    LDS_WAIT(); asm volatile("" ::: "memory");
}

__device__ __forceinline__ void convert_layer(const Frame& F, const Args& a, int l) {
    LAS float* scr = (LAS float*)(F.lds + F.wave * 16384);
    const int gw = F.vcu * NWAVES + F.wave, NGW = F.G * NWAVES;
    GAS unsigned char* ws = F.ws;
    constexpr int I_IN = 16 * 192, I_SQ = 16 * 32, I_E1 = 16 * 8, I_E2 = 4 * 32, I_RG = 2 * 4;
    constexpr int N0 = I_IN, N1 = N0 + 3 * I_SQ, N2 = N1 + 64 * I_E1, N3 = N2 + 64 * I_E1, N4 = N3 + 2 * I_E1, N5 = N4 + 64 * I_E2, N6 = N5 + I_E2, N7 = N6 + 8 * I_RG, N8 = N7 + 8 * I_RG;
    for (int it = gw; it < N8; it += NGW) {
        if (it < N0) { transpose_item(((const GAS float*)a.in[4]) + (size_t)l * D * NIN, NIN, (GAS bf16_t*)(ws + W_IN), D, 1, 0, scr, it, F.lane); }
        else if (it < N1) { const int r = it - N0, w = r / I_SQ, ii = r % I_SQ; const GAS float* src = ((const GAS float*)a.in[16 + w]) + (size_t)l * D * D; GAS bf16_t* dst = (GAS bf16_t*)(ws + (w == 0 ? W_A : (w == 1 ? W_B : W_O)));
            transpose_item(src, D, dst, D, 1, 0, scr, ii, F.lane); }
        else if (it < N2) { const int r = it - N1, e = r / I_E1, ii = r % I_E1; transpose_item(((const GAS float*)a.in[23]) + ((size_t)l * NE + e) * D * DE, DE, (GAS bf16_t*)(ws + W_E13) + (size_t)e * 512 * D, D, 2, 0, scr, ii, F.lane); }
        else if (it < N3) { const int r = it - N2, e = r / I_E1, ii = r % I_E1; transpose_item(((const GAS float*)a.in[24]) + ((size_t)l * NE + e) * D * DE, DE, (GAS bf16_t*)(ws + W_E13) + (size_t)e * 512 * D, D, 2, 1, scr, ii, F.lane); }
        else if (it < N4) { const int r = it - N3, w = r / I_E1, ii = r % I_E1; transpose_item(((const GAS float*)a.in[26 + w]) + (size_t)l * D * DE, DE, (GAS bf16_t*)(ws + W_E13) + (size_t)64 * 512 * D, D, 2, w, scr, ii, F.lane); }
        else if (it < N5) { const int r = it - N4, e = r / I_E2, ii = r % I_E2; transpose_item(((const GAS float*)a.in[25]) + ((size_t)l * NE + e) * DE * D, D, (GAS bf16_t*)(ws + W_E2) + (size_t)e * D * DE, DE, 1, 0, scr, ii, F.lane); }
        else if (it < N6) { const int ii = it - N5; transpose_item(((const GAS float*)a.in[28]) + (size_t)l * DE * D, D, (GAS bf16_t*)(ws + W_E2) + (size_t)64 * D * DE, DE, 1, 0, scr, ii, F.lane); }
        else if (it < N7) { const int r = it - N6, h = r / I_RG, ii = r % I_RG; transpose_item(((const GAS float*)a.in[11]) + ((size_t)l * 8 + h) * 128 * 128, 128, (GAS bf16_t*)(ws + W_RGA) + (size_t)h * 128 * 128, 128, 1, 0, scr, ii, F.lane); }
        else { const int r = it - N7, h = r / I_RG, ii = r % I_RG; transpose_item(((const GAS float*)a.in[13]) + ((size_t)l * 8 + h) * 128 * 128, 128, (GAS bf16_t*)(ws + W_RGX) + (size_t)h * 128 * 128, 128, 1, 0, scr, ii, F.lane); }
    }
    const int gt = F.vcu * 512 + F.tid, NGT = F.G * 512;
    for (int i = gt; i < 8 * 128 * 128; i += NGT) { const int s = i & 127, t = (i >> 7) & 127; const float v = ((const GAS float*)a.in[7])[(size_t)l * 8 * 128 * 128 + i];
        ((GAS bf16_t*)(ws + W_SG))[i] = (bf16_t)(cvt_pk_bf16(s <= t ? v : 0.f, 0.f) & 0xffffu); }
    for (int i = gt; i < 64 * 1024; i += NGT) { const int c = i >> 6, e = i & 63; const float v = ((const GAS float*)a.in[21])[(size_t)l * D * 64 + i];
        const unsigned hi = cvt_pk_bf16(v, 0.f) & 0xffffu; const float r = v - __uint_as_float(hi << 16);
        ((GAS bf16_t*)(ws + W_RH))[e * D + c] = (bf16_t)hi; ((GAS bf16_t*)(ws + W_RL))[e * D + c] = (bf16_t)(cvt_pk_bf16(r, 0.f) & 0xffffu); }
    for (int i = gt; i < D; i += NGT) ((GAS float*)(ws + WS_MISC))[i] = 8.0f * log1pf(expf(-((const GAS float*)a.in[15])[(size_t)l * D + i]));
}

__device__ __forceinline__ void ada_phase(const Frame& F, const Args& a) {
    LAS float* sc = (LAS float*)F.lds;
    LAS float* red = (LAS float*)(F.lds + 65536);
    bool loaded = false;
    for (int u = F.vcu; u < 4 * 96; u += F.G) {
        if (!loaded) { for (int i = F.tid; i < 16 * D; i += 512) { const int b = i >> 10, k = i & 1023; const float v = ((const GAS float*)a.in[1])[i]; sc[k * 16 + b] = v * fsigmoid(v); } loaded = true; __syncthreads(); }
        const int l = u / 96, j0 = (u % 96) * 64, jj = F.tid & 63, ks = F.tid >> 6;
        float acc[16];
#pragma unroll
        for (int b = 0; b < 16; ++b) acc[b] = 0.f;
        const GAS float* wp = ((const GAS float*)a.in[2]) + ((size_t)l * D + ks * 128) * NIN + j0 + jj;
#pragma unroll 4
        for (int k = 0; k < 128; ++k) { const float w = wp[(size_t)k * NIN]; const LAS f32x4* s4 = (const LAS f32x4*)(sc + (ks * 128 + k) * 16);
#pragma unroll
            for (int q = 0; q < 4; ++q) { const f32x4 sv = s4[q]; acc[4 * q] += sv[0] * w; acc[4 * q + 1] += sv[1] * w; acc[4 * q + 2] += sv[2] * w; acc[4 * q + 3] += sv[3] * w; } }
#pragma unroll
        for (int b = 0; b < 16; ++b) red[(ks * 16 + b) * 64 + jj] = acc[b];
        __syncthreads();
#pragma unroll
        for (int p = 0; p < 2; ++p) { const int o = F.tid + 512 * p, b = o >> 6, j = o & 63; float s = 0.f;
#pragma unroll
            for (int k2 = 0; k2 < 8; ++k2) s += red[(k2 * 16 + b) * 64 + j];
            ((GAS float*)(F.ws + WS_ADA))[((size_t)l * 16 + b) * NIN + j0 + j] = s + ((const GAS float*)a.in[3])[(size_t)l * NIN + j0 + j]; }
        __syncthreads();
    }
}

__device__ __forceinline__ void modulate0(const Frame& F, const Args& a) {
    const GAS float* ada = (const GAS float*)(F.ws + WS_ADA); GAS bf16_t* H = (GAS bf16_t*)(F.ws + WS_BIG);
    const size_t NG = (size_t)T * D / 8;
    for (size_t i = (size_t)F.vcu * 512 + F.tid; i < NG; i += (size_t)F.G * 512) {
        const size_t t = i >> 7; const int c = (int)(i & 127) * 8; const int b = (int)(t >> 12);
        const GAS float* xp = ((const GAS float*)a.in[0]) + t * D + c; const f32x4 x0 = *(const GAS f32x4*)xp, x1 = *(const GAS f32x4*)(xp + 4);
        const GAS float* sh = ada + (size_t)b * NIN + c; const f32x4 h0 = *(const GAS f32x4*)sh, h1 = *(const GAS f32x4*)(sh + 4), s0 = *(const GAS f32x4*)(sh + D), s1 = *(const GAS f32x4*)(sh + D + 4);
        const f32x4 r0 = x0 * (s0 + 1.0f) + h0, r1 = x1 * (s1 + 1.0f) + h1;
        u32x4 o; o.x = cvt_pk_bf16(r0[0], r0[1]); o.y = cvt_pk_bf16(r0[2], r0[3]); o.z = cvt_pk_bf16(r1[0], r1[1]); o.w = cvt_pk_bf16(r1[2], r1[3]);
        *(GAS u32x4*)(H + t * D + c) = o;
    }
}

__device__ __forceinline__ void unpack8(const u32x4 v, float (&f)[8]) { f[0] = bf_lo(v.x); f[1] = bf_hi(v.x); f[2] = bf_lo(v.y); f[3] = bf_hi(v.y); f[4] = bf_lo(v.z); f[5] = bf_hi(v.z); f[6] = bf_lo(v.w); f[7] = bf_hi(v.w); }
__device__ __forceinline__ u32x4 pack8(const float (&f)[8]) { u32x4 o; o.x = cvt_pk_bf16(f[0], f[1]); o.y = cvt_pk_bf16(f[2], f[3]); o.z = cvt_pk_bf16(f[4], f[5]); o.w = cvt_pk_bf16(f[6], f[7]); return o; }

__device__ __forceinline__ void vstats_phase(const Frame& F) {
    const GAS bf16_t* V = (const GAS bf16_t*)(F.ws + WS_BIG + 2 * BIGSZ); GAS f32x2* vs = (GAS f32x2*)(F.ws + WS_VSTAT);
    const int gw = F.vcu * NWAVES + F.wave, NGW = F.G * NWAVES;
    for (int row = gw; row < T; row += NGW) {
        const GAS bf16_t* rp = V + (size_t)row * D + 8 * F.lane; float f[16];
        { float t8[8]; unpack8(*(const GAS u32x4*)rp, t8);
#pragma unroll
          for (int j = 0; j < 8; ++j) f[j] = t8[j];
          unpack8(*(const GAS u32x4*)(rp + 512), t8);
#pragma unroll
          for (int j = 0; j < 8; ++j) f[8 + j] = t8[j]; }
        float s = 0.f;
#pragma unroll
        for (int j = 0; j < 16; ++j) s += f[j];
        const float mean = wave_sum(s) * (1.0f / D); float q = 0.f;
#pragma unroll
        for (int j = 0; j < 16; ++j) { const float d = f[j] - mean; q += d * d; }
        const float rstd = rsqrtf(wave_sum(q) * (1.0f / D) + LN_EPS);
        if (F.lane == 0) vs[row] = (f32x2){mean, rstd};
    }
}

__device__ __forceinline__ void rg_unit(const Frame& F, const Args& a, int l, int unit) {
    LAS unsigned char* lds = F.lds; const int tid = F.tid, lane = F.lane, wid = F.wave, wr = wid >> 2, wc = wid & 3, fr = lane & 15, fq = lane >> 4;
    const int hd = unit & 7, gc = unit >> 3, nch = gc & 31; const size_t t0 = (size_t)gc * 128;
    GAS unsigned char* ws = F.ws;
    const GAS bf16_t* RI = (const GAS bf16_t*)(ws + WS_BIG + 4 * BIGSZ);
    GAS bf16_t* HL = (GAS bf16_t*)(ws + WS_BIG); GAS bf16_t* CA = (GAS bf16_t*)(ws + WS_BIG + 7 * BIGSZ);
    LAS unsigned char* At = lds; LAS unsigned char* Wa = lds + 34816; LAS unsigned char* Wx = lds + 69632;
    const int cb = tid & 15, c0 = hd * 128 + cb * 8;
#pragma unroll
    for (int p = 0; p < 4; ++p) { const int row = (tid >> 4) + 32 * p;
        *(LAS u32x4*)(Wa + row * 272 + cb * 16) = *(const GAS u32x4*)((const GAS bf16_t*)(ws + W_RGA) + ((size_t)hd * 128 + row) * 128 + cb * 8);
        *(LAS u32x4*)(Wx + row * 272 + cb * 16) = *(const GAS u32x4*)((const GAS bf16_t*)(ws + W_RGX) + ((size_t)hd * 128 + row) * 128 + cb * 8); }
    {
        float cw[4][8], cbias[8];
#pragma unroll
        for (int k = 0; k < 4; ++k) { const GAS float* p = ((const GAS float*)a.in[9]) + ((size_t)l * 4 + k) * D + c0; const f32x4 w0 = *(const GAS f32x4*)p, w1 = *(const GAS f32x4*)(p + 4);
#pragma unroll
            for (int j = 0; j < 4; ++j) { cw[k][j] = w0[j]; cw[k][4 + j] = w1[j]; } }
        { const GAS float* p = ((const GAS float*)a.in[10]) + (size_t)l * D + c0; const f32x4 w0 = *(const GAS f32x4*)p, w1 = *(const GAS f32x4*)(p + 4);
#pragma unroll
          for (int j = 0; j < 4; ++j) { cbias[j] = w0[j]; cbias[4 + j] = w1[j]; } }
#pragma unroll
        for (int p = 0; p < 4; ++p) { const int t = (tid >> 4) + 32 * p; float r[8];
#pragma unroll
            for (int j = 0; j < 8; ++j) r[j] = cbias[j];
#pragma unroll
            for (int k = 0; k < 4; ++k) { const int tt = t - 3 + k;
                if (tt >= 0 || nch > 0) { float v[8]; unpack8(*(const GAS u32x4*)(RI + (size_t)((long)t0 + tt) * D + c0), v);
#pragma unroll
                    for (int j = 0; j < 8; ++j) r[j] += cw[k][j] * v[j]; } }
            *(LAS u32x4*)(At + t * 272 + cb * 16) = pack8(r); }
    }
    __syncthreads();
    f32x4 ga[4][2], gx[4][2];
#pragma unroll
    for (int m = 0; m < 4; ++m)
#pragma unroll
        for (int n = 0; n < 2; ++n) { ga[m][n] = (f32x4){0.f, 0.f, 0.f, 0.f}; gx[m][n] = (f32x4){0.f, 0.f, 0.f, 0.f}; }
#pragma unroll
    for (int kk = 0; kk < 4; ++kk) {
        bf16x8 af[4], ba[2], bx[2];
#pragma unroll
        for (int m = 0; m < 4; ++m) af[m] = *(const LAS bf16x8*)(At + (wr * 64 + m * 16 + fr) * 272 + (kk * 32 + fq * 8) * 2);
#pragma unroll
        for (int n = 0; n < 2; ++n) { ba[n] = *(const LAS bf16x8*)(Wa + (wc * 32 + n * 16 + fr) * 272 + (kk * 32 + fq * 8) * 2); bx[n] = *(const LAS bf16x8*)(Wx + (wc * 32 + n * 16 + fr) * 272 + (kk * 32 + fq * 8) * 2); }
#pragma unroll
        for (int m = 0; m < 4; ++m)
#pragma unroll
            for (int n = 0; n < 2; ++n) { ga[m][n] = __builtin_amdgcn_mfma_f32_16x16x32_bf16(ba[n], af[m], ga[m][n], 0, 0, 0); gx[m][n] = __builtin_amdgcn_mfma_f32_16x16x32_bf16(bx[n], af[m], gx[m][n], 0, 0, 0); }
    }
#pragma unroll
    for (int n = 0; n < 2; ++n) { const int j0 = wc * 32 + n * 16 + 4 * fq, c = hd * 128 + j0;
        const f32x4 bav = *(const GAS f32x4*)(((const GAS float*)a.in[12]) + (size_t)l * D + c), bxv = *(const GAS f32x4*)(((const GAS float*)a.in[14]) + (size_t)l * D + c), spv = *(const GAS f32x4*)((const GAS float*)(ws + WS_MISC) + c);
#pragma unroll
        for (int m = 0; m < 4; ++m) { const int t = wr * 64 + m * 16 + fr; const u32x2 rv = *(const LAS u32x2*)(At + t * 272 + j0 * 2);
            const float rin[4] = {bf_lo(rv.x), bf_hi(rv.x), bf_lo(rv.y), bf_hi(rv.y)};
#pragma unroll
            for (int r = 0; r < 4; ++r) { const float rg = fsigmoid(ga[m][n][r] + bav[r]), ig = fsigmoid(gx[m][n][r] + bxv[r]);
                const float la = -spv[r] * rg, av = __builtin_amdgcn_exp2f(la * LOG2E), x2 = 2.0f * la;
                const float om = (x2 > -0.25f) ? -(x2 * (1.0f + x2 * (0.5f + x2 * (0.16666667f + x2 * (0.041666668f + x2 * 0.0083333333f))))) : (1.0f - av * av);
                ga[m][n][r] = av; gx[m][n][r] = sqrtf(fmaxf(om, 0.f)) * ig * rin[r]; } } }
    __syncthreads();
    LAS float* PA = (LAS float*)lds; LAS float* PI = (LAS float*)(lds + 67584);
#pragma unroll
    for (int m = 0; m < 4; ++m)
#pragma unroll
        for (int n = 0; n < 2; ++n) { const int t = wr * 64 + m * 16 + fr, j0 = wc * 32 + n * 16 + 4 * fq; *(LAS f32x4*)(PA + t * 132 + j0) = ga[m][n]; *(LAS f32x4*)(PI + t * 132 + j0) = gx[m][n]; }
    __syncthreads();
    LAS f32x2* SE = (LAS f32x2*)(lds + 135168); LAS f32x2* CR = (LAS f32x2*)(lds + 135168 + 4096);
    const int c = tid & 127, seg = tid >> 7; float h = 0.f, cum = 1.f;
#pragma unroll 8
    for (int tt = 0; tt < 32; ++tt) { const int t = seg * 32 + tt; const float av = PA[t * 132 + c], xv = PI[t * 132 + c]; h = av * h + xv; cum *= av; PI[t * 132 + c] = h; PA[t * 132 + c] = cum; }
    SE[seg * 128 + c] = (f32x2){cum, h};
    __syncthreads();
    { float ch = 0.f, cc = 1.f;
      for (int s = 0; s < seg; ++s) { const f32x2 e = SE[s * 128 + c]; ch = e.x * ch + e.y; cc *= e.x; }
      CR[seg * 128 + c] = (f32x2){cc, ch};
      if (seg == 3) { GAS float* cr = (GAS float*)(ws + WS_CARRY) + (size_t)gc * 2 * D + hd * 128 + c; cr[0] = cum * cc; cr[D] = h + cum * ch; } }
    __syncthreads();
#pragma unroll
    for (int p = 0; p < 4; ++p) { const int t = (tid >> 4) + 32 * p, sg = t >> 5; float oh[8], oc[8];
#pragma unroll
        for (int j = 0; j < 8; ++j) { const float cu = PA[t * 132 + cb * 8 + j], hv = PI[t * 132 + cb * 8 + j]; const f32x2 cr = CR[sg * 128 + cb * 8 + j]; oh[j] = hv + cu * cr.y; oc[j] = cu * cr.x; }
        *(GAS u32x4*)(HL + (t0 + t) * D + c0) = pack8(oh); *(GAS u32x4*)(CA + (t0 + t) * D + c0) = pack8(oc); }
    __syncthreads();
}

__device__ __forceinline__ void sgu_unit(const Frame& F, const Args& a, int l, int unit) {
    LAS unsigned char* lds = F.lds; const int tid = F.tid, lane = F.lane, wid = F.wave, wr = wid >> 2, wc = wid & 3, fr = lane & 15, fq = lane >> 4;
    const int g = unit & 7, gc = unit >> 3; const size_t t0 = (size_t)gc * 128;
    GAS unsigned char* ws = F.ws;
    GAS bf16_t* U = (GAS bf16_t*)(ws + WS_BIG + 1 * BIGSZ); const GAS bf16_t* V = (const GAS bf16_t*)(ws + WS_BIG + 2 * BIGSZ); const GAS f32x2* vs = (const GAS f32x2*)(ws + WS_VSTAT);
    LAS unsigned char* Wt = lds; LAS unsigned char* Vs = lds + 34816;
    const int cb = tid & 15, c0 = g * 128 + cb * 8;
    float gam[8], bet[8];
    { const GAS float* p = ((const GAS float*)a.in[5]) + (size_t)l * D + c0; const f32x4 w0 = *(const GAS f32x4*)p, w1 = *(const GAS f32x4*)(p + 4); const GAS float* q = ((const GAS float*)a.in[6]) + (size_t)l * D + c0; const f32x4 b0 = *(const GAS f32x4*)q, b1 = *(const GAS f32x4*)(q + 4);
#pragma unroll
      for (int j = 0; j < 4; ++j) { gam[j] = w0[j]; gam[4 + j] = w1[j]; bet[j] = b0[j]; bet[4 + j] = b1[j]; } }
#pragma unroll
    for (int p = 0; p < 4; ++p) { const int row = (tid >> 4) + 32 * p;
        *(LAS u32x4*)(Wt + row * 272 + cb * 16) = *(const GAS u32x4*)((const GAS bf16_t*)(ws + W_SG) + ((size_t)g * 128 + row) * 128 + cb * 8);
        float v[8]; unpack8(*(const GAS u32x4*)(V + (t0 + row) * D + c0), v); const f32x2 st = vs[t0 + row];
#pragma unroll
        for (int j = 0; j < 8; ++j) v[j] = (v[j] - st.x) * st.y * gam[j] + bet[j];
        const u32x4 o = pack8(v); *(LAS u32x2*)(Vs + row * 264 + cb * 16) = (u32x2){o.x, o.y}; *(LAS u32x2*)(Vs + row * 264 + cb * 16 + 8) = (u32x2){o.z, o.w}; }
    __syncthreads();
    f32x4 acc[4][2];
#pragma unroll
    for (int m = 0; m < 4; ++m)
#pragma unroll
        for (int n = 0; n < 2; ++n) acc[m][n] = (f32x4){0.f, 0.f, 0.f, 0.f};
#pragma unroll
    for (int kk = 0; kk < 4; ++kk) {
        bf16x8 af[4], bfr[2];
#pragma unroll
        for (int m = 0; m < 4; ++m) af[m] = *(const LAS bf16x8*)(Wt + (wr * 64 + m * 16 + fr) * 272 + (kk * 32 + fq * 8) * 2);
#pragma unroll
        for (int n = 0; n < 2; ++n) { const int cc = wc * 32 + n * 16 + fr;
#pragma unroll
            for (int e = 0; e < 8; ++e) bfr[n][e] = (short)*(const LAS unsigned short*)(Vs + (kk * 32 + fq * 8 + e) * 264 + cc * 2); }
#pragma unroll
        for (int m = 0; m < 4; ++m)
#pragma unroll
            for (int n = 0; n < 2; ++n) acc[m][n] = __builtin_amdgcn_mfma_f32_16x16x32_bf16(bfr[n], af[m], acc[m][n], 0, 0, 0);
    }
#pragma unroll
    for (int m = 0; m < 4; ++m) { const int t = wr * 64 + m * 16 + fr; const float bs = ((const GAS float*)a.in[8])[((size_t)l * 8 + g) * 128 + t];
#pragma unroll
        for (int n = 0; n < 2; ++n) { GAS bf16_t* up = U + (t0 + t) * D + g * 128 + wc * 32 + n * 16 + 4 * fq; const u32x2 uv = *(const GAS u32x2*)up;
            u32x2 o; o.x = cvt_pk_bf16(bf_lo(uv.x) * (acc[m][n][0] + bs), bf_hi(uv.x) * (acc[m][n][1] + bs)); o.y = cvt_pk_bf16(bf_lo(uv.y) * (acc[m][n][2] + bs), bf_hi(uv.y) * (acc[m][n][3] + bs));
            *(GAS u32x2*)up = o; } }
    __syncthreads();
}

__device__ __forceinline__ void scanfix_unit(const Frame& F, int gc) {
    GAS unsigned char* ws = F.ws; const int tid = F.tid;
    GAS bf16_t* RG = (GAS bf16_t*)(ws + WS_BIG + 3 * BIGSZ); const GAS bf16_t* HL = (const GAS bf16_t*)(ws + WS_BIG); const GAS bf16_t* CA = (const GAS bf16_t*)(ws + WS_BIG + 7 * BIGSZ);
    LAS float* hin = (LAS float*)F.lds;
    const int nch = gc & 31, cbk = tid & 127, tseg = tid >> 7;
    if (tseg == 0) { float h[8];
#pragma unroll
        for (int j = 0; j < 8; ++j) h[j] = 0.f;
        const GAS float* cr = (const GAS float*)(ws + WS_CARRY) + (size_t)(gc - nch) * 2 * D + cbk * 8;
        for (int n = 0; n < nch; ++n) { const f32x4 p0 = *(const GAS f32x4*)(cr + (size_t)n * 2 * D), p1 = *(const GAS f32x4*)(cr + (size_t)n * 2 * D + 4), h0 = *(const GAS f32x4*)(cr + (size_t)n * 2 * D + D), h1 = *(const GAS f32x4*)(cr + (size_t)n * 2 * D + D + 4);
#pragma unroll
            for (int j = 0; j < 4; ++j) { h[j] = p0[j] * h[j] + h0[j]; h[4 + j] = p1[j] * h[4 + j] + h1[j]; } }
#pragma unroll
        for (int j = 0; j < 8; ++j) hin[cbk * 8 + j] = h[j]; }
    __syncthreads();
    float hi[8];
#pragma unroll
    for (int j = 0; j < 8; ++j) hi[j] = hin[cbk * 8 + j];
    const size_t base = ((size_t)gc * 128 + tseg * 32) * D + cbk * 8;
#pragma unroll 4
    for (int tt = 0; tt < 32; ++tt) { const size_t o = base + (size_t)tt * D; float g[8], hl[8], ca[8];
        unpack8(*(const GAS u32x4*)(RG + o), g); unpack8(*(const GAS u32x4*)(HL + o), hl); unpack8(*(const GAS u32x4*)(CA + o), ca);
#pragma unroll
        for (int j = 0; j < 8; ++j) g[j] = g[j] * (hl[j] + ca[j] * hi[j]);
        *(GAS u32x4*)(RG + o) = pack8(g); }
    __syncthreads();
}

__device__ __forceinline__ void ln1_route_unit(const Frame& F, const Args& a, int l, int unit) {
    LAS unsigned char* lds = F.lds; const int tid = F.tid, lane = F.lane, wid = F.wave, fr = lane & 15, fq = lane >> 4;
    GAS unsigned char* ws = F.ws;
    const int r0 = unit * 128, b = r0 >> 12, slab = r0 >> 15;
    LAS float* VEC = (LAS float*)lds;
    LAS float* LG = (LAS float*)(lds + 16384);
    LAS float* BS = (LAS float*)(lds + 16384 + 33280);
    LAS float* RB = (LAS float*)(lds + 82944);
    LAS int* LCNT = (LAS int*)(lds + 83200);
    LAS int* GBS = (LAS int*)(lds + 83456);
    LAS int* AE = (LAS int*)(lds + 83712);
    LAS int* AR = (LAS int*)(lds + 87808);
    LAS float* AW = (LAS float*)(lds + 91904);
    const GAS float* ada = (const GAS float*)(ws + WS_ADA) + ((size_t)l * 16 + b) * NIN;
    for (int i = tid; i < D; i += 512) { VEC[i] = ((const GAS float*)a.in[19])[(size_t)l * D + i]; VEC[D + i] = ((const GAS float*)a.in[20])[(size_t)l * D + i]; VEC[2 * D + i] = 1.0f + ada[4 * D + i]; VEC[3 * D + i] = ada[3 * D + i]; }
    if (tid < 64) { RB[tid] = ((const GAS float*)a.in[22])[(size_t)l * 64 + tid]; LCNT[tid] = 0; }
    __syncthreads();
    GAS float* X = (GAS float*)a.out; GAS bf16_t* H = (GAS bf16_t*)(ws + WS_BIG);
    const int row = r0 + wid * 16 + fr;
    float mean, rstd;
    { const GAS f32x4* ps = (const GAS f32x4*)((const GAS float*)(ws + WS_PSTAT) + (size_t)row * 32) + 2 * fq; const f32x4 p0 = ps[0], p1 = ps[1];
      float s = (p0[0] + p0[2]) + (p1[0] + p1[2]), q = (p0[1] + p0[3]) + (p1[1] + p1[3]);
      s += __shfl_xor(s, 16); s += __shfl_xor(s, 32); q += __shfl_xor(q, 16); q += __shfl_xor(q, 32);
      mean = s * (1.0f / D); const float var = fmaxf(q * (1.0f / D) - mean * mean, 0.f); rstd = rsqrtf(var + LN_EPS); }
    f32x4 acc[4];
#pragma unroll
    for (int n = 0; n < 4; ++n) acc[n] = (f32x4){0.f, 0.f, 0.f, 0.f};
    const GAS bf16_t* RH = (const GAS bf16_t*)(ws + W_RH); const GAS bf16_t* RL = (const GAS bf16_t*)(ws + W_RL);
#pragma unroll 2
    for (int kk = 0; kk < 32; ++kk) { const int c = kk * 32 + fq * 8; GAS float* xp = X + (size_t)row * D + c;
        const f32x4 x0 = *(const GAS f32x4*)xp, x1 = *(const GAS f32x4*)(xp + 4);
        const f32x4 g0 = *(const LAS f32x4*)(VEC + c), g1 = *(const LAS f32x4*)(VEC + c + 4), b0 = *(const LAS f32x4*)(VEC + D + c), b1 = *(const LAS f32x4*)(VEC + D + c + 4);
        const f32x4 s0 = *(const LAS f32x4*)(VEC + 2 * D + c), s1 = *(const LAS f32x4*)(VEC + 2 * D + c + 4), h0 = *(const LAS f32x4*)(VEC + 3 * D + c), h1 = *(const LAS f32x4*)(VEC + 3 * D + c + 4);
        const f32x4 n0 = (x0 - mean) * rstd * g0 + b0, n1 = (x1 - mean) * rstd * g1 + b1;
        *(GAS f32x4*)xp = n0; *(GAS f32x4*)(xp + 4) = n1;
        const f32x4 f0 = n0 * s0 + h0, f1 = n1 * s1 + h1;
        u32x4 hi; hi.x = cvt_pk_bf16(f0[0], f0[1]); hi.y = cvt_pk_bf16(f0[2], f0[3]); hi.z = cvt_pk_bf16(f1[0], f1[1]); hi.w = cvt_pk_bf16(f1[2], f1[3]);
        *(GAS u32x4*)(H + (size_t)row * D + c) = hi;
        u32x4 lo; lo.x = cvt_pk_bf16(f0[0] - bf_lo(hi.x), f0[1] - bf_hi(hi.x)); lo.y = cvt_pk_bf16(f0[2] - bf_lo(hi.y), f0[3] - bf_hi(hi.y));
        lo.z = cvt_pk_bf16(f1[0] - bf_lo(hi.z), f1[1] - bf_hi(hi.z)); lo.w = cvt_pk_bf16(f1[2] - bf_lo(hi.w), f1[3] - bf_hi(hi.w));
        const bf16x8 ah = __builtin_bit_cast(bf16x8, hi), al = __builtin_bit_cast(bf16x8, lo);
#pragma unroll
        for (int n = 0; n < 4; ++n) { const bf16x8 bh = *(const GAS bf16x8*)(RH + (size_t)(n * 16 + fr) * D + c), bl = *(const GAS bf16x8*)(RL + (size_t)(n * 16 + fr) * D + c);
            acc[n] = __builtin_amdgcn_mfma_f32_16x16x32_bf16(bh, ah, acc[n], 0, 0, 0);
            acc[n] = __builtin_amdgcn_mfma_f32_16x16x32_bf16(bl, ah, acc[n], 0, 0, 0);
            acc[n] = __builtin_amdgcn_mfma_f32_16x16x32_bf16(bh, al, acc[n], 0, 0, 0); } }
#pragma unroll
    for (int n = 0; n < 4; ++n)
#pragma unroll
        for (int r = 0; r < 4; ++r) LG[(wid * 16 + fr) * 65 + n * 16 + 4 * fq + r] = acc[n][r];
    LDS_WAIT(); asm volatile("" ::: "memory");
    if (lane < 16) {
        const int tokl = wid * 16 + lane; LAS float* lg = LG + tokl * 65; LAS float* bs = BS + tokl * 65;
        float gs[8];
#pragma unroll
        for (int g = 0; g < 8; ++g) { float m1 = -INFINITY, m2 = -INFINITY;
#pragma unroll
            for (int j = 0; j < 8; ++j) { const int e = g * 8 + j; const float v = fsigmoid(lg[e]) + RB[e]; bs[e] = v; if (v > m1) { m2 = m1; m1 = v; } else if (v > m2) m2 = v; }
            gs[g] = m1 + m2; }
        unsigned keep = 0u;
#pragma unroll
        for (int it = 0; it < 4; ++it) { float best = -INFINITY; int bi = 0;
#pragma unroll
            for (int g = 0; g < 8; ++g) { const bool ok = !((keep >> g) & 1u) && (gs[g] > best); best = ok ? gs[g] : best; bi = ok ? g : bi; }
            keep |= 1u << bi; }
        unsigned long long taken = 0ull; float ssum = 0.f;
        for (int k = 0; k < 8; ++k) { float best = -INFINITY; int bi = 0;
            for (int g = 0; g < 8; ++g) { if ((keep >> g) & 1u) {
#pragma unroll
                for (int j = 0; j < 8; ++j) { const int e = g * 8 + j; const float v = bs[e]; const bool ok = !((taken >> e) & 1ull) && (v > best); best = ok ? v : best; bi = ok ? e : bi; } } }
            taken |= 1ull << bi; const float sc = fsigmoid(lg[bi]); ssum += sc; AE[tokl * 8 + k] = bi; AW[tokl * 8 + k] = sc; }
        const float inv = 2.5f / ssum;
        for (int k = 0; k < 8; ++k) { const int e = AE[tokl * 8 + k]; AW[tokl * 8 + k] *= inv; AR[tokl * 8 + k] = __hip_atomic_fetch_add(LCNT + e, 1, __ATOMIC_RELAXED, __HIP_MEMORY_SCOPE_WORKGROUP); }
    }
    __syncthreads();
    if (tid < 64) { const int cl = LCNT[tid]; int base = 0;
        if (cl > 0) base = (int)__hip_atomic_fetch_add((GAS unsigned*)(ws + WS_CTL) + CW_CNT + (l * 2 + slab) * 64 + tid, (unsigned)cl, __ATOMIC_RELAXED, __HIP_MEMORY_SCOPE_AGENT);
        GBS[tid] = base; }
    __syncthreads();
#pragma unroll
    for (int p = 0; p < 2; ++p) { const int i = tid + 512 * p, tokl = i >> 3; const int e = AE[i], pos = GBS[e] + AR[i]; const int t = r0 + tokl;
        ((GAS unsigned*)(ws + WS_TOKE))[((size_t)slab * 64 + e) * ECAP + pos] = (unsigned)(t - slab * SLAB_T);
        ((GAS float*)(ws + WS_WTE))[((size_t)slab * 64 + e) * ECAP + pos] = AW[i];
        ((GAS unsigned*)(ws + WS_POS))[(size_t)t * 8 + (i & 7)] = ((unsigned)e << 16) | (unsigned)pos; }
    __syncthreads();
}

__device__ __forceinline__ int moe_setup(const Frame& F, int l, int slab) {
    LAS int* TB = (LAS int*)(F.lds + L_TBASE); LAS int* CN = (LAS int*)(F.lds + L_CNT); LAS unsigned short* TM = (LAS unsigned short*)(F.lds + L_TMAP);
    __syncthreads();
    if (F.wave == 0) {
        const int e = F.lane; const int cnt = (int)__hip_atomic_load((GAS unsigned*)(F.ws + WS_CTL) + CW_CNT + (l * 2 + slab) * 64 + e, __ATOMIC_RELAXED, __HIP_MEMORY_SCOPE_AGENT);
        const int ntl = (cnt + 255) >> 8; int incl = ntl;
#pragma unroll
        for (int o = 1; o < 64; o <<= 1) { const int v = __shfl_up(incl, o); if (e >= o) incl += v; }
        const int excl = incl - ntl; TB[e] = excl; CN[e] = cnt;
        const int total = __shfl(incl, 63);
        if (e == 0) { TB[64] = total; TB[65] = total + SLAB_T / 256; CN[64] = SLAB_T; }
        for (int i = excl; i < incl; ++i) TM[i] = (unsigned short)e;
        for (int i = e; i < SLAB_T / 256; i += 64) TM[total + i] = (unsigned short)64;
    }
    __syncthreads();
    return TB[65];
}

__device__ __forceinline__ void combine_phase(const Frame& F, const Args& a, int l, int slab) {
    GAS unsigned char* ws = F.ws; const LAS int* TB = (const LAS int*)(F.lds + L_TBASE);
    const GAS bf16_t* Y = (const GAS bf16_t*)(ws + WS_BIG + 3 * BIGSZ); GAS float* X = (GAS float*)a.out; GAS bf16_t* H = (GAS bf16_t*)(ws + WS_BIG);
    const int gw = F.vcu * NWAVES + F.wave; const int tl0 = gw * 16; if (tl0 >= SLAB_T) return;
    const int b = (slab * SLAB_T + tl0) >> 12; const int cl = 4 * F.lane;
    const GAS float* ada = (const GAS float*)(ws + WS_ADA) + ((size_t)l * 16 + b) * NIN;
    const GAS float* adan = (const GAS float*)(ws + WS_ADA) + ((size_t)(l < DEPTH - 1 ? l + 1 : l) * 16 + b) * NIN;
    f32x4 g2[4], gm[4], bt[4], sc[4], sh[4];
#pragma unroll
    for (int j = 0; j < 4; ++j) { const int c = cl + 256 * j; g2[j] = *(const GAS f32x4*)(ada + 5 * D + c); gm[j] = *(const GAS f32x4*)(((const GAS float*)a.in[29]) + (size_t)l * D + c); bt[j] = *(const GAS f32x4*)(((const GAS float*)a.in[30]) + (size_t)l * D + c);
        sc[j] = *(const GAS f32x4*)(adan + D + c) + 1.0f; sh[j] = *(const GAS f32x4*)(adan + c); }
    const int shbase = TB[64] * 256;
    for (int i = 0; i < 16; ++i) { const int tl = tl0 + i; const size_t t = (size_t)slab * SLAB_T + tl;
        f32x4 acc[4];
#pragma unroll
        for (int j = 0; j < 4; ++j) acc[j] = (f32x4){0.f, 0.f, 0.f, 0.f};
        const GAS unsigned* pp = (const GAS unsigned*)(ws + WS_POS) + t * 8;
#pragma unroll
        for (int k = 0; k < 9; ++k) { size_t rowi;
            if (k < 8) { const unsigned pk = (unsigned)__builtin_amdgcn_readfirstlane((int)pp[k]); rowi = (size_t)TB[pk >> 16] * 256 + (pk & 0xffffu); } else rowi = (size_t)shbase + tl;
            const GAS bf16_t* yp = Y + rowi * D + cl;
#pragma unroll
            for (int j = 0; j < 4; ++j) { const u32x2 v = *(const GAS u32x2*)(yp + 256 * j); acc[j] += (f32x4){bf_lo(v.x), bf_hi(v.x), bf_lo(v.y), bf_hi(v.y)}; } }
        f32x4 pre[4]; float s = 0.f;
#pragma unroll
        for (int j = 0; j < 4; ++j) { const f32x4 xv = *(const GAS f32x4*)(X + t * D + cl + 256 * j); pre[j] = xv * ALPHA + g2[j] * acc[j]; s += (pre[j][0] + pre[j][1]) + (pre[j][2] + pre[j][3]); }
        const float mean = wave_sum(s) * (1.0f / D); float q = 0.f;
#pragma unroll
        for (int j = 0; j < 4; ++j) { pre[j] = pre[j] - mean; q += (pre[j][0] * pre[j][0] + pre[j][1] * pre[j][1]) + (pre[j][2] * pre[j][2] + pre[j][3] * pre[j][3]); }
        const float rstd = rsqrtf(wave_sum(q) * (1.0f / D) + LN_EPS);
#pragma unroll
        for (int j = 0; j < 4; ++j) { const f32x4 xn = pre[j] * rstd * gm[j] + bt[j]; *(GAS f32x4*)(X + t * D + cl + 256 * j) = xn;
            if (l < DEPTH - 1) { const f32x4 hn = xn * sc[j] + sh[j]; u32x2 o; o.x = cvt_pk_bf16(hn[0], hn[1]); o.y = cvt_pk_bf16(hn[2], hn[3]); *(GAS u32x2*)(H + t * D + cl + 256 * j) = o; } }
    }
}

template <class Tp> __device__ __forceinline__ Tp* launder(Tp* p) { asm volatile("" : "+s"(p)); return p; }
#define IN(p) (lo <= (p) && (p) < hi)
#ifndef PH_MASK
#define PH_MASK 0xffff
#endif
#define PHM(k) ((PH_MASK >> (k)) & 1)
#define RELAUNDER() do { ws = launder(ws); F.ws = ws; { int _t = F.tid; asm volatile("" : "+v"(_t)); F.tid = _t; F.lane = _t & 63; F.wave = __builtin_amdgcn_readfirstlane(_t >> 6); } asm volatile("" : "+s"(F.vcu), "+s"(F.G), "+s"(bx)); } while (0)
#define SEAM(p) do { if (IN(p) && IN((p) + 1)) xcd_barrier(bar); } while (0)
template <int l> __device__ __forceinline__ void layer_body(Frame& F, const Args& args, const XcdBarrier& bar, GAS unsigned char*& ws, const int lo, const int hi, int& bx) {
        const int pb = 2 + 12 * l;
        if (PHM(2) && IN(pb + 0)) {
            RELAUNDER();
            pg8::ProbPlain P{(const GAS char*)(ws + WS_BIG), (const GAS char*)(ws + W_IN), D}; pg8::SchedStatic S{T / 256, NIN / 256, F.G, bx};
            pg8::EpiZ E{(GAS bf16_t*)(ws + WS_BIG + 1 * BIGSZ)};
            pg8::gemm_phase(F.lds, F.tid, P, S, E);
        }
        SEAM(pb + 0);
        if (PHM(3) && IN(pb + 1)) {
            RELAUNDER();
            for (int u = F.vcu; u < 512 * 8; u += F.G) rg_unit(F, args, l, u);
            vstats_phase(F);
        }
        SEAM(pb + 1);
        if (PHM(4) && IN(pb + 2)) {
            RELAUNDER();
            for (int u = F.vcu; u < 512 * 8; u += F.G) sgu_unit(F, args, l, u);
            for (int u = F.vcu; u < 512; u += F.G) scanfix_unit(F, u);
        }
        SEAM(pb + 2);
        if (PHM(5) && IN(pb + 3)) {
            RELAUNDER();
            pg8::ProbPair P{(const GAS char*)(ws + WS_BIG + 1 * BIGSZ), (const GAS char*)(ws + WS_BIG + 3 * BIGSZ), (const GAS char*)(ws + W_A), (const GAS char*)(ws + W_B), D};
            pg8::SchedPair S{T / 256, D / 256, F.G, bx};
            pg8::EpiPair E{(GAS bf16_t*)(ws + WS_BIG + 5 * BIGSZ), (const GAS bf16_t*)(ws + WS_BIG + 6 * BIGSZ)};
            pg8::gemm_phase(F.lds, F.tid, P, S, E);
        }
        SEAM(pb + 3);
        if (PHM(6) && IN(pb + 4)) {
            RELAUNDER();
            pg8::ProbPlain P{(const GAS char*)(ws + WS_BIG + 5 * BIGSZ), (const GAS char*)(ws + W_O), D}; pg8::SchedStatic S{T / 256, D / 256, F.G, bx};
            pg8::EpiOut E{l == 0 ? ((const GAS float*)args.in[0]) : (const GAS float*)args.out, (GAS float*)args.out, (const GAS float*)(ws + WS_ADA) + (size_t)l * 16 * NIN, (GAS float*)(ws + WS_PSTAT)};
            pg8::gemm_phase(F.lds, F.tid, P, S, E);
        }
        SEAM(pb + 4);
        if (PHM(7) && IN(pb + 5)) { RELAUNDER(); for (int u = F.vcu; u < T / 128; u += F.G) ln1_route_unit(F, args, l, u); }
        SEAM(pb + 5);
#pragma unroll
        for (int s = 0; s < 2; ++s) {
            const int ps = pb + 6 + 3 * s;
            int ntiles = 0;
            RELAUNDER();
            if (IN(ps) || IN(ps + 1) || IN(ps + 2)) ntiles = moe_setup(F, l, s);
            GAS bf16_t* hid = (GAS bf16_t*)(ws + WS_BIG + 1 * BIGSZ); GAS bf16_t* yb = (GAS bf16_t*)(ws + WS_BIG + 3 * BIGSZ);
            const LAS int* CN = (const LAS int*)(F.lds + L_CNT); const LAS int* TB = (const LAS int*)(F.lds + L_TBASE); const LAS unsigned short* TM = (const LAS unsigned short*)(F.lds + L_TMAP);
            if (PHM(8) && IN(ps)) {
                RELAUNDER();
                pg8::ProbMoe1 P{(const GAS char*)(ws + WS_BIG) + (size_t)s * SLAB_T * D * 2, (const GAS char*)(ws + W_E13), (const GAS unsigned*)(ws + WS_TOKE) + (size_t)s * 64 * ECAP, CN, D};
                pg8::SchedMoe<2> S{ntiles, F.G, F.vcu, TM, TB};
                pg8::EpiMoe1 E{hid, (const GAS float*)(ws + WS_WTE) + (size_t)s * 64 * ECAP, CN};
                pg8::gemm_phase(F.lds, F.tid, P, S, E);
            }
            SEAM(ps);
            if (PHM(9) && IN(ps + 1)) {
                RELAUNDER();
                pg8::ProbMoe2 P{(const GAS char*)hid, (const GAS char*)(ws + W_E2), DE};
                pg8::SchedMoe<4> S{ntiles, F.G, F.vcu, TM, TB};
                pg8::EpiMoe2 E{yb};
                pg8::gemm_phase(F.lds, F.tid, P, S, E);
            }
            SEAM(ps + 1);
            if (PHM(10) && IN(ps + 2)) {
                RELAUNDER();
                combine_phase(F, args, l, s);
                if (s == 1 && l < DEPTH - 1) { __syncthreads(); convert_layer(F, args, l + 1); }
            }
            if (ps + 2 < NPH - 1) SEAM(ps + 2);
        }
}
__global__ void __launch_bounds__(512, 2) mk_fwd(Args args) {
    extern __shared__ __attribute__((aligned(16))) unsigned char lds_raw[];
    Frame F;
    F.lds = (LAS unsigned char*)lds_raw; F.tid = threadIdx.x; F.lane = F.tid & 63; F.wave = __builtin_amdgcn_readfirstlane(F.tid >> 6);
    F.G = gridDim.x; { const int bx = blockIdx.x; F.vcu = (F.G % 8 == 0) ? (bx % 8) * (F.G / 8) + bx / 8 : bx; }
    F.ws = (GAS unsigned char*)args.ws;
    GAS unsigned char* ws = (GAS unsigned char*)args.ws;
    volatile LAS unsigned* MISC = (volatile LAS unsigned*)(F.lds + L_MISC);
    if (F.tid < 32) MISC[F.tid] = 0u;
    __syncthreads();
    XcdBarrier bar = xcd_barrier_post((GAS unsigned*)(ws + WS_CTL) + CW_BAR, MISC + 8);
    const int lo = args.ph_lo, hi = args.ph_hi;
    int bx = (int)blockIdx.x;

    if (PHM(0) && IN(0)) { RELAUNDER(); ada_phase(F, args); __syncthreads(); convert_layer(F, args, 0); }
    SEAM(0);
    if (PHM(1) && IN(1)) { RELAUNDER(); modulate0(F, args); }
    SEAM(1);

    layer_body<0>(F, args, bar, ws, lo, hi, bx); layer_body<1>(F, args, bar, ws, lo, hi, bx); layer_body<2>(F, args, bar, ws, lo, hi, bx); layer_body<3>(F, args, bar, ws, lo, hi, bx);
#undef IN
#undef SEAM
}

extern "C" void kernel_launch(void* const* d_in, const int* in_sizes, int n_in, void* d_out, int out_size, void* d_ws, size_t ws_size, hipStream_t stream) {
    static int grid = 0;
    if (grid == 0) {
        if (n_in != 31 || out_size != T * D || ws_size < WS_END) { fprintf(stderr, "kernel_launch: unexpected shapes (n_in %d, out %d, ws %zu < %zu)\n", n_in, out_size, ws_size, (size_t)WS_END); grid = -1; return; }
        int dev = 0, cus = 0, per_cu = 0;
        if (hipGetDevice(&dev) != hipSuccess || hipDeviceGetAttribute(&cus, hipDeviceAttributeMultiprocessorCount, dev) != hipSuccess) { grid = -1; return; }
        if (hipFuncSetAttribute((const void*)mk_fwd, hipFuncAttributeMaxDynamicSharedMemorySize, LDS_BYTES) != hipSuccess) { fprintf(stderr, "kernel_launch: hipFuncSetAttribute failed\n"); grid = -1; return; }
        if (hipOccupancyMaxActiveBlocksPerMultiprocessor(&per_cu, (const void*)mk_fwd, 512, LDS_BYTES) != hipSuccess || per_cu < 1) { fprintf(stderr, "kernel_launch: occupancy query says %d\n", per_cu); }
        (void)hipGetLastError();
        grid = cus;
    }
    if (grid < 0) return;
    (void)in_sizes;
    hipMemsetAsync((char*)d_ws + WS_CTL, 0, CTL_BYTES, stream);
    Args a{};
    for (int i = 0; i < 31; ++i) a.in[i] = (const float*)d_in[i];
    a.out = (float*)d_out; a.ws = (unsigned char*)d_ws;
#if MK_MULTI
    for (int p = 0; p < NPH; ++p) { a.ph_lo = p; a.ph_hi = p + 1; hipLaunchKernelGGL(mk_fwd, dim3(grid), dim3(512), LDS_BYTES, stream, a); }
#else
    a.ph_lo = 0; a.ph_hi = NPH;
    hipLaunchKernelGGL(mk_fwd, dim3(grid), dim3(512), LDS_BYTES, stream, a);
#endif
}
```

```cpp
#include <hip/hip_runtime.h>
#include <cstdio>
#include <cstdint>

#ifndef MFMA_SCALED
#define MFMA_SCALED 0
#endif
#ifndef MK_MULTI
#define MK_MULTI 0
#endif

#define GAS __attribute__((address_space(1)))
#define LAS __attribute__((address_space(3)))
typedef unsigned short bf16_t;
typedef short bf16x8 __attribute__((ext_vector_type(8)));
typedef float f32x4 __attribute__((ext_vector_type(4)));
typedef float f32x2 __attribute__((ext_vector_type(2)));
typedef unsigned u32x4 __attribute__((ext_vector_type(4)));
typedef unsigned u32x2 __attribute__((ext_vector_type(2)));
typedef int i32x4 __attribute__((ext_vector_type(4)));
typedef int i32x8 __attribute__((ext_vector_type(8)));

constexpr int D = 1024, BATCH = 16, SEQ = 4096, T = BATCH * SEQ, DEPTH = 4;
constexpr int NIN = 6144, NE = 64, DE = 256;
constexpr int NSLAB = 1, SLAB_T = T / NSLAB;
constexpr int ECAP = SLAB_T;
constexpr float LN_EPS = 1e-5f;
constexpr float ALPHA = 1.6817928305074290f;
constexpr float LOG2E = 1.4426950408889634f;
constexpr int PPL = 6 + 3 * NSLAB, NPH = 2 + PPL * DEPTH;

constexpr size_t MiB = 1u << 20;
constexpr size_t WS_CTL = 0, CTL_BYTES = 1 * MiB;
constexpr size_t WS_ADA = 1 * MiB;
constexpr size_t WS_MISC = 3 * MiB;
constexpr size_t WS_VSTAT = 4 * MiB;
constexpr size_t WS_PSTAT = 5 * MiB;
constexpr size_t WS_CARRY = 13 * MiB;
constexpr size_t WS_POS = 17 * MiB;
constexpr size_t WS_TOKE = 19 * MiB;
constexpr size_t WS_WTE = 35 * MiB;
constexpr size_t WS_W = 51 * MiB;
constexpr size_t W_IN = WS_W;
constexpr size_t W_A = W_IN + 6 * MiB;
constexpr size_t W_B = W_A + 1 * MiB;
constexpr size_t W_O = W_B + 1 * MiB;
constexpr size_t W_E13 = W_O + 1 * MiB;
constexpr size_t W_E2 = W_E13 + 33 * MiB;
constexpr size_t W_RGA = W_E2 + 17 * MiB;
constexpr size_t W_RGX = W_RGA + 256 * 1024;
constexpr size_t W_SG = W_RGX + 256 * 1024;
constexpr size_t W_RH = W_SG + 256 * 1024;
constexpr size_t W_RL = W_RH + 128 * 1024;
constexpr size_t WS_BIG = 112 * MiB;
constexpr size_t BIGSZ = 128 * MiB;
constexpr size_t B_U = WS_BIG, B_V = WS_BIG + 1 * BIGSZ, B_RG = WS_BIG + 2 * BIGSZ, B_RI = WS_BIG + 3 * BIGSZ, B_GA = WS_BIG + 4 * BIGSZ, B_GB = WS_BIG + 5 * BIGSZ, B_HL = WS_BIG + 6 * BIGSZ, B_CA = WS_BIG + 7 * BIGSZ;
constexpr size_t B_H8 = WS_BIG + 8 * BIGSZ;
constexpr size_t B_YA8 = B_RI, B_YB8 = B_RI + 64 * MiB;
constexpr size_t B_MG8 = B_U;
constexpr size_t B_HID8 = B_HL, B_Y = B_U;
constexpr size_t B_XL = B_GB;
constexpr size_t WS_END = B_H8 + 64 * MiB;
static_assert(W_RL + 128 * 1024 <= WS_BIG, "weights region");
constexpr size_t HID_ROWS_MAX = (size_t)SLAB_T * 9 + 65 * 256;
static_assert(HID_ROWS_MAX * 256 <= 2 * BIGSZ && HID_ROWS_MAX * 1024 <= 5 * BIGSZ, "MoE overlay");
constexpr float DSC(float sa) { return MFMA_SCALED ? 1.0f : 1.0f / (sa * 64.f); }
constexpr float SC_W2 = 16.f;
constexpr float SC_W = 64.f, SC_H = 16.f, SC_Y = 8.f, SC_MG = 32.f, SC_HID = 8.f, SC_YO = 128.f, SC_Z = 16.f, SC_G = 256.f, SC_HL = 16.f, SC_CA = 256.f;

constexpr int CW_BAR = 4096;
constexpr int CW_CNT = 16384;

constexpr int SCR_BYTES = 147456;
constexpr int L_MISC = SCR_BYTES;
constexpr int L_TBASE = L_MISC + 128;
constexpr int L_CNT = L_TBASE + 384;
constexpr int L_TMAP = L_CNT + 512;
constexpr int LDS_BYTES = SCR_BYTES + 6144;
static_assert(L_TMAP + 5120 <= LDS_BYTES && (T * 9) / 256 + 65 <= 2560, "LDS map");

#define LDS_WAIT() asm volatile("s_waitcnt lgkmcnt(0)" ::: "memory")
#define VM_WAIT() asm volatile("s_waitcnt vmcnt(0)" ::: "memory")
__device__ __forceinline__ unsigned cvt_pk_bf16(float lo, float hi) { unsigned r; asm("v_cvt_pk_bf16_f32 %0, %1, %2" : "=v"(r) : "v"(lo), "v"(hi)); return r; }
__device__ __forceinline__ unsigned pk4_fp8(float a, float b, float c, float d) {
    a = __builtin_amdgcn_fmed3f(a, -448.f, 448.f); b = __builtin_amdgcn_fmed3f(b, -448.f, 448.f); c = __builtin_amdgcn_fmed3f(c, -448.f, 448.f); d = __builtin_amdgcn_fmed3f(d, -448.f, 448.f);
    int w = __builtin_amdgcn_cvt_pk_fp8_f32(a, b, 0, false); w = __builtin_amdgcn_cvt_pk_fp8_f32(c, d, w, true); return (unsigned)w; }
__device__ __forceinline__ unsigned pk4_fp8_nc(float a, float b, float c, float d) {
    int w = __builtin_amdgcn_cvt_pk_fp8_f32(a, b, 0, false); w = __builtin_amdgcn_cvt_pk_fp8_f32(c, d, w, true); return (unsigned)w; }
__device__ __forceinline__ void unpack4_fp8(unsigned w, float (&f)[4]) { const f32x2 lo = __builtin_amdgcn_cvt_pk_f32_fp8((int)w, false), hi = __builtin_amdgcn_cvt_pk_f32_fp8((int)w, true); f[0] = lo.x; f[1] = lo.y; f[2] = hi.x; f[3] = hi.y; }
__device__ __forceinline__ void unpack8_fp8(const u32x2 w, float (&f)[8]) { float a[4], b[4]; unpack4_fp8(w.x, a); unpack4_fp8(w.y, b);
#pragma unroll
    for (int j = 0; j < 4; ++j) { f[j] = a[j]; f[4 + j] = b[j]; } }
__device__ __forceinline__ void unpack16_fp8(const u32x4 w, float (&f)[16]) { float a[8], b[8]; unpack8_fp8((u32x2){w.x, w.y}, a); unpack8_fp8((u32x2){w.z, w.w}, b);
#pragma unroll
    for (int j = 0; j < 8; ++j) { f[j] = a[j]; f[8 + j] = b[j]; } }
__device__ __forceinline__ float bf_lo(unsigned w) { return __uint_as_float(w << 16); }
__device__ __forceinline__ float bf_hi(unsigned w) { return __uint_as_float(w & 0xffff0000u); }
__device__ __forceinline__ float fsigmoid(float x) { return __builtin_amdgcn_rcpf(1.0f + __builtin_amdgcn_exp2f(-LOG2E * x)); }
template <int CTRL> __device__ __forceinline__ float dpp_add(float v) { return v + __int_as_float(__builtin_amdgcn_update_dpp(0, __float_as_int(v), CTRL, 0xf, 0xf, true)); }
template <int CTRL> __device__ __forceinline__ int dpp_i(int v) { return __builtin_amdgcn_update_dpp(0, v, CTRL, 0xf, 0xf, true); }
template <int CTRL> __device__ __forceinline__ float dpp_f(float v) { return __int_as_float(dpp_i<CTRL>(__float_as_int(v))); }
__device__ __forceinline__ float rlane(float v, int l) { return __int_as_float(__builtin_amdgcn_readlane(__float_as_int(v), l)); }
__device__ __forceinline__ float wave_sum(float v) {
    v = dpp_add<0xB1>(v); v = dpp_add<0x4E>(v); v = dpp_add<0x141>(v); v = dpp_add<0x140>(v);
    return (rlane(v, 0) + rlane(v, 16)) + (rlane(v, 32) + rlane(v, 48));
}
__device__ __forceinline__ f32x2 gelu_pk(f32x2 v) {
    const f32x2 av = __builtin_elementwise_min(__builtin_elementwise_abs(v), (f32x2){4.5f, 4.5f});
    const f32x2 t = av * 0.4444444444f + (-1.0f);
    f32x2 q = t * 3.951919514e-02f + (-1.927818768e-02f);
    q = q * t + (-1.653166270e-01f); q = q * t + 1.674144965e-01f; q = q * t + 1.899891083e-01f; q = q * t + (-4.229837828e-01f);
    q = q * t + 2.122498017e-01f; q = q * t + 1.402255593e-01f; q = q * t + (-2.492420617e-01f); q = q * t + 1.346304704e-01f; q = q * t + (-2.719805609e-02f);
    return __builtin_elementwise_max(v, (f32x2){0.f, 0.f}) + q;
}
__device__ __forceinline__ f32x2 gelu16_pk(f32x2 v) {
    constexpr float KT = DSC(SC_H) / 4.5f, KM = SC_Z * DSC(SC_H); static_assert(SC_Z == 16.f, "polynomial carries the x16");
    float s0, s1;
    asm("v_mul_f32_e64 %0, |%1|, %2 clamp" : "=v"(s0) : "v"(v.x), "s"(KT));
    asm("v_mul_f32_e64 %0, |%1|, %2 clamp" : "=v"(s1) : "v"(v.y), "s"(KT));
    const f32x2 t = (f32x2){s0, s1};
    f32x2 q = t * (-2.724598309e+02f) + 1.343870688e+03f;
    q = q * t + (-2.690302968e+03f); q = q * t + 2.722895127e+03f; q = q * t + (-1.343784371e+03f); q = q * t + 1.599681120e+02f;
    q = q * t + 1.153520608e+02f; q = q * t + (-3.553613442e+01f); q = q * t + (-2.555093946e-03f);
    return __builtin_elementwise_max(v, (f32x2){0.f, 0.f}) * KM + q;
}
__device__ __forceinline__ void unpack8(const u32x4 v, float (&f)[8]) { f[0] = bf_lo(v.x); f[1] = bf_hi(v.x); f[2] = bf_lo(v.y); f[3] = bf_hi(v.y); f[4] = bf_lo(v.z); f[5] = bf_hi(v.z); f[6] = bf_lo(v.w); f[7] = bf_hi(v.w); }
__device__ __forceinline__ u32x4 pack8(const float (&f)[8]) { u32x4 o; o.x = cvt_pk_bf16(f[0], f[1]); o.y = cvt_pk_bf16(f[2], f[3]); o.z = cvt_pk_bf16(f[4], f[5]); o.w = cvt_pk_bf16(f[6], f[7]); return o; }
__device__ __forceinline__ float gelu1(float x) { f32x2 r = gelu_pk((f32x2){x, x}); return r.x; }

#define XB_TMO      128
#define XB_XCNT(j)  (256  + 64 * (j))
#define XB_XSUB(j)  (1280 + 64 * (j))
#define XB_XGEN(j)  (2304 + 64 * (j))
#define XB_TOP      3328
#define XB_TOPGEN   3392
#define XCD_BAR_WORDS 3456
#define XB_SPIN_CAP (1u << 20)
__device__ __forceinline__ unsigned xb_ld(GAS unsigned* p)              { return __hip_atomic_load(p, __ATOMIC_RELAXED, __HIP_MEMORY_SCOPE_AGENT); }
__device__ __forceinline__ unsigned xb_add(GAS unsigned* p, unsigned v) { return __hip_atomic_fetch_add(p, v, __ATOMIC_RELAXED, __HIP_MEMORY_SCOPE_AGENT); }
__device__ __forceinline__ unsigned xb_xcc_id() { return (unsigned)__builtin_amdgcn_s_getreg((3 << 11) | 20) & 0xFu; }
#define XB_SPIN(cond, bar) do { unsigned _sp = 0; while (cond) { __builtin_amdgcn_s_sleep(1); \
    if ((++_sp & 255u) == 0u) { if (xb_ld(&(bar)[XB_TMO])) break; if (_sp > XB_SPIN_CAP) { (void)xb_add(&(bar)[XB_TMO], 1u); break; } } } } while (0)
struct XcdBarrier { GAS unsigned* bar; unsigned x; volatile LAS unsigned* st; };
__device__ __forceinline__ XcdBarrier xcd_barrier_post(GAS unsigned* bar, volatile LAS unsigned* st) {
    XcdBarrier b; b.bar = bar; b.x = xb_xcc_id(); b.st = st;
    if (threadIdx.x == 0) (void)xb_add(&bar[XB_XCNT(b.x)], 1u);
    return b;
}
__device__ __forceinline__ void xcd_barrier_complete(GAS unsigned* bar, unsigned x, unsigned& nloc, unsigned& nx) {
    const unsigned G = gridDim.x * gridDim.y * gridDim.z;
    unsigned sum, cnt, mine, sp = 0u;
    for (;;) {
        sum = 0u; cnt = 0u; mine = 0u;
#pragma unroll
        for (unsigned j = 0; j < 16; ++j) { const unsigned c = xb_ld(&bar[XB_XCNT(j)]); sum += c; cnt += (c > 0u) ? 1u : 0u; mine = (j == x) ? c : mine; }
        if (sum == G) break;
        __builtin_amdgcn_s_sleep(1);
        if ((++sp & 255u) == 0u) { if (xb_ld(&bar[XB_TMO])) break; if (sp > XB_SPIN_CAP) { (void)xb_add(&bar[XB_TMO], 1u); break; } }
    }
    nloc = mine > 0u ? mine : 1u; nx = cnt > 0u ? cnt : 1u;
}
__device__ __forceinline__ void xcd_barrier(const XcdBarrier& b) {
    asm volatile("s_waitcnt vmcnt(0)" ::: "memory");
    __syncthreads();
    if (threadIdx.x == 0) {
        GAS unsigned* bar = b.bar; unsigned bx_ = b.x; asm volatile("" : "+s"(bar), "+s"(bx_));
        __builtin_amdgcn_s_waitcnt(0);
        unsigned nloc = b.st[0], nx = b.st[1];
        if (nloc == 0u) { xcd_barrier_complete(bar, bx_, nloc, nx); b.st[0] = nloc; b.st[1] = nx; }
        const unsigned old = xb_add(&bar[XB_XSUB(bx_)], 1u);
        const unsigned gen = old / nloc;
        if (old + 1u == (gen + 1u) * nloc) {
            __builtin_amdgcn_fence(__ATOMIC_RELEASE, "agent");
            asm volatile("s_waitcnt vmcnt(0)" ::: "memory");
            const unsigned og = xb_add(&bar[XB_TOP], 1u);
            const unsigned tg = og / nx;
            if (og + 1u == (tg + 1u) * nx) xb_add(&bar[XB_TOPGEN], 1u);
            else XB_SPIN(xb_ld(&bar[XB_TOPGEN]) == tg, bar);
            __builtin_amdgcn_fence(__ATOMIC_ACQUIRE, "agent");
            xb_add(&bar[XB_XGEN(bx_)], 1u);
            asm volatile("s_waitcnt vmcnt(0)" ::: "memory");
        } else {
            XB_SPIN(xb_ld(&bar[XB_XGEN(bx_)]) == gen, bar);
            __builtin_amdgcn_fence(__ATOMIC_ACQUIRE, "agent");
            asm volatile("s_waitcnt vmcnt(0)" ::: "memory");
        }
    }
    __syncthreads();
}

#ifndef PROBE_SET
#define PROBE_SET 0
#endif
#ifndef PROBE_MUL
#define PROBE_MUL 1
#endif
#define STAMP(ty) do { if (PROBE_SET != 0 && blockIdx.x == 0 && threadIdx.x == 0) { volatile LAS unsigned long long* _m = (volatile LAS unsigned long long*)(F.lds + L_MISC + 64); \
        const unsigned long long _n = __builtin_amdgcn_s_memrealtime(); if ((PROBE_SET >> (ty)) & 1) _m[1] += _n - _m[0]; _m[0] = _n; } } while (0)
struct Args { const float* in[31]; float* out; unsigned char* ws; int ph_lo, ph_hi; };
#define GSTAMP(ldsp, ty) do { if (PROBE_SET != 0 && (ty) >= 0 && blockIdx.x == 0 && threadIdx.x == 0) { volatile LAS unsigned long long* _m = (volatile LAS unsigned long long*)((ldsp) + L_MISC + 64); \
        const unsigned long long _n = __builtin_amdgcn_s_memrealtime(); if ((PROBE_SET >> ((ty) & 31)) & 1) _m[1] += _n - _m[0]; _m[0] = _n; } } while (0)
namespace pg8 {
constexpr int BM = 256, BK = 64, HALF = 128, HTB = HALF * BK * 2, STAGE_BYTES = 8 * HTB, NXCD = 8, WGM = 8;
__device__ __forceinline__ int lds_byte(int r, int c) { const int st = (r >> 4) * 2 + (c >> 5), rr = r & 15, cc = c & 31, ob = rr * 64 + cc * 2; return st * 1024 + (ob ^ (((ob >> 9) & 1) << 5)); }
__device__ __forceinline__ void stage_rc(int b, int& R, int& C) { const int st = b / 1024, sb = b % 1024, swz = sb ^ (((sb >> 9) & 1) << 5); R = (st >> 1) * 16 + swz / 64; C = (st & 1) * 32 + (swz % 64) / 2; }
__device__ __forceinline__ int perm32(int rho) { const int n = rho >> 4, i = rho & 15; return 8 * (i >> 2) + 4 * n + (i & 3); }

struct Unit { int pm, pn, aux, j; };

__device__ __forceinline__ void tile_of(int wgid, int nM, int nN, int& pm, int& pn) {
    const int nwg = nM * nN; { const int q = nwg / NXCD, r = nwg % NXCD, xcd = wgid % NXCD, off = wgid / NXCD; wgid = (xcd < r ? xcd * (q + 1) : r * (q + 1) + (xcd - r) * q) + off; }
    const int nig = WGM * nN, gid = wgid / nig, fm = gid * WGM, gsz = (nM - fm) < WGM ? (nM - fm) : WGM;
    pm = fm + ((wgid % nig) % gsz); pn = (wgid % nig) / gsz;
}
struct SchedStatic {
    int nM, nN, G, c;
    __device__ __forceinline__ bool next(int i, Unit& u) const { const long L = (long)i * G + c; if (L >= (long)nM * nN) return false; tile_of((int)L, nM, nN, u.pm, u.pn); u.aux = 0; u.j = 0; return true; }
};
struct SchedPair {
    int nM, nN, G, c;
    __device__ __forceinline__ bool next(int i, Unit& u) const { const long L = (long)(i >> 1) * G + c; if (L >= (long)nM * nN) return false; tile_of((int)L, nM, nN, u.pm, u.pn); u.aux = i & 1; u.j = 0; return true; }
};
template <int NCT> struct SchedMoe {
    int ntiles, G, c; const LAS unsigned short* tmap; const LAS int* tbase;
    __device__ __forceinline__ bool next(int i, Unit& u) const {
        const long L = (long)i * G + c; const int tile = (int)(L / NCT); if (tile >= ntiles) return false;
        u.pm = tile; u.pn = (int)(L % NCT); u.aux = __builtin_amdgcn_readfirstlane((int)tmap[tile]); u.j = tile - __builtin_amdgcn_readfirstlane(tbase[u.aux]); return true;
    }
};

#define E8M0x4(e) ((int)(((unsigned)(e)) * 0x01010101u))
template <int EA> struct ProbPlainT {
    static constexpr bool GATHER = false; static constexpr int SCA = E8M0x4(EA), SCB = E8M0x4(121);
    const GAS char* A; const GAS char* Bt; int K;
    __device__ __forceinline__ const GAS char* a_base(const Unit& u) const { return A + (size_t)u.pm * 256 * K; }
    __device__ __forceinline__ const GAS char* b_base(const Unit& u) const { return Bt + (size_t)u.pn * 256 * K; }
    __device__ __forceinline__ void gather(const Unit&, const int (&)[2], const int (&)[2], unsigned (&)[2][2]) const {}
};
struct ProbPair {
    static constexpr bool GATHER = false; static constexpr int SCA = E8M0x4(124), SCB = E8M0x4(121);
    const GAS char* A0; const GAS char* A1; const GAS char* B0; const GAS char* B1; int K;
    __device__ __forceinline__ const GAS char* a_base(const Unit& u) const { return (u.aux ? A1 : A0) + (size_t)u.pm * 256 * K; }
    __device__ __forceinline__ const GAS char* b_base(const Unit& u) const { return (u.aux ? B1 : B0) + (size_t)u.pn * 256 * K; }
    __device__ __forceinline__ void gather(const Unit&, const int (&)[2], const int (&)[2], unsigned (&)[2][2]) const {}
};
struct ProbMoe1 {
    static constexpr bool GATHER = true; static constexpr int SCA = E8M0x4(123), SCB = E8M0x4(121);
    const GAS char* A; const GAS char* W; const GAS unsigned* tok; const LAS int* cnt; int K;
    __device__ __forceinline__ const GAS char* a_base(const Unit&) const { return A; }
    __device__ __forceinline__ const GAS char* b_base(const Unit& u) const { return W + (size_t)u.aux * (512 * 1024) + (size_t)u.pn * 256 * 1024; }
    __device__ __forceinline__ void gather(const Unit& u, const int (&R)[2], const int (&C2)[2], unsigned (&vo)[2][2]) const {
        const int c = cnt[u.aux];
#pragma unroll
        for (int h = 0; h < 2; ++h)
#pragma unroll
            for (int i = 0; i < 2; ++i) { const int p = u.j * 256 + h * 128 + R[i]; unsigned tk = 0u;
                if (p < c) tk = (u.aux == 64) ? (unsigned)p : __builtin_nontemporal_load(tok + (size_t)u.aux * ECAP + p);
                vo[h][i] = tk * 1024u + (unsigned)C2[i]; }
    }
};
struct ProbMoe2 {
    static constexpr bool GATHER = false; static constexpr int SCA = E8M0x4(124), SCB = E8M0x4(121);
    const GAS char* A; const GAS char* W; int K;
    __device__ __forceinline__ const GAS char* a_base(const Unit& u) const { return A + (size_t)u.pm * 256 * 256; }
    __device__ __forceinline__ const GAS char* b_base(const Unit& u) const { return W + (size_t)u.aux * (1024 * 256) + (size_t)u.pn * 256 * 256; }
    __device__ __forceinline__ void gather(const Unit&, const int (&)[2], const int (&)[2], unsigned (&)[2][2]) const {}
};

typedef f32x4 Acc[2][2][4][2];

struct EpiZ {
    static constexpr int PERM = 2; static constexpr bool NOKEEP = true;
    GAS unsigned char* out0;
    __device__ __forceinline__ bool keep(const Unit&) const { return false; }
    template <int ACT> __device__ __forceinline__ void run(const Acc& acc, GAS unsigned char* base, int row0, int col0) const {
#pragma unroll
        for (int ai = 0; ai < 2; ++ai)
#pragma unroll
            for (int m = 0; m < 4; ++m) { const size_t eo = (size_t)(row0 + ai * HALF + m * 16) * D + col0; u32x4 w; unsigned wq[4];
#pragma unroll
                for (int q = 0; q < 4; ++q) { f32x4 v = acc[ai][q >> 1][m][q & 1];
                    if (ACT == 0) v = v * (SC_Z * DSC(SC_H));
                    if (ACT == 1) { const f32x2 a = gelu16_pk((f32x2){v[0], v[1]}), c = gelu16_pk((f32x2){v[2], v[3]}); v = (f32x4){a.x, a.y, c.x, c.y}; }
                    if (ACT == 2) { static_assert(SC_G == 256.f, "SC_G * sigmoid(x) = 1 / (2^-8 + 2^(-x log2 e - 8))");
                        const f32x4 ex = v * (-LOG2E * DSC(SC_H)) + (-8.0f);
#pragma unroll
                        for (int j = 0; j < 4; ++j) v[j] = __builtin_amdgcn_rcpf(__builtin_amdgcn_exp2f(ex[j]) + 0.00390625f); }
                    wq[q] = (ACT == 2) ? pk4_fp8_nc(v[0], v[1], v[2], v[3]) : pk4_fp8(v[0], v[1], v[2], v[3]); }
                w.x = wq[0]; w.y = wq[1]; w.z = wq[2]; w.w = wq[3];
                __builtin_nontemporal_store(w, (GAS u32x4*)(base + eo)); }
    }
    struct Pre {}; __device__ __forceinline__ void prefetch(Pre&, const Unit&, int, int, int, int) const {}
    __device__ __forceinline__ void operator()(Acc& acc, const Unit& u, int wr, int wc, int fr, int fq, const Pre& pre) const {
        const int part = u.pn >> 2; GAS unsigned char* base = out0 + (size_t)part * BIGSZ;
        const int row0 = u.pm * BM + wr * 64 + fr, col0 = (u.pn & 3) * BM + wc * 64 + 16 * fq;
        if (part < 3) run<1>(acc, base, row0, col0); else if (part == 3) run<0>(acc, base, row0, col0); else run<2>(acc, base, row0, col0);
    }
};
struct EpiPair {
    static constexpr int PERM = 2; static constexpr bool NOKEEP = false;
    const GAS unsigned char* GA; const GAS unsigned char* GB; GAS unsigned char* MG;
    __device__ __forceinline__ bool keep(const Unit& u) const { return u.aux == 0; }
    struct Pre { u32x4 gb[2], ga[2]; };
    __device__ __forceinline__ void ldg(u32x4 (&gb)[2], u32x4 (&ga)[2], const Unit& u, int row0, int col0, int h) const {
#pragma unroll
        for (int mm = 0; mm < 2; ++mm) { const size_t off = (size_t)(row0 + (h >> 1) * HALF + ((h & 1) * 2 + mm) * 16) * D + col0; gb[mm] = *(const GAS u32x4*)(GB + off); ga[mm] = gb[mm]; if (u.aux == 0) ga[mm] = *(const GAS u32x4*)(GA + off); }
    }
    __device__ __forceinline__ void prefetch(Pre& pre, const Unit& u, int wr, int wc, int fr, int fq) const { ldg(pre.gb, pre.ga, u, u.pm * BM + wr * 64 + fr, u.pn * BM + wc * 64 + 16 * fq, 0); }
    __device__ __forceinline__ void operator()(Acc& acc, const Unit& u, int wr, int wc, int fr, int fq, const Pre& pre) const {
        const int row0 = u.pm * BM + wr * 64 + fr, col0 = u.pn * BM + wc * 64 + 16 * fq;
        u32x4 gb[2][2], ga[2][2];
#pragma unroll
        for (int mm = 0; mm < 2; ++mm) { gb[0][mm] = pre.gb[mm]; ga[0][mm] = pre.ga[mm]; }
#pragma unroll
        for (int h = 0; h < 4; ++h) { const int ai = h >> 1;
            if (h < 3) ldg(gb[(h + 1) & 1], ga[(h + 1) & 1], u, row0, col0, h + 1);
            asm volatile("" ::: "memory");
#pragma unroll
            for (int mm = 0; mm < 2; ++mm) { const int m = (h & 1) * 2 + mm; const size_t off = (size_t)(row0 + ai * HALF + m * 16) * D + col0;
                float sb[16]; unpack16_fp8(gb[h & 1][mm], sb);
#pragma unroll
                for (int j = 0; j < 16; ++j) sb[j] = fmaxf(sb[j], 1e-9f);
                if (u.aux == 0) { float sa[16]; unpack16_fp8(ga[h & 1][mm], sa);
#pragma unroll
                    for (int q = 0; q < 4; ++q)
#pragma unroll
                        for (int j = 0; j < 4; ++j) acc[ai][q >> 1][m][q & 1][j] *= sa[4 * q + j] * __builtin_amdgcn_rcpf(sb[4 * q + j]);
                } else { u32x4 w; unsigned wq[4];
#pragma unroll
                    for (int q = 0; q < 4; ++q) { f32x4 v = acc[ai][q >> 1][m][q & 1];
#pragma unroll
                        for (int j = 0; j < 4; ++j) v[j] *= sb[4 * q + j] * (SC_MG / SC_G * DSC(SC_Y));
                        wq[q] = pk4_fp8(v[0], v[1], v[2], v[3]); }
                    w.x = wq[0]; w.y = wq[1]; w.z = wq[2]; w.w = wq[3];
                    *(GAS u32x4*)(MG + off) = w; } }
            asm volatile("" ::: "memory"); }
    }
};
template <bool XF32> struct EpiOutT {
    static constexpr int PERM = 2; static constexpr bool NOKEEP = true;
    const GAS void* xsrc; GAS bf16_t* xdst; const GAS float* ada_l; GAS float* pstat;
    __device__ __forceinline__ bool keep(const Unit&) const { return false; }
    struct Pre { f32x4 g[4]; u32x4 x[2][2]; };
    __device__ __forceinline__ void prefetch(Pre& pre, const Unit& u, int wr, int wc, int fr, int fq) const {
        const int row0 = u.pm * BM + wr * 64 + fr, col0 = u.pn * BM + wc * 64 + 16 * fq; const int b = u.pm >> 4;
        const GAS float* gate = ada_l + (size_t)b * NIN + 2 * D + col0;
#pragma unroll
        for (int q = 0; q < 4; ++q) pre.g[q] = *(const GAS f32x4*)(gate + 4 * q);
#pragma unroll
        for (int mm = 0; mm < 2; ++mm) { pre.x[mm][0] = (u32x4){0u, 0u, 0u, 0u}; pre.x[mm][1] = pre.x[mm][0];
            if (!XF32) { const size_t off = (size_t)(row0 + mm * 16) * D + col0; pre.x[mm][0] = *(const GAS u32x4*)((const GAS bf16_t*)xsrc + off); pre.x[mm][1] = *(const GAS u32x4*)((const GAS bf16_t*)xsrc + off + 8); } }
    }
    __device__ __forceinline__ void operator()(Acc& acc, const Unit& u, int wr, int wc, int fr, int fq, const Pre& pre) const {
        const int row0 = u.pm * BM + wr * 64 + fr, col0 = u.pn * BM + wc * 64 + 16 * fq; const int b = u.pm >> 4;
        f32x4 g[4];
#pragma unroll
        for (int q = 0; q < 4; ++q) g[q] = pre.g[q] * DSC(SC_MG);
        u32x4 xr[2][2][2];
#pragma unroll
        for (int mm = 0; mm < 2; ++mm) { xr[0][mm][0] = pre.x[mm][0]; xr[0][mm][1] = pre.x[mm][1]; }
#pragma unroll
        for (int bt = 0; bt < 4; ++bt) { const int ai = bt >> 1, m0 = (bt & 1) * 2;
            f32x4 xv[2][4];
            if (XF32) {
#pragma unroll
                for (int mm = 0; mm < 2; ++mm) { const size_t off = (size_t)(row0 + ai * HALF + (m0 + mm) * 16) * D + col0;
#pragma unroll
                    for (int q = 0; q < 4; ++q) xv[mm][q] = *(const GAS f32x4*)((const GAS float*)xsrc + off + 4 * q); }
            } else {
                if (bt < 3) { const int ain = (bt + 1) >> 1, m0n = ((bt + 1) & 1) * 2;
#pragma unroll
                    for (int mm = 0; mm < 2; ++mm) { const size_t off = (size_t)(row0 + ain * HALF + (m0n + mm) * 16) * D + col0;
                        xr[(bt + 1) & 1][mm][0] = *(const GAS u32x4*)((const GAS bf16_t*)xsrc + off); xr[(bt + 1) & 1][mm][1] = *(const GAS u32x4*)((const GAS bf16_t*)xsrc + off + 8); } }
#pragma unroll
                for (int mm = 0; mm < 2; ++mm) { float f[8]; unpack8(xr[bt & 1][mm][0], f); xv[mm][0] = (f32x4){f[0], f[1], f[2], f[3]}; xv[mm][1] = (f32x4){f[4], f[5], f[6], f[7]};
                    unpack8(xr[bt & 1][mm][1], f); xv[mm][2] = (f32x4){f[0], f[1], f[2], f[3]}; xv[mm][3] = (f32x4){f[4], f[5], f[6], f[7]}; }
            }
#pragma unroll
            for (int mm = 0; mm < 2; ++mm) { const int m = m0 + mm; const int row = row0 + ai * HALF + m * 16; const size_t off = (size_t)row * D + col0; float s = 0.f, q2 = 0.f;
                u32x4 w0, w1; unsigned wq[8];
#pragma unroll
                for (int q = 0; q < 4; ++q) { const f32x4 v = xv[mm][q] * ALPHA + g[q] * acc[ai][q >> 1][m][q & 1]; wq[2 * q] = cvt_pk_bf16(v[0], v[1]); wq[2 * q + 1] = cvt_pk_bf16(v[2], v[3]); }
                w0.x = wq[0]; w0.y = wq[1]; w0.z = wq[2]; w0.w = wq[3]; w1.x = wq[4]; w1.y = wq[5]; w1.z = wq[6]; w1.w = wq[7];
                *(GAS u32x4*)(xdst + off) = w0; *(GAS u32x4*)(xdst + off + 8) = w1;
                { float r[8]; unpack8(w0, r);
#pragma unroll
                  for (int j = 0; j < 8; ++j) { s += r[j]; q2 += r[j] * r[j]; }
                  unpack8(w1, r);
#pragma unroll
                  for (int j = 0; j < 8; ++j) { s += r[j]; q2 += r[j] * r[j]; } }
                s += __shfl_xor(s, 16); s += __shfl_xor(s, 32); q2 += __shfl_xor(q2, 16); q2 += __shfl_xor(q2, 32);
                if (fq == 0) *(GAS f32x2*)(pstat + ((size_t)row * 16 + u.pn * 4 + wc) * 2) = (f32x2){s, q2}; }
            if (XF32) asm volatile("" ::: "memory"); }
    }
};
struct EpiMoe1 {
    static constexpr int PERM = 2; static constexpr bool NOKEEP = true;
    GAS unsigned char* hid; const GAS float* wts; const LAS int* cnt;
    __device__ __forceinline__ bool keep(const Unit&) const { return false; }
    struct Pre { float wrow[2][4]; };
    __device__ __forceinline__ void prefetch(Pre& pre, const Unit& u, int wr, int wc, int fr, int fq) const {
        const int e = u.aux, c = cnt[e];
#pragma unroll
        for (int ai = 0; ai < 2; ++ai)
#pragma unroll
            for (int m = 0; m < 4; ++m) { const int p = u.j * 256 + ai * HALF + wr * 64 + m * 16 + fr; float w = 0.f; if (p < c) w = (e == 64) ? 1.0f : wts[(size_t)e * ECAP + p]; pre.wrow[ai][m] = w; }
    }
    __device__ __forceinline__ void operator()(Acc& acc, const Unit& u, int wr, int wc, int fr, int fq, const Pre& pre) const {
        const int e = u.aux, c = cnt[e]; const int hc0 = u.pn * 128 + wc * 32 + 8 * fq;
#pragma unroll
        for (int ai = 0; ai < 2; ++ai)
#pragma unroll
            for (int m = 0; m < 4; ++m) { const int r = ai * HALF + wr * 64 + m * 16 + fr; const float ws2 = pre.wrow[ai][m] * (SC_HID * DSC(SC_H) * DSC(SC_H));
                GAS unsigned char* rowp = hid + (size_t)(u.pm * 256 + r) * DE + hc0; float h[8];
#pragma unroll
                for (int q = 0; q < 4; ++q) { const f32x4 v = acc[ai][q >> 1][m][q & 1];
                    const float r0 = __builtin_amdgcn_rcpf(1.0f + __builtin_amdgcn_exp2f(v[0] * (-LOG2E * DSC(SC_H)))) * ws2, r1 = __builtin_amdgcn_rcpf(1.0f + __builtin_amdgcn_exp2f(v[2] * (-LOG2E * DSC(SC_H)))) * ws2;
                    h[2 * q] = (v[0] * v[1]) * r0; h[2 * q + 1] = (v[2] * v[3]) * r1; }
                u32x2 o; o.x = pk4_fp8(h[0], h[1], h[2], h[3]); o.y = pk4_fp8(h[4], h[5], h[6], h[7]); *(GAS u32x2*)rowp = o; }
    }
};
struct EpiMoe2 {
    static constexpr int PERM = 2; static constexpr bool NOKEEP = true;
    GAS unsigned char* y;
    __device__ __forceinline__ bool keep(const Unit&) const { return false; }
    struct Pre {}; __device__ __forceinline__ void prefetch(Pre&, const Unit&, int, int, int, int) const {}
    __device__ __forceinline__ void operator()(Acc& acc, const Unit& u, int wr, int wc, int fr, int fq, const Pre& pre) const {
        const int row0 = u.pm * BM + wr * 64 + fr, col0 = u.pn * BM + wc * 64 + 16 * fq;
        static_assert(SC_HID * SC_W2 == SC_YO && !MFMA_SCALED, "E6 accumulators must already be in y's fp8 units");
        float mx = 0.f;
#pragma unroll
        for (int ai = 0; ai < 2; ++ai)
#pragma unroll
            for (int m = 0; m < 4; ++m)
#pragma unroll
                for (int q = 0; q < 4; ++q) { const f32x4 v = acc[ai][q >> 1][m][q & 1]; mx = fmaxf(fmaxf(fabsf(v[0]), fabsf(v[1])), mx); mx = fmaxf(fmaxf(fabsf(v[2]), fabsf(v[3])), mx); }
        const bool big = __builtin_amdgcn_ballot_w64(!(mx <= 448.f)) != 0ull;
        if (!big) {
#pragma unroll
            for (int ai = 0; ai < 2; ++ai)
#pragma unroll
                for (int m = 0; m < 4; ++m) { GAS unsigned char* rowp = y + (size_t)(row0 + ai * HALF + m * 16) * D + col0; u32x4 w;
                    { const f32x4 v0 = acc[ai][0][m][0], v1 = acc[ai][0][m][1], v2 = acc[ai][1][m][0], v3 = acc[ai][1][m][1];
                      w.x = pk4_fp8_nc(v0[0], v0[1], v0[2], v0[3]); w.y = pk4_fp8_nc(v1[0], v1[1], v1[2], v1[3]); w.z = pk4_fp8_nc(v2[0], v2[1], v2[2], v2[3]); w.w = pk4_fp8_nc(v3[0], v3[1], v3[2], v3[3]); }
                    __builtin_nontemporal_store(w, (GAS u32x4*)rowp); }
        } else {
#pragma unroll
            for (int ai = 0; ai < 2; ++ai)
#pragma unroll
                for (int m = 0; m < 4; ++m) { GAS unsigned char* rowp = y + (size_t)(row0 + ai * HALF + m * 16) * D + col0; u32x4 w;
                    { const f32x4 v0 = acc[ai][0][m][0], v1 = acc[ai][0][m][1], v2 = acc[ai][1][m][0], v3 = acc[ai][1][m][1];
                      w.x = pk4_fp8(v0[0], v0[1], v0[2], v0[3]); w.y = pk4_fp8(v1[0], v1[1], v1[2], v1[3]); w.z = pk4_fp8(v2[0], v2[1], v2[2], v2[3]); w.w = pk4_fp8(v3[0], v3[1], v3[2], v3[3]); }
                    __builtin_nontemporal_store(w, (GAS u32x4*)rowp); }
        }
    }
};

__device__ __forceinline__ void stage2(LAS unsigned char* dst, const GAS char* g0, const GAS char* g1) {
    __builtin_amdgcn_global_load_lds((const GAS unsigned*)g0, (LAS unsigned*)dst, 16, 0, 0);
    __builtin_amdgcn_global_load_lds((const GAS unsigned*)g1, (LAS unsigned*)(dst + 1024), 16, 0, 0);
}

template <int PK = -1, class Prob, class Epi, class Sched>
__device__ __forceinline__ void gemm_phase(LAS unsigned char* lds, const int tid, const Prob& P, const Sched& S, const Epi& E) {
    constexpr bool GATHER = Prob::GATHER;
    const int wid = __builtin_amdgcn_readfirstlane(tid >> 6), lane = tid & 63, wr = wid >> 2, wc = wid & 3, fr = lane & 15, fq = lane >> 4;
    const int K = P.K, nt = K / 128;
    unsigned voffA[2], voffB[2], voffB1[2]; int RA[2], CA2[2];
#pragma unroll
    for (int i = 0; i < 2; ++i) { int R, C; stage_rc((2 * wid + i) * 1024 + lane * 16, R, C);   const int Rb = Epi::PERM ? ((R & ~31) + perm32(R & 31)) : R;
        voffA[i] = (unsigned)(R * K + C * 2); voffB[i] = (unsigned)(Rb * K + C * 2); voffB1[i] = 0u; RA[i] = R; CA2[i] = C * 2;
        if (Epi::PERM == 2) { const int w_ = R >> 5, n_ = (R >> 4) & 1, q_ = (R >> 2) & 3, j_ = R & 3, src = 64 * w_ + 16 * q_ + 4 * n_ + j_;
            voffB[i] = (unsigned)(src * K + C * 2); voffB1[i] = (unsigned)((src + 8) * K + C * 2); } }
    const size_t kstep = (size_t)(BK * 2);
    const size_t hstep = (size_t)HALF * K;
    const unsigned ldsw = (unsigned)wid * 2048u;
    const int aoff = lds_byte(wr * 64 + fr, fq * 8), boff = lds_byte(wc * 32 + fr, fq * 8);
#define PG8_SA(b, h) (((b) * 2 + (h)) * HTB)
#define PG8_SB(b, h) ((4 + (b) * 2 + (h)) * HTB)
#define PG8_STG_B(bufoff, pb) stage2(lds + (bufoff) + ldsw, (pb) + voffB[0], (pb) + voffB[1])
#define PG8_STG_B1(bufoff, pb) do { if (Epi::PERM == 2) stage2(lds + (bufoff) + ldsw, (pb) + voffB1[0], (pb) + voffB1[1]); else stage2(lds + (bufoff) + ldsw, (pb) + hstep + voffB[0], (pb) + hstep + voffB[1]); } while (0)
#define PG8_STG_A(bufoff, NXT, h, kb) do { const GAS char* _b = ((NXT) ? nA : cA) + (kb) + (GATHER ? (size_t)0 : (size_t)(h) * hstep); \
        const unsigned _o0 = GATHER ? ((NXT) ? nvA[h][0] : vA[h][0]) : voffA[0], _o1 = GATHER ? ((NXT) ? nvA[h][1] : vA[h][1]) : voffA[1]; \
        stage2(lds + (bufoff) + ldsw, _b + _o0, _b + _o1); } while (0)
#define PG8_LDA(dst, b, h) do { _Pragma("unroll") for (int m = 0; m < 4; ++m) _Pragma("unroll") for (int k = 0; k < 2; ++k) dst[m][k] = *(const LAS bf16x8*)(lds + PG8_SA(b, h) + aoff + m * 2048 + k * 1024); } while (0)
#define PG8_LDB(dst, b, h) do { _Pragma("unroll") for (int n = 0; n < 2; ++n) _Pragma("unroll") for (int k = 0; k < 2; ++k) dst[n][k] = *(const LAS bf16x8*)(lds + PG8_SB(b, h) + boff + n * 2048 + k * 1024); } while (0)
#define PG8_CAT(x) __builtin_shufflevector(__builtin_bit_cast(i32x4, (x)[0]), __builtin_bit_cast(i32x4, (x)[1]), 0, 1, 2, 3, 4, 5, 6, 7)
#define PG8_MMA(ai, bj, At, Bt) do { __builtin_amdgcn_s_setprio(1); _Pragma("unroll") for (int m = 0; m < 4; ++m) _Pragma("unroll") for (int n = 0; n < 2; ++n) \
        { if (MFMA_SCALED) asm volatile("v_mfma_scale_f32_16x16x128_f8f6f4 %0, %1, %2, %0, %3, %4 op_sel_hi:[0,0,0]" : "+v"(acc[ai][bj][m][n]) : "v"(PG8_CAT(Bt[n])), "v"(PG8_CAT(At[m])), "v"(scb), "v"(sca)); \
          else asm volatile("v_mfma_f32_16x16x128_f8f6f4 %0, %1, %2, %0" : "+v"(acc[ai][bj][m][n]) : "v"(PG8_CAT(Bt[n])), "v"(PG8_CAT(At[m]))); } __builtin_amdgcn_s_setprio(0); } while (0)
#define PG8_MMAZ(ai, bj, At, Bt) do { __builtin_amdgcn_s_setprio(1); _Pragma("unroll") for (int m = 0; m < 4; ++m) _Pragma("unroll") for (int n = 0; n < 2; ++n) \
        { asm volatile("v_mfma_f32_16x16x128_f8f6f4 %0, %1, %2, 0" : "+v"(acc[ai][bj][m][n]) : "v"(PG8_CAT(Bt[n])), "v"(PG8_CAT(At[m]))); } __builtin_amdgcn_s_setprio(0); } while (0)
#define PG8_WAIT_V(n) asm volatile("s_waitcnt vmcnt(" #n ")" ::: "memory")
#define PG8_WAIT_L(n) asm volatile("s_waitcnt lgkmcnt(" #n ")" ::: "memory")
#define PG8_BAR __builtin_amdgcn_s_barrier()
#define PG8_SCHED __builtin_amdgcn_sched_barrier(0)
#define PG8_TRIP(t, MM) do { \
            const bool last = (t == nt - 2); \
            const size_t kb1 = (size_t)(t + 1) * kstep; \
            const size_t kb2 = last ? (size_t)0 : (size_t)(t + 2) * kstep, kb3 = kb2 + kstep; \
            const GAS char* b2 = (last ? nB : cB) + kb2; const GAS char* b3 = b2 + kstep; \
            if (GATHER && t == 0 && has_next) P.gather(nxt, RA, CA2, nvA); \
            PG8_LDB(B0, 0, 0); PG8_LDB(B1, 0, 1); PG8_SCHED; PG8_LDA(At, 0, 0); PG8_STG_A(PG8_SA(1, 1), false, 1, kb1); \
            PG8_WAIT_V(8); PG8_WAIT_L(0); PG8_BAR; MM(0, 0, At, B0); MM(0, 1, At, B1); PG8_BAR; PG8_SCHED; \
            PG8_LDA(At, 0, 1); PG8_STG_B(PG8_SB(0, 0), b2); PG8_STG_B1(PG8_SB(0, 1), b2); PG8_STG_A(PG8_SA(0, 0), last, 0, kb2); \
            PG8_WAIT_V(8); PG8_WAIT_L(0); PG8_BAR; MM(1, 0, At, B0); MM(1, 1, At, B1); PG8_BAR; PG8_SCHED; \
            PG8_LDB(B0, 1, 0); PG8_LDB(B1, 1, 1); PG8_SCHED; PG8_LDA(At, 1, 0); PG8_STG_A(PG8_SA(0, 1), last, 1, kb2); \
            PG8_WAIT_V(8); PG8_WAIT_L(0); PG8_BAR; PG8_MMA(0, 0, At, B0); PG8_MMA(0, 1, At, B1); PG8_BAR; PG8_SCHED; \
            PG8_LDA(At, 1, 1); PG8_STG_B(PG8_SB(1, 0), b3); PG8_STG_B1(PG8_SB(1, 1), b3); PG8_STG_A(PG8_SA(1, 0), last, 0, kb3); \
            PG8_WAIT_V(8); PG8_WAIT_L(0); PG8_BAR; PG8_MMA(1, 0, At, B0); PG8_MMA(1, 1, At, B1); PG8_BAR; PG8_SCHED; \
        } while (0)
    constexpr bool ZC = !MFMA_SCALED && Epi::NOKEEP;
    Unit cur, nxt; int ui = 0;
    if (!S.next(0, cur)) return;
    const int sca = Prob::SCA, scb = Prob::SCB;
    Acc acc;
#pragma unroll
    for (int a = 0; a < 2; ++a)
#pragma unroll
        for (int b = 0; b < 2; ++b)
#pragma unroll
            for (int m = 0; m < 4; ++m)
#pragma unroll
                for (int n = 0; n < 2; ++n) acc[a][b][m][n] = (f32x4){0.f, 0.f, 0.f, 0.f};
    bf16x8 At[4][2], B0[2][2], B1[2][2];
    unsigned vA[2][2] = {{0u, 0u}, {0u, 0u}}, nvA[2][2] = {{0u, 0u}, {0u, 0u}};
    const GAS char* cA = P.a_base(cur); const GAS char* cB = P.b_base(cur);
    const GAS char* nA = cA;
    if (GATHER) { P.gather(cur, RA, CA2, vA); }
    {
        const bool F = false;
        PG8_STG_B(PG8_SB(0, 0), cB); PG8_STG_B1(PG8_SB(0, 1), cB); PG8_STG_A(PG8_SA(0, 0), F, 0, (size_t)0); PG8_STG_A(PG8_SA(0, 1), F, 1, (size_t)0);
        if (wr == 1) PG8_BAR;
        PG8_WAIT_V(2); PG8_BAR;
        PG8_STG_B(PG8_SB(1, 0), cB + kstep); PG8_STG_A(PG8_SA(1, 0), F, 0, kstep); PG8_STG_B1(PG8_SB(1, 1), cB + kstep);
        PG8_WAIT_V(6); PG8_BAR;
    }
    for (;;) {
        const bool has_next = S.next(ui + 1, nxt);
        nA = has_next ? P.a_base(nxt) : cA; const GAS char* nB = has_next ? P.b_base(nxt) : cB;
        if (GATHER && !has_next) {
#pragma unroll
            for (int h = 0; h < 2; ++h) { nvA[h][0] = vA[h][0]; nvA[h][1] = vA[h][1]; } }
        if (ZC) { PG8_TRIP(0, PG8_MMAZ); for (int t = 2; t < nt; t += 2) PG8_TRIP(t, PG8_MMA); }
        else { for (int t = 0; t < nt; t += 2) PG8_TRIP(t, PG8_MMA); }
        GSTAMP(lds, PK);
        typename Epi::Pre pre; E.prefetch(pre, cur, wr, wc, fr, fq);
        if (wr == 0) PG8_BAR;
        asm volatile("s_nop 15\n\ts_nop 15\n\ts_nop 15" ::: "memory");
        E(acc, cur, wr, wc, fr, fq, pre);
        GSTAMP(lds, PK < 0 ? -1 : PK + 1);
        if (!has_next) break;
        if (!ZC && !E.keep(cur)) {
#pragma unroll
            for (int a = 0; a < 2; ++a)
#pragma unroll
                for (int b = 0; b < 2; ++b)
#pragma unroll
                    for (int m = 0; m < 4; ++m)
#pragma unroll
                        for (int n = 0; n < 2; ++n) acc[a][b][m][n] = (f32x4){0.f, 0.f, 0.f, 0.f};
        }
        cur = nxt; cA = nA; cB = nB; ++ui;
        if (GATHER) {
#pragma unroll
            for (int h = 0; h < 2; ++h) { vA[h][0] = nvA[h][0]; vA[h][1] = nvA[h][1]; } }
        if (wr == 1) PG8_BAR;
    }
    PG8_WAIT_V(0);
    PG8_BAR;
#undef PG8_SA
#undef PG8_SB
#undef PG8_STG_A
#undef PG8_STG_B
#undef PG8_STG_B1
#undef PG8_LDA
#undef PG8_LDB
#undef PG8_MMA
#undef PG8_MMAZ
#undef PG8_TRIP
#undef PG8_CAT
#undef PG8_WAIT_V
#undef PG8_WAIT_L
#undef PG8_BAR
#undef PG8_SCHED
}
}

struct Frame {
    LAS unsigned char* lds; int tid, lane, wave, vcu, G;
    GAS unsigned char* ws;
};
#define NWAVES 8

__device__ __forceinline__ void transpose_item(const GAS float* W, int N, GAS bf16_t* WT, int ldo, int row_mul, int row_add, LAS float* scr, int item, int lane) {
    const int nblk = N / 32, kb = item / nblk, nb = item % nblk, k0 = 64 * kb, n0 = 32 * nb;
#pragma unroll 8
    for (int i = 0; i < 32; ++i) { const int kk = 2 * i + (lane >> 5); scr[kk * 33 + (lane & 31)] = W[(size_t)(k0 + kk) * N + n0 + (lane & 31)]; }
    LDS_WAIT(); asm volatile("" ::: "memory");
    const int c = lane & 7;
#pragma unroll
    for (int j = 0; j < 4; ++j) { const int n = (lane >> 3) + 8 * j; const LAS float* s = scr + (8 * c) * 33 + n;
        u32x4 o; o.x = cvt_pk_bf16(s[0 * 33], s[1 * 33]); o.y = cvt_pk_bf16(s[2 * 33], s[3 * 33]); o.z = cvt_pk_bf16(s[4 * 33], s[5 * 33]); o.w = cvt_pk_bf16(s[6 * 33], s[7 * 33]);
        *(GAS u32x4*)(WT + (size_t)((n0 + n) * row_mul + row_add) * ldo + k0 + 8 * c) = o; }
    LDS_WAIT(); asm volatile("" ::: "memory");
}

__device__ __forceinline__ void transpose_item8(const GAS float* W, int N, GAS unsigned char* WT, int ldo, int row_mul, int row_add, LAS float* scr, int item, int lane, const float wsc = SC_W) {
    const int nblk = N / 32, kb = item / nblk, nb = item % nblk, k0 = 64 * kb, n0 = 32 * nb;
    { const int q4 = 4 * (lane & 7), r8 = lane >> 3; f32x4 v[8];
#pragma unroll
      for (int i = 0; i < 8; ++i) v[i] = *(const GAS f32x4*)(W + (size_t)(k0 + 8 * i + r8) * N + n0 + q4);
#pragma unroll
      for (int i = 0; i < 8; ++i) { LAS float* d = scr + (8 * i + r8) * 33 + q4; d[0] = v[i][0] * wsc; d[1] = v[i][1] * wsc; d[2] = v[i][2] * wsc; d[3] = v[i][3] * wsc; } }
    LDS_WAIT(); asm volatile("" ::: "memory");
    const int c = lane & 7;
#pragma unroll
    for (int j = 0; j < 4; ++j) { const int n = (lane >> 3) + 8 * j; const LAS float* q = scr + (8 * c) * 33 + n;
        u32x2 o; o.x = pk4_fp8(q[0 * 33], q[1 * 33], q[2 * 33], q[3 * 33]); o.y = pk4_fp8(q[4 * 33], q[5 * 33], q[6 * 33], q[7 * 33]);
        *(GAS u32x2*)(WT + (size_t)((n0 + n) * row_mul + row_add) * ldo + k0 + 8 * c) = o; }
    LDS_WAIT(); asm volatile("" ::: "memory");
}

__device__ __forceinline__ void convert_layer(const Frame& F, const Args& a, int l) {
    LAS float* scr = (LAS float*)(F.lds + F.wave * 16384);
    const int gw = F.vcu * NWAVES + F.wave, NGW = F.G * NWAVES;
    GAS unsigned char* ws = F.ws;
    constexpr int I_IN = 16 * 192, I_SQ = 16 * 32, I_E1 = 16 * 8, I_E2 = 4 * 32, I_RG = 2 * 4;
    constexpr int N0 = I_IN, N1 = N0 + 3 * I_SQ, N2 = N1 + 64 * I_E1, N3 = N2 + 64 * I_E1, N4 = N3 + 2 * I_E1, N5 = N4 + 64 * I_E2, N6 = N5 + I_E2, N7 = N6 + 8 * I_RG, N8 = N7 + 8 * I_RG;
    for (int it = gw; it < N8; it += NGW) {
        if (it < N0) { transpose_item8(((const GAS float*)a.in[4]) + (size_t)l * D * NIN, NIN, (GAS unsigned char*)(ws + W_IN), D, 1, 0, scr, it, F.lane); }
        else if (it < N1) { const int r = it - N0, w = r / I_SQ, ii = r % I_SQ; const GAS float* src = ((const GAS float*)a.in[16 + w]) + (size_t)l * D * D; GAS unsigned char* dst = (GAS unsigned char*)(ws + (w == 0 ? W_A : (w == 1 ? W_B : W_O)));
            transpose_item8(src, D, dst, D, 1, 0, scr, ii, F.lane); }
        else if (it < N2) { const int r = it - N1, e = r / I_E1, ii = r % I_E1; transpose_item8(((const GAS float*)a.in[23]) + ((size_t)l * NE + e) * D * DE, DE, (GAS unsigned char*)(ws + W_E13) + (size_t)e * 512 * D, D, 2, 0, scr, ii, F.lane); }
        else if (it < N3) { const int r = it - N2, e = r / I_E1, ii = r % I_E1; transpose_item8(((const GAS float*)a.in[24]) + ((size_t)l * NE + e) * D * DE, DE, (GAS unsigned char*)(ws + W_E13) + (size_t)e * 512 * D, D, 2, 1, scr, ii, F.lane); }
        else if (it < N4) { const int r = it - N3, w = r / I_E1, ii = r % I_E1; transpose_item8(((const GAS float*)a.in[26 + w]) + (size_t)l * D * DE, DE, (GAS unsigned char*)(ws + W_E13) + (size_t)64 * 512 * D, D, 2, w, scr, ii, F.lane); }
        else if (it < N5) { const int r = it - N4, e = r / I_E2, ii = r % I_E2; transpose_item8(((const GAS float*)a.in[25]) + ((size_t)l * NE + e) * DE * D, D, (GAS unsigned char*)(ws + W_E2) + (size_t)e * D * DE, DE, 1, 0, scr, ii, F.lane, SC_W2); }
        else if (it < N6) { const int ii = it - N5; transpose_item8(((const GAS float*)a.in[28]) + (size_t)l * DE * D, D, (GAS unsigned char*)(ws + W_E2) + (size_t)64 * D * DE, DE, 1, 0, scr, ii, F.lane, SC_W2); }
        else if (it < N7) { const int r = it - N6, h = r / I_RG, ii = r % I_RG; transpose_item(((const GAS float*)a.in[11]) + ((size_t)l * 8 + h) * 128 * 128, 128, (GAS bf16_t*)(ws + W_RGA) + (size_t)h * 128 * 128, 128, 1, 0, scr, ii, F.lane); }
        else { const int r = it - N7, h = r / I_RG, ii = r % I_RG; transpose_item(((const GAS float*)a.in[13]) + ((size_t)l * 8 + h) * 128 * 128, 128, (GAS bf16_t*)(ws + W_RGX) + (size_t)h * 128 * 128, 128, 1, 0, scr, ii, F.lane); }
    }
    const int gt = F.vcu * 512 + F.tid, NGT = F.G * 512;
    for (int i = gt; i < 8 * 128 * 128; i += NGT) { const int s = i & 127, t = (i >> 7) & 127; const float v = ((const GAS float*)a.in[7])[(size_t)l * 8 * 128 * 128 + i];
        ((GAS bf16_t*)(ws + W_SG))[i] = (bf16_t)(cvt_pk_bf16(s <= t ? v : 0.f, 0.f) & 0xffffu); }
    for (int i = gt; i < 64 * 1024; i += NGT) { const int c = i >> 6, e = i & 63; const float v = ((const GAS float*)a.in[21])[(size_t)l * D * 64 + i];
        const unsigned hi = cvt_pk_bf16(v, 0.f) & 0xffffu; const float r = v - __uint_as_float(hi << 16);
        ((GAS bf16_t*)(ws + W_RH))[e * D + c] = (bf16_t)hi; ((GAS bf16_t*)(ws + W_RL))[e * D + c] = (bf16_t)(cvt_pk_bf16(r, 0.f) & 0xffffu); }
    for (int i = gt; i < D; i += NGT) ((GAS float*)(ws + WS_MISC))[i] = 8.0f * log1pf(expf(-((const GAS float*)a.in[15])[(size_t)l * D + i]));
}

__device__ __forceinline__ void ada_phase(const Frame& F, const Args& a) {
    LAS float* sc = (LAS float*)F.lds;
    LAS float* red = (LAS float*)(F.lds + 65536);
    bool loaded = false;
    for (int u = F.vcu; u < 4 * 96; u += F.G) {
        if (!loaded) { for (int i = F.tid; i < 16 * D; i += 512) { const int b = i >> 10, k = i & 1023; const float v = ((const GAS float*)a.in[1])[i]; sc[k * 16 + b] = v * fsigmoid(v); } loaded = true; __syncthreads(); }
        const int l = u / 96, j0 = (u % 96) * 64, jj = F.tid & 63, ks = F.tid >> 6;
        float acc[16];
#pragma unroll
        for (int b = 0; b < 16; ++b) acc[b] = 0.f;
        const GAS float* wp = ((const GAS float*)a.in[2]) + ((size_t)l * D + ks * 128) * NIN + j0 + jj;
#pragma unroll 4
        for (int k = 0; k < 128; ++k) { const float w = wp[(size_t)k * NIN]; const LAS f32x4* s4 = (const LAS f32x4*)(sc + (ks * 128 + k) * 16);
#pragma unroll
            for (int q = 0; q < 4; ++q) { const f32x4 sv = s4[q]; acc[4 * q] += sv[0] * w; acc[4 * q + 1] += sv[1] * w; acc[4 * q + 2] += sv[2] * w; acc[4 * q + 3] += sv[3] * w; } }
#pragma unroll
        for (int b = 0; b < 16; ++b) red[(ks * 16 + b) * 64 + jj] = acc[b];
        __syncthreads();
#pragma unroll
        for (int p = 0; p < 2; ++p) { const int o = F.tid + 512 * p, b = o >> 6, j = o & 63; float s = 0.f;
#pragma unroll
            for (int k2 = 0; k2 < 8; ++k2) s += red[(k2 * 16 + b) * 64 + j];
            ((GAS float*)(F.ws + WS_ADA))[((size_t)l * 16 + b) * NIN + j0 + j] = s + ((const GAS float*)a.in[3])[(size_t)l * NIN + j0 + j]; }
        __syncthreads();
    }
}

__device__ __forceinline__ void modulate0(const Frame& F, const Args& a) {
    const GAS float* ada = (const GAS float*)(F.ws + WS_ADA); GAS unsigned char* H = (GAS unsigned char*)(F.ws + B_H8);
    const size_t NG = (size_t)T * D / 8;
    for (size_t i = (size_t)F.vcu * 512 + F.tid; i < NG; i += (size_t)F.G * 512) {
        const size_t t = i >> 7; const int c = (int)(i & 127) * 8; const int b = (int)(t >> 12);
        const GAS float* xp = ((const GAS float*)a.in[0]) + t * D + c; const f32x4 x0 = *(const GAS f32x4*)xp, x1 = *(const GAS f32x4*)(xp + 4);
        const GAS float* sh = ada + (size_t)b * NIN + c; const f32x4 h0 = *(const GAS f32x4*)sh, h1 = *(const GAS f32x4*)(sh + 4), s0 = *(const GAS f32x4*)(sh + D), s1 = *(const GAS f32x4*)(sh + D + 4);
        const f32x4 r0 = (x0 * (s0 + 1.0f) + h0) * SC_H, r1 = (x1 * (s1 + 1.0f) + h1) * SC_H;
        u32x2 o; o.x = pk4_fp8(r0[0], r0[1], r0[2], r0[3]); o.y = pk4_fp8(r1[0], r1[1], r1[2], r1[3]);
        *(GAS u32x2*)(H + t * D + c) = o;
    }
}


__device__ __forceinline__ void vstats_phase(const Frame& F) {
    const GAS unsigned char* V = (const GAS unsigned char*)(F.ws + B_V); GAS f32x2* vs = (GAS f32x2*)(F.ws + WS_VSTAT);
    const int gw = F.vcu * NWAVES + F.wave, NGW = F.G * NWAVES;
    for (int row = gw; row < T; row += NGW) {
        const u32x4 rw = *(const GAS u32x4*)(V + (size_t)row * D + 16 * F.lane); float f[16];
        { float t8[8]; unpack8_fp8((u32x2){rw.x, rw.y}, t8);
#pragma unroll
          for (int j = 0; j < 8; ++j) f[j] = t8[j] * (1.0f / SC_Z);
          unpack8_fp8((u32x2){rw.z, rw.w}, t8);
#pragma unroll
          for (int j = 0; j < 8; ++j) f[8 + j] = t8[j] * (1.0f / SC_Z); }
        float s = 0.f;
#pragma unroll
        for (int j = 0; j < 16; ++j) s += f[j];
        const float mean = wave_sum(s) * (1.0f / D); float q = 0.f;
#pragma unroll
        for (int j = 0; j < 16; ++j) { const float d = f[j] - mean; q += d * d; }
        const float rstd = rsqrtf(wave_sum(q) * (1.0f / D) + LN_EPS);
        if (F.lane == 0) vs[row] = (f32x2){mean, rstd};
    }
}

__device__ __forceinline__ void vstat_row(const u32x4 rw, GAS f32x2* dst, int lane) {
    float f[16];
    { float t8[8]; unpack8_fp8((u32x2){rw.x, rw.y}, t8);
#pragma unroll
      for (int j = 0; j < 8; ++j) f[j] = t8[j] * (1.0f / SC_Z);
      unpack8_fp8((u32x2){rw.z, rw.w}, t8);
#pragma unroll
      for (int j = 0; j < 8; ++j) f[8 + j] = t8[j] * (1.0f / SC_Z); }
    float s = 0.f;
#pragma unroll
    for (int j = 0; j < 16; ++j) s += f[j];
    const float mean = wave_sum(s) * (1.0f / D); float q = 0.f;
#pragma unroll
    for (int j = 0; j < 16; ++j) { const float d = f[j] - mean; q += d * d; }
    const float rstd = rsqrtf(wave_sum(q) * (1.0f / D) + LN_EPS);
    if (lane == 0) *dst = (f32x2){mean, rstd};
}
__device__ __forceinline__ void rg_phase(const Frame& F, const Args& a, int l) {
    LAS unsigned char* lds = F.lds; const int tid0 = F.tid, wid = F.wave, wr = wid >> 2, wc = wid & 3;
    GAS unsigned char* ws = F.ws;
    const int hd = F.vcu & 7, g0 = F.vcu >> 3, gstep = F.G >> 3;
    const GAS bf16_t* RI = (const GAS bf16_t*)(ws + B_RI);
    GAS bf16_t* HL = (GAS bf16_t*)(ws + B_HL); GAS bf16_t* CA = (GAS bf16_t*)(ws + B_CA);
    LAS unsigned char* At = lds;
    LAS float* CST = (LAS float*)(lds + 143360);
    const int c0 = hd * 128 + (tid0 & 15) * 8;
    __syncthreads();
    for (int i = tid0; i < 8 * 128; i += 512) { const int r = i >> 7, c = hd * 128 + (i & 127); float v;
        if (r < 4) v = ((const GAS float*)a.in[9])[((size_t)l * 4 + r) * D + c] * (1.0f / SC_Z); else if (r == 4) v = ((const GAS float*)a.in[10])[(size_t)l * D + c];
        else if (r == 5) v = ((const GAS float*)a.in[12])[(size_t)l * D + c]; else if (r == 6) v = ((const GAS float*)a.in[14])[(size_t)l * D + c]; else v = ((const GAS float*)(ws + WS_MISC))[c];
        CST[i] = v; }
    bf16x8 ba[2][4], bx[2][4];
#pragma unroll
    for (int n = 0; n < 2; ++n)
#pragma unroll
        for (int kk = 0; kk < 4; ++kk) { const size_t o = ((size_t)hd * 128 + wc * 32 + n * 16 + (tid0 & 15)) * 128 + kk * 32 + ((tid0 & 63) >> 4) * 8;
            ba[n][kk] = *(const GAS bf16x8*)((const GAS bf16_t*)(ws + W_RGA) + o); bx[n][kk] = *(const GAS bf16x8*)((const GAS bf16_t*)(ws + W_RGX) + o); }
    __syncthreads();
    u32x2 rv[4][4];
    const __amdgpu_buffer_rsrc_t rsRI = __builtin_amdgcn_make_buffer_rsrc((void*)(a.ws + B_RI), 0, 0x4000000, 0x00020000);
    const __amdgpu_buffer_rsrc_t rsHL = __builtin_amdgcn_make_buffer_rsrc((void*)(a.ws + B_HL), 0, 0x8000000, 0x00020000);
    const __amdgpu_buffer_rsrc_t rsCA = __builtin_amdgcn_make_buffer_rsrc((void*)(a.ws + B_CA), 0, 0x8000000, 0x00020000);
    const int vo = ((tid0 >> 4) * D + c0) * 2;
#define RG_LOAD(gc_) do { const int _nch = (gc_) & 31; const int _t0 = (gc_) * 128; \
        _Pragma("unroll") for (int p = 0; p < 4; ++p) { const int t = (tid0 >> 4) + 32 * p; \
            _Pragma("unroll") for (int k = 0; k < 4; ++k) { const int tt = t - 3 + k; rv[p][k] = (u32x2){0u, 0u}; \
                if (tt >= 0 || _nch > 0) rv[p][k] = __builtin_amdgcn_raw_buffer_load_b64(rsRI, vo >> 1, (_t0 + 32 * p + k - 3) * D, 0); } } } while (0)
    if (g0 < 512) RG_LOAD(g0);
    for (int gc = g0; gc < 512; gc += gstep) {
        const size_t t0 = (size_t)gc * 128;
        int tq = tid0; asm volatile("" : "+v"(tq));
        const int tid = tq, lane = tq & 63, fr = lane & 15, fq = lane >> 4, cb = tq & 15;
        const int vit = (gc - g0) / gstep; const size_t vrow = (size_t)(F.vcu * NWAVES + wid) * 32 + 2 * vit;
        const u32x4 vsa = *(const GAS u32x4*)((const GAS unsigned char*)(ws + B_V) + vrow * D + 16 * lane), vsb = *(const GAS u32x4*)((const GAS unsigned char*)(ws + B_V) + (vrow + 1) * D + 16 * lane);
#pragma unroll
        for (int p = 0; p < 4; ++p) { const int t = (tid >> 4) + 32 * p; float r[8];
            { const f32x4 b0 = *(const LAS f32x4*)(CST + 4 * 128 + cb * 8), b1 = *(const LAS f32x4*)(CST + 4 * 128 + cb * 8 + 4);
#pragma unroll
              for (int j = 0; j < 4; ++j) { r[j] = b0[j]; r[4 + j] = b1[j]; } }
#pragma unroll
            for (int k = 0; k < 4; ++k) { float v[8]; unpack8_fp8(rv[p][k], v); const f32x4 w0 = *(const LAS f32x4*)(CST + k * 128 + cb * 8), w1 = *(const LAS f32x4*)(CST + k * 128 + cb * 8 + 4);
#pragma unroll
                for (int j = 0; j < 4; ++j) { r[j] += w0[j] * v[j]; r[4 + j] += w1[j] * v[4 + j]; } }
            *(LAS u32x4*)(At + t * 272 + cb * 16) = pack8(r); }
        __syncthreads();
        f32x4 ga[4][2], gx[4][2];
#pragma unroll
        for (int m = 0; m < 4; ++m)
#pragma unroll
            for (int n = 0; n < 2; ++n) { ga[m][n] = (f32x4){0.f, 0.f, 0.f, 0.f}; gx[m][n] = (f32x4){0.f, 0.f, 0.f, 0.f}; }
#pragma unroll
        for (int kk = 0; kk < 4; ++kk) { bf16x8 af[4];
#pragma unroll
            for (int m = 0; m < 4; ++m) af[m] = *(const LAS bf16x8*)(At + (wr * 64 + m * 16 + fr) * 272 + (kk * 32 + fq * 8) * 2);
#pragma unroll
            for (int m = 0; m < 4; ++m)
#pragma unroll
                for (int n = 0; n < 2; ++n) { ga[m][n] = __builtin_amdgcn_mfma_f32_16x16x32_bf16(ba[n][kk], af[m], ga[m][n], 0, 0, 0); gx[m][n] = __builtin_amdgcn_mfma_f32_16x16x32_bf16(bx[n][kk], af[m], gx[m][n], 0, 0, 0); } }
#pragma unroll
        for (int n = 0; n < 2; ++n) { const int j0 = wc * 32 + n * 16 + 4 * fq;
            const f32x4 bav = *(const LAS f32x4*)(CST + 5 * 128 + j0), bxv = *(const LAS f32x4*)(CST + 6 * 128 + j0), spv = *(const LAS f32x4*)(CST + 7 * 128 + j0);
#pragma unroll
            for (int m = 0; m < 4; ++m) { const int t = wr * 64 + m * 16 + fr; const u32x2 rw = *(const LAS u32x2*)(At + t * 272 + j0 * 2);
                const float rin[4] = {bf_lo(rw.x), bf_hi(rw.x), bf_lo(rw.y), bf_hi(rw.y)};
#pragma unroll
                for (int r = 0; r < 4; ++r) { const float rg = fsigmoid(ga[m][n][r] + bav[r]), ig = fsigmoid(gx[m][n][r] + bxv[r]);
                    const float av = __builtin_amdgcn_exp2f(-(spv[r] * LOG2E) * rg);
                    const float om = 1.0f - av * av;
                    ga[m][n][r] = av; gx[m][n][r] = sqrtf(fmaxf(om, 0.f)) * ig * rin[r]; } } }
        __syncthreads();
        LAS float* PA = (LAS float*)lds; LAS float* PI = (LAS float*)(lds + 67584);
#pragma unroll
        for (int m = 0; m < 4; ++m)
#pragma unroll
            for (int n = 0; n < 2; ++n) { const int t = wr * 64 + m * 16 + fr, j0 = wc * 32 + n * 16 + 4 * fq; *(LAS f32x4*)(PA + t * 132 + j0) = ga[m][n]; *(LAS f32x4*)(PI + t * 132 + j0) = gx[m][n]; }
        __syncthreads();
        vstat_row(vsa, (GAS f32x2*)(ws + WS_VSTAT) + vrow, lane); vstat_row(vsb, (GAS f32x2*)(ws + WS_VSTAT) + vrow + 1, lane);
        if (gc + gstep < 512) RG_LOAD(gc + gstep);
        LAS f32x2* SE = (LAS f32x2*)(lds + 135168); LAS float* CRC = (LAS float*)(lds + 135168 + 4096); LAS float* CRH = CRC + 512;
        const int c = tid & 127, seg = tid >> 7; float h = 0.f, cum = 1.f;
#pragma unroll 8
        for (int tt = 0; tt < 32; ++tt) { const int t = seg * 32 + tt; const float av = PA[t * 132 + c], xv = PI[t * 132 + c]; h = av * h + xv; cum *= av; PI[t * 132 + c] = h; PA[t * 132 + c] = cum; }
        SE[seg * 128 + c] = (f32x2){cum, h};
        __syncthreads();
        { float ch = 0.f, cc = 1.f;
          for (int sg2 = 0; sg2 < seg; ++sg2) { const f32x2 e = SE[sg2 * 128 + c]; ch = e.x * ch + e.y; cc *= e.x; }
          CRC[seg * 128 + c] = cc; CRH[seg * 128 + c] = ch;
          if (seg == 3) { GAS float* cr = (GAS float*)(ws + WS_CARRY) + (size_t)gc * 2 * D + hd * 128 + c; cr[0] = cum * cc; cr[D] = h + cum * ch; } }
        __syncthreads();
#pragma unroll 1
        for (int p = 0; p < 4; ++p) { const int t = (tid >> 4) + 32 * p, sg = t >> 5; float oh[8], oc[8];
            { const f32x4 cu0 = *(const LAS f32x4*)(PA + t * 132 + cb * 8), cu1 = *(const LAS f32x4*)(PA + t * 132 + cb * 8 + 4), hv0 = *(const LAS f32x4*)(PI + t * 132 + cb * 8), hv1 = *(const LAS f32x4*)(PI + t * 132 + cb * 8 + 4);
              const f32x4 cc0 = *(const LAS f32x4*)(CRC + sg * 128 + cb * 8), cc1 = *(const LAS f32x4*)(CRC + sg * 128 + cb * 8 + 4), ch0 = *(const LAS f32x4*)(CRH + sg * 128 + cb * 8), ch1 = *(const LAS f32x4*)(CRH + sg * 128 + cb * 8 + 4);
              const f32x4 h0 = hv0 + cu0 * ch0, h1 = hv1 + cu1 * ch1, c0v = cu0 * cc0, c1v = cu1 * cc1;
#pragma unroll
              for (int j = 0; j < 4; ++j) { oh[j] = h0[j]; oh[4 + j] = h1[j]; oc[j] = c0v[j]; oc[4 + j] = c1v[j]; } }
            { u32x2 wh8, wc8; wh8.x = pk4_fp8(oh[0] * SC_HL, oh[1] * SC_HL, oh[2] * SC_HL, oh[3] * SC_HL); wh8.y = pk4_fp8(oh[4] * SC_HL, oh[5] * SC_HL, oh[6] * SC_HL, oh[7] * SC_HL);
              wc8.x = pk4_fp8(oc[0] * SC_CA, oc[1] * SC_CA, oc[2] * SC_CA, oc[3] * SC_CA); wc8.y = pk4_fp8(oc[4] * SC_CA, oc[5] * SC_CA, oc[6] * SC_CA, oc[7] * SC_CA);
              __builtin_amdgcn_raw_buffer_store_b64(wh8, rsHL, vo >> 1, ((int)t0 + 32 * p) * D, 0); __builtin_amdgcn_raw_buffer_store_b64(wc8, rsCA, vo >> 1, ((int)t0 + 32 * p) * D, 0); } }
        __syncthreads();
    }
#undef RG_LOAD
}

__device__ __forceinline__ void sgu_phase(const Frame& F, const Args& a, int l) {
    LAS unsigned char* lds = F.lds; const int tid0 = F.tid, wid = F.wave, wr = wid >> 2, wc = wid & 3;
    GAS unsigned char* ws = F.ws;
    const int g = F.vcu & 7, g0 = F.vcu >> 3, gstep = F.G >> 3;
    const GAS unsigned char* U = (const GAS unsigned char*)(ws + B_U); GAS unsigned char* YA = (GAS unsigned char*)(ws + B_YA8); const GAS unsigned char* V = (const GAS unsigned char*)(ws + B_V); const GAS f32x2* vs = (const GAS f32x2*)(ws + WS_VSTAT);
    LAS unsigned char* Wt = lds; LAS unsigned char* Vs = lds + 34816;
    float gam[8], bet[8], bsr[4];
    { const int cb0 = tid0 & 15, c00 = g * 128 + cb0 * 8;
      const GAS float* p = ((const GAS float*)a.in[5]) + (size_t)l * D + c00; const f32x4 w0 = *(const GAS f32x4*)p, w1 = *(const GAS f32x4*)(p + 4); const GAS float* q = ((const GAS float*)a.in[6]) + (size_t)l * D + c00; const f32x4 b0 = *(const GAS f32x4*)q, b1 = *(const GAS f32x4*)(q + 4);
#pragma unroll
      for (int j = 0; j < 4; ++j) { gam[j] = w0[j] * (1.0f / SC_Z); gam[4 + j] = w1[j] * (1.0f / SC_Z); bet[j] = b0[j]; bet[4 + j] = b1[j]; }
#pragma unroll
      for (int m = 0; m < 4; ++m) bsr[m] = ((const GAS float*)a.in[8])[((size_t)l * 8 + g) * 128 + wr * 64 + m * 16 + (tid0 & 15)];
      __syncthreads();
#pragma unroll
      for (int p2 = 0; p2 < 4; ++p2) { const int row = (tid0 >> 4) + 32 * p2;
        *(LAS u32x4*)(Wt + row * 272 + cb0 * 16) = *(const GAS u32x4*)((const GAS bf16_t*)(ws + W_SG) + ((size_t)g * 128 + row) * 128 + cb0 * 8); } }
    u32x2 vraw[4]; f32x2 stv[4]; u32x2 uraw[4];
#define SG_LOAD(gc_) do { const size_t _t0 = (size_t)(gc_) * 128; \
        _Pragma("unroll") for (int p2 = 0; p2 < 4; ++p2) { const int row = (tid0 >> 4) + 32 * p2; vraw[p2] = *(const GAS u32x2*)(V + (_t0 + row) * D + g * 128 + (tid0 & 15) * 8); stv[p2] = vs[_t0 + row]; } \
        _Pragma("unroll") for (int m = 0; m < 4; ++m) uraw[m] = *(const GAS u32x2*)(U + (_t0 + wr * 64 + m * 16 + (tid0 & 15)) * D + g * 128 + wc * 32 + 8 * ((tid0 & 63) >> 4)); } while (0)
    if (g0 < 512) SG_LOAD(g0);
    for (int gc = g0; gc < 512; gc += gstep) {
        const size_t t0 = (size_t)gc * 128;
        int tq = tid0; asm volatile("" : "+v"(tq));
        const int lane = tq & 63, fr = lane & 15, fq = lane >> 4, cb = tq & 15;
#pragma unroll
        for (int p2 = 0; p2 < 4; ++p2) { const int row = (tq >> 4) + 32 * p2; float v[8]; unpack8_fp8(vraw[p2], v); const float ms = stv[p2].x * SC_Z, rs = stv[p2].y;
#pragma unroll
            for (int j = 0; j < 8; ++j) v[j] = (v[j] - ms) * rs * gam[j] + bet[j];
            const u32x4 o = pack8(v); *(LAS u32x2*)(Vs + row * 264 + cb * 16) = (u32x2){o.x, o.y}; *(LAS u32x2*)(Vs + row * 264 + cb * 16 + 8) = (u32x2){o.z, o.w}; }
        u32x2 ucur[4];
#pragma unroll
        for (int m = 0; m < 4; ++m) ucur[m] = uraw[m];
        __syncthreads();
        if (gc + gstep < 512) SG_LOAD(gc + gstep);
        f32x4 acc[4][2];
#pragma unroll
        for (int m = 0; m < 4; ++m)
#pragma unroll
            for (int n = 0; n < 2; ++n) acc[m][n] = (f32x4){0.f, 0.f, 0.f, 0.f};
#pragma unroll
        for (int kk = 0; kk < 4; ++kk) {
            bf16x8 af[4], bfr[2];
#pragma unroll
            for (int m = 0; m < 4; ++m) af[m] = *(const LAS bf16x8*)(Wt + (wr * 64 + m * 16 + fr) * 272 + (kk * 32 + fq * 8) * 2);
#pragma unroll
            for (int n = 0; n < 2; ++n) { const int cc = wc * 32 + 8 * (fr >> 2) + 4 * n + (fr & 3);
#pragma unroll
                for (int e = 0; e < 8; ++e) bfr[n][e] = (short)*(const LAS unsigned short*)(Vs + (kk * 32 + fq * 8 + e) * 264 + cc * 2); }
#pragma unroll
            for (int m = 0; m < 4; ++m)
#pragma unroll
                for (int n = 0; n < 2; ++n) acc[m][n] = __builtin_amdgcn_mfma_f32_16x16x32_bf16(bfr[n], af[m], acc[m][n], 0, 0, 0);
        }
#pragma unroll
        for (int m = 0; m < 4; ++m) { const int t = wr * 64 + m * 16 + fr; const float bs = bsr[m]; const size_t eo = (t0 + t) * D + g * 128 + wc * 32 + 8 * fq; float uf[8]; unpack8_fp8(ucur[m], uf);
            u32x2 o; o.x = pk4_fp8(uf[0] * (acc[m][0][0] + bs) * (SC_Y / SC_Z), uf[1] * (acc[m][0][1] + bs) * (SC_Y / SC_Z), uf[2] * (acc[m][0][2] + bs) * (SC_Y / SC_Z), uf[3] * (acc[m][0][3] + bs) * (SC_Y / SC_Z));
            o.y = pk4_fp8(uf[4] * (acc[m][1][0] + bs) * (SC_Y / SC_Z), uf[5] * (acc[m][1][1] + bs) * (SC_Y / SC_Z), uf[6] * (acc[m][1][2] + bs) * (SC_Y / SC_Z), uf[7] * (acc[m][1][3] + bs) * (SC_Y / SC_Z));
            *(GAS u32x2*)(YA + eo) = o; }
        __syncthreads();
    }
#undef SG_LOAD
}

__device__ __forceinline__ void scanfix_unit(const Frame& F, int gc) {
    GAS unsigned char* ws = F.ws; const int tid = F.tid;
    const GAS unsigned char* RG = (const GAS unsigned char*)(ws + B_RG); GAS unsigned char* YB = (GAS unsigned char*)(ws + B_YB8); const GAS unsigned char* HL = (const GAS unsigned char*)(ws + B_HL); const GAS unsigned char* CA = (const GAS unsigned char*)(ws + B_CA);
    LAS float* hin = (LAS float*)F.lds;
    const int nch = gc & 31, cbk = tid & 63, tseg = tid >> 6;
    if (tid < 128) { float h[8];
#pragma unroll
        for (int j = 0; j < 8; ++j) h[j] = 0.f;
        const GAS float* cr = (const GAS float*)(ws + WS_CARRY) + (size_t)(gc - nch) * 2 * D + tid * 8;
        for (int n = 0; n < nch; ++n) { const f32x4 p0 = *(const GAS f32x4*)(cr + (size_t)n * 2 * D), p1 = *(const GAS f32x4*)(cr + (size_t)n * 2 * D + 4), h0 = *(const GAS f32x4*)(cr + (size_t)n * 2 * D + D), h1 = *(const GAS f32x4*)(cr + (size_t)n * 2 * D + D + 4);
#pragma unroll
            for (int j = 0; j < 4; ++j) { h[j] = p0[j] * h[j] + h0[j]; h[4 + j] = p1[j] * h[4 + j] + h1[j]; } }
#pragma unroll
        for (int j = 0; j < 8; ++j) hin[tid * 8 + j] = h[j] * (1.0f / SC_CA); }
    __syncthreads();
    float hi[16];
#pragma unroll
    for (int j = 0; j < 16; ++j) hi[j] = hin[cbk * 16 + j];
    const size_t base = ((size_t)gc * 128 + tseg * 16) * D + cbk * 16;
    u32x4 rg[4], hl[4], ca[4];
#define SF_LOAD(t0_) do { _Pragma("unroll") for (int q = 0; q < 4; ++q) { const size_t o = base + (size_t)((t0_) + q) * D; rg[q] = *(const GAS u32x4*)(RG + o); hl[q] = *(const GAS u32x4*)(HL + o); ca[q] = *(const GAS u32x4*)(CA + o); } } while (0)
    SF_LOAD(0);
    for (int tb = 0; tb < 16; tb += 4) {
        u32x4 w[4];
#pragma unroll
        for (int q = 0; q < 4; ++q) { float g[16], h[16], c[16]; unpack16_fp8(rg[q], g); unpack16_fp8(hl[q], h); unpack16_fp8(ca[q], c);
#pragma unroll
            for (int j = 0; j < 16; ++j) g[j] = g[j] * (h[j] * (1.0f / SC_HL) + c[j] * hi[j]) * (SC_Y / SC_Z);
            w[q].x = pk4_fp8(g[0], g[1], g[2], g[3]); w[q].y = pk4_fp8(g[4], g[5], g[6], g[7]); w[q].z = pk4_fp8(g[8], g[9], g[10], g[11]); w[q].w = pk4_fp8(g[12], g[13], g[14], g[15]); }
        if (tb + 4 < 16) SF_LOAD(tb + 4);
#pragma unroll
        for (int q = 0; q < 4; ++q) *(GAS u32x4*)(YB + base + (size_t)(tb + q) * D) = w[q];
    }
#undef SF_LOAD
    __syncthreads();
}

__device__ __forceinline__ void ln1_route_phase(const Frame& F, const Args& a, int l) {
    LAS unsigned char* lds = F.lds; const int tid = F.tid, lane = F.lane, wid = F.wave, fr = lane & 15, fq = lane >> 4;
    GAS unsigned char* ws = F.ws;
    LAS float* VEC = (LAS float*)lds;
    LAS float* LG = (LAS float*)(lds + 16384);
    LAS float* ST = (LAS float*)(lds + 49664);
    LAS float* RB = (LAS float*)(lds + 50688);
    LAS int* LCNT = (LAS int*)(lds + 50944);
    LAS int* GBS = (LAS int*)(lds + 51200);
    LAS int* AE = (LAS int*)(lds + 51456);
    LAS int* AR = (LAS int*)(lds + 55552);
    LAS float* AW = (LAS float*)(lds + 59648);
    LAS float* STG = (LAS float*)(lds + 65536);
    const __amdgpu_buffer_rsrc_t rsX = __builtin_amdgcn_make_buffer_rsrc((void*)a.out, 0, T * D * 2, 0x00020000);
    const __amdgpu_buffer_rsrc_t rsXO = __builtin_amdgcn_make_buffer_rsrc(l == DEPTH - 1 ? (void*)(a.ws + B_XL) : (void*)a.out, 0, T * D * 2, 0x00020000);
    const __amdgpu_buffer_rsrc_t rsH = __builtin_amdgcn_make_buffer_rsrc((void*)(a.ws + B_H8), 0, T * D, 0x00020000);
    bf16x8 wh[4][4], wl[4][4];
#pragma unroll
    for (int kq = 0; kq < 4; ++kq)
#pragma unroll
        for (int n = 0; n < 4; ++n) { const size_t o = (size_t)(n * 16 + fr) * D + wid * 128 + kq * 32 + fq * 8;
            wh[kq][n] = *(const GAS bf16x8*)((const GAS bf16_t*)(ws + W_RH) + o); wl[kq][n] = *(const GAS bf16x8*)((const GAS bf16_t*)(ws + W_RL) + o); }
    for (int unit = F.vcu; unit < T / 128; unit += F.G) {
    const int r0 = unit * 128, b = r0 >> 12, slab = r0 / SLAB_T;
    int tq = tid; asm volatile("" : "+v"(tq));
    const GAS float* ada = (const GAS float*)(ws + WS_ADA) + ((size_t)l * 16 + b) * NIN;
    __syncthreads();
    for (int i = tq; i < D; i += 512) { VEC[i] = ((const GAS float*)a.in[19])[(size_t)l * D + i]; VEC[D + i] = ((const GAS float*)a.in[20])[(size_t)l * D + i]; VEC[2 * D + i] = 1.0f + ada[4 * D + i]; VEC[3 * D + i] = ada[3 * D + i]; }
    if (tq < 64) { RB[tq] = ((const GAS float*)a.in[22])[(size_t)l * 64 + tq]; LCNT[tq] = 0; }
    if (tq < 128) { const GAS f32x4* ps = (const GAS f32x4*)((const GAS float*)(ws + WS_PSTAT) + (size_t)(r0 + tq) * 32); float sm = 0.f, q = 0.f;
#pragma unroll
        for (int j = 0; j < 8; ++j) { const f32x4 p4 = ps[j]; sm += p4[0] + p4[2]; q += p4[1] + p4[3]; }
        const float mean = sm * (1.0f / D), var = fmaxf(q * (1.0f / D) - mean * mean, 0.f); ST[2 * tq] = mean; ST[2 * tq + 1] = rsqrtf(var + LN_EPS); }
    __syncthreads();
    {
        const int vo = ((r0 + fr) * D + wid * 128 + fq * 8) * 2, ho = (r0 + fr) * D + wid * 128 + fq * 8;
#define T6_LD(dst, st_) do { const int _s = (st_) < 32 ? (st_) : 31; dst = __builtin_amdgcn_raw_buffer_load_b128(rsX, vo, ((_s >> 2) * 16 * D + (_s & 3) * 32) * 2, 0); } while (0)
#define T6_STEP(st_, xr_) do { const int rt_ = (st_) >> 2, kq_ = (st_) & 3; const int c = wid * 128 + kq_ * 32 + fq * 8; \
        const float mean = ST[2 * (rt_ * 16 + fr)], rstd = ST[2 * (rt_ * 16 + fr) + 1]; \
        const f32x4 g0 = *(const LAS f32x4*)(VEC + c), g1 = *(const LAS f32x4*)(VEC + c + 4), b0 = *(const LAS f32x4*)(VEC + D + c), b1 = *(const LAS f32x4*)(VEC + D + c + 4); \
        const f32x4 s0 = *(const LAS f32x4*)(VEC + 2 * D + c), s1 = *(const LAS f32x4*)(VEC + 2 * D + c + 4), h0 = *(const LAS f32x4*)(VEC + 3 * D + c), h1 = *(const LAS f32x4*)(VEC + 3 * D + c + 4); \
        float xf_[8]; unpack8(xr_, xf_); const f32x4 xq0 = (f32x4){xf_[0], xf_[1], xf_[2], xf_[3]}, xq1 = (f32x4){xf_[4], xf_[5], xf_[6], xf_[7]}; \
        const f32x4 n0 = (xq0 - mean) * rstd * g0 + b0, n1 = (xq1 - mean) * rstd * g1 + b1; \
        { u32x4 xw; xw.x = cvt_pk_bf16(n0[0], n0[1]); xw.y = cvt_pk_bf16(n0[2], n0[3]); xw.z = cvt_pk_bf16(n1[0], n1[1]); xw.w = cvt_pk_bf16(n1[2], n1[3]); __builtin_amdgcn_raw_buffer_store_b128(xw, rsXO, vo, (rt_ * 16 * D + kq_ * 32) * 2, 0); } \
        const f32x4 f0 = n0 * s0 + h0, f1 = n1 * s1 + h1; \
        u32x4 hi; hi.x = cvt_pk_bf16(f0[0], f0[1]); hi.y = cvt_pk_bf16(f0[2], f0[3]); hi.z = cvt_pk_bf16(f1[0], f1[1]); hi.w = cvt_pk_bf16(f1[2], f1[3]); \
        { u32x2 h8; h8.x = pk4_fp8(f0[0] * SC_H, f0[1] * SC_H, f0[2] * SC_H, f0[3] * SC_H); h8.y = pk4_fp8(f1[0] * SC_H, f1[1] * SC_H, f1[2] * SC_H, f1[3] * SC_H); __builtin_amdgcn_raw_buffer_store_b64(h8, rsH, ho, rt_ * 16 * D + kq_ * 32, 0); } \
        u32x4 lo; lo.x = cvt_pk_bf16(f0[0] - bf_lo(hi.x), f0[1] - bf_hi(hi.x)); lo.y = cvt_pk_bf16(f0[2] - bf_lo(hi.y), f0[3] - bf_hi(hi.y)); \
        lo.z = cvt_pk_bf16(f1[0] - bf_lo(hi.z), f1[1] - bf_hi(hi.z)); lo.w = cvt_pk_bf16(f1[2] - bf_lo(hi.w), f1[3] - bf_hi(hi.w)); \
        const bf16x8 ah = __builtin_bit_cast(bf16x8, hi), al = __builtin_bit_cast(bf16x8, lo); \
        _Pragma("unroll") for (int n = 0; n < 4; ++n) { \
            acc[n] = __builtin_amdgcn_mfma_f32_16x16x32_bf16(wh[kq_][n], ah, acc[n], 0, 0, 0); \
            acc[n] = __builtin_amdgcn_mfma_f32_16x16x32_bf16(wl[kq_][n], ah, acc[n], 0, 0, 0); \
            acc[n] = __builtin_amdgcn_mfma_f32_16x16x32_bf16(wh[kq_][n], al, acc[n], 0, 0, 0); } } while (0)
        u32x4 xa, xb, xc, xd;
        for (int rt = 0; rt < 8; ++rt) {
            f32x4 acc[4];
#pragma unroll
            for (int n = 0; n < 4; ++n) acc[n] = (f32x4){0.f, 0.f, 0.f, 0.f};
            T6_LD(xa, rt * 4 + 0); T6_LD(xb, rt * 4 + 1); T6_LD(xc, rt * 4 + 2); T6_LD(xd, rt * 4 + 3);
            T6_STEP(rt * 4 + 0, xa); T6_STEP(rt * 4 + 1, xb); T6_STEP(rt * 4 + 2, xc); T6_STEP(rt * 4 + 3, xd);
            { LAS float* sg = STG + ((rt & 1) * 8 + wid) * (16 * 68) + fr * 68 + 4 * fq;
#pragma unroll
              for (int n = 0; n < 4; ++n) *(LAS f32x4*)(sg + 16 * n) = acc[n]; }
            __syncthreads();
#pragma unroll
            for (int p2 = 0; p2 < 2; ++p2) { const int o = tid + 512 * p2, r = o >> 6, e = o & 63; const LAS float* sp = STG + (rt & 1) * 8 * (16 * 68) + r * 68 + e; float sum = 0.f;
#pragma unroll
                for (int w = 0; w < 8; ++w) sum += sp[w * (16 * 68)];
                LG[(rt * 16 + r) * 65 + e] = sum; }
        }
#undef T6_LD
#undef T6_STEP
    }
    __syncthreads();
    {
        const int ti = lane >> 2, sub = lane & 3, tokl = wid * 16 + ti; const LAS float* lg = LG + tokl * 65 + 16 * sub;
        float bsv[16]; float g0a = -INFINITY, g0b = -INFINITY, g1a = -INFINITY, g1b = -INFINITY;
#pragma unroll
        for (int j = 0; j < 16; ++j) { const float v = fsigmoid(lg[j]) + RB[16 * sub + j]; bsv[j] = v;
            if (j < 8) { if (v > g0a) { g0b = g0a; g0a = v; } else if (v > g0b) g0b = v; } else { if (v > g1a) { g1b = g1a; g1a = v; } else if (v > g1b) g1b = v; } }
        const float gsa = g0a + g0b, gsb = g1a + g1b;
        float gs[8];
        gs[0] = dpp_f<0x00>(gsa); gs[1] = dpp_f<0x00>(gsb); gs[2] = dpp_f<0x55>(gsa); gs[3] = dpp_f<0x55>(gsb);
        gs[4] = dpp_f<0xAA>(gsa); gs[5] = dpp_f<0xAA>(gsb); gs[6] = dpp_f<0xFF>(gsa); gs[7] = dpp_f<0xFF>(gsb);
        unsigned keep = 0u;
#pragma unroll
        for (int it = 0; it < 4; ++it) { float best = -INFINITY; int bi = 0;
#pragma unroll
            for (int g = 0; g < 8; ++g) { const bool ok = !((keep >> g) & 1u) && (gs[g] > best); best = ok ? gs[g] : best; bi = ok ? g : bi; }
            keep |= 1u << bi; }
        unsigned avail = (((keep >> (2 * sub)) & 1u) ? 0x00ffu : 0u) | (((keep >> (2 * sub + 1)) & 1u) ? 0xff00u : 0u);
        float ssum = 0.f;
#pragma unroll 1
        for (int k = 0; k < 8; ++k) { float best = -INFINITY; int bi = 1 << 20;
#pragma unroll
            for (int j = 0; j < 16; ++j) { const bool ok = ((avail >> j) & 1u) && (bsv[j] > best); best = ok ? bsv[j] : best; bi = ok ? (16 * sub + j) : bi; }
            { const float ov = dpp_f<0xB1>(best); const int oi = dpp_i<0xB1>(bi); const bool tk = (ov > best) || (ov == best && oi < bi); best = tk ? ov : best; bi = tk ? oi : bi; }
            { const float ov = dpp_f<0x4E>(best); const int oi = dpp_i<0x4E>(bi); const bool tk = (ov > best) || (ov == best && oi < bi); best = tk ? ov : best; bi = tk ? oi : bi; }
            bi &= 63;
            if ((bi >> 4) == sub) avail &= ~(1u << (bi & 15));
            const float sc = fsigmoid(LG[tokl * 65 + bi]); ssum += sc;
            if (sub == 0) { AE[tokl * 8 + k] = bi; AW[tokl * 8 + k] = sc; } }
        LDS_WAIT(); asm volatile("" ::: "memory");
        const float inv = 2.5f / ssum;
#pragma unroll
        for (int kk2 = 0; kk2 < 2; ++kk2) { const int k = sub + 4 * kk2; const int e = AE[tokl * 8 + k]; AW[tokl * 8 + k] *= inv; AR[tokl * 8 + k] = __hip_atomic_fetch_add(LCNT + e, 1, __ATOMIC_RELAXED, __HIP_MEMORY_SCOPE_WORKGROUP); }
    }
    __syncthreads();
    if (tq < 64) { const int cl = LCNT[tq]; int base = 0;
        if (cl > 0) base = (int)__hip_atomic_fetch_add((GAS unsigned*)(ws + WS_CTL) + CW_CNT + (l * NSLAB + slab) * 64 + tq, (unsigned)cl, __ATOMIC_RELAXED, __HIP_MEMORY_SCOPE_AGENT);
        GBS[tq] = base; }
    __syncthreads();
#pragma unroll
    for (int p = 0; p < 2; ++p) { const int i = tq + 512 * p, tokl = i >> 3; const int e = AE[i], pos = GBS[e] + AR[i]; const int t = r0 + tokl;
        ((GAS unsigned*)(ws + WS_TOKE))[((size_t)slab * 64 + e) * ECAP + pos] = (unsigned)(t - slab * SLAB_T);
        ((GAS float*)(ws + WS_WTE))[((size_t)slab * 64 + e) * ECAP + pos] = AW[i];
        ((GAS unsigned*)(ws + WS_POS))[(size_t)t * 8 + (i & 7)] = ((unsigned)e << 16) | (unsigned)pos; }
    __syncthreads();
    }
}

__device__ __forceinline__ int moe_setup(const Frame& F, int l, int slab) {
    LAS int* TB = (LAS int*)(F.lds + L_TBASE); LAS int* CN = (LAS int*)(F.lds + L_CNT); LAS unsigned short* TM = (LAS unsigned short*)(F.lds + L_TMAP);
    __syncthreads();
    if (F.wave == 0) {
        const int e = F.lane; const int cnt = (int)__hip_atomic_load((GAS unsigned*)(F.ws + WS_CTL) + CW_CNT + (l * NSLAB + slab) * 64 + e, __ATOMIC_RELAXED, __HIP_MEMORY_SCOPE_AGENT);
        const int ntl = (cnt + 255) >> 8; int incl = ntl;
#pragma unroll
        for (int o = 1; o < 64; o <<= 1) { const int v = __shfl_up(incl, o); if (e >= o) incl += v; }
        const int excl = incl - ntl; TB[e] = excl; CN[e] = cnt;
        const int total = __shfl(incl, 63);
        if (e == 0) { TB[64] = total; TB[65] = total + SLAB_T / 256; CN[64] = SLAB_T; }
        for (int i = excl; i < incl; ++i) TM[i] = (unsigned short)e;
        for (int i = e; i < SLAB_T / 256; i += 64) TM[total + i] = (unsigned short)64;
    }
    __syncthreads();
    return TB[65];
}

__device__ __forceinline__ void combine_phase(const Frame& F, const Args& a, int l, int slab) {
    GAS unsigned char* ws = F.ws; const LAS int* TB = (const LAS int*)(F.lds + L_TBASE);
    const GAS unsigned char* Y = (const GAS unsigned char*)(ws + B_Y);
    const GAS bf16_t* XI = (l == DEPTH - 1) ? (const GAS bf16_t*)(ws + B_XL) : (const GAS bf16_t*)a.out;
    GAS unsigned char* H = (GAS unsigned char*)(ws + B_H8);
    constexpr int TPW = SLAB_T / 2048;
    const int gw = F.vcu * NWAVES + F.wave; const int tl0 = gw * TPW; if (tl0 >= SLAB_T) return;
    const int b = (slab * SLAB_T + tl0) >> 12; const int cl = 16 * F.lane;
    const GAS float* ada = (const GAS float*)(ws + WS_ADA) + ((size_t)l * 16 + b) * NIN;
    const GAS float* adan = (const GAS float*)(ws + WS_ADA) + ((size_t)(l < DEPTH - 1 ? l + 1 : l) * 16 + b) * NIN;
    f32x4 g2[4], gm[4], bt[4], sc[4], sh[4];
#pragma unroll
    for (int j = 0; j < 4; ++j) { const int c = cl + 4 * j; g2[j] = *(const GAS f32x4*)(ada + 5 * D + c) * (1.0f / SC_YO); gm[j] = *(const GAS f32x4*)(((const GAS float*)a.in[29]) + (size_t)l * D + c); bt[j] = *(const GAS f32x4*)(((const GAS float*)a.in[30]) + (size_t)l * D + c);
        sc[j] = (*(const GAS f32x4*)(adan + D + c) + 1.0f) * SC_H; sh[j] = *(const GAS f32x4*)(adan + c) * SC_H; }
    const int shbase = TB[64] * 256;
    for (int i = 0; i < TPW; ++i) { const int tl = tl0 + i; const size_t t = (size_t)slab * SLAB_T + tl;
        const GAS unsigned* pp = (const GAS unsigned*)(ws + WS_POS) + t * 8;
        u32x4 yv[9];
#pragma unroll
        for (int k = 0; k < 9; ++k) { size_t rowi;
            if (k < 8) { const unsigned pk = (unsigned)__builtin_amdgcn_readfirstlane((int)pp[k]); rowi = (size_t)TB[pk >> 16] * 256 + (pk & 0xffffu); } else rowi = (size_t)shbase + tl;
            yv[k] = *(const GAS u32x4*)(Y + rowi * D + cl); }
        const u32x4 xr0 = *(const GAS u32x4*)(XI + t * D + cl), xr1 = *(const GAS u32x4*)(XI + t * D + cl + 8);
        f32x4 acc[4];
#pragma unroll
        for (int j = 0; j < 4; ++j) acc[j] = (f32x4){0.f, 0.f, 0.f, 0.f};
#pragma unroll
        for (int k = 0; k < 9; ++k) { const unsigned w[4] = {yv[k].x, yv[k].y, yv[k].z, yv[k].w};
#pragma unroll
            for (int j = 0; j < 4; ++j) { const f32x2 lo = __builtin_amdgcn_cvt_pk_f32_fp8((int)w[j], false), hi = __builtin_amdgcn_cvt_pk_f32_fp8((int)w[j], true); acc[j] += (f32x4){lo.x, lo.y, hi.x, hi.y}; } }
        float xf[16]; { float t8[8]; unpack8(xr0, t8);
#pragma unroll
          for (int j = 0; j < 8; ++j) xf[j] = t8[j];
          unpack8(xr1, t8);
#pragma unroll
          for (int j = 0; j < 8; ++j) xf[8 + j] = t8[j]; }
        f32x4 pre[4]; float s = 0.f;
#pragma unroll
        for (int j = 0; j < 4; ++j) { const f32x4 xv = (f32x4){xf[4 * j], xf[4 * j + 1], xf[4 * j + 2], xf[4 * j + 3]}; pre[j] = xv * ALPHA + g2[j] * acc[j]; s += (pre[j][0] + pre[j][1]) + (pre[j][2] + pre[j][3]); }
        const float mean = wave_sum(s) * (1.0f / D); float q = 0.f;
#pragma unroll
        for (int j = 0; j < 4; ++j) { pre[j] = pre[j] - mean; q += (pre[j][0] * pre[j][0] + pre[j][1] * pre[j][1]) + (pre[j][2] * pre[j][2] + pre[j][3] * pre[j][3]); }
        const float rstd = rsqrtf(wave_sum(q) * (1.0f / D) + LN_EPS);
        f32x4 xn[4];
#pragma unroll
        for (int j = 0; j < 4; ++j) xn[j] = pre[j] * rstd * gm[j] + bt[j];
        if (l == DEPTH - 1) { GAS float* O = (GAS float*)a.out + t * D + cl;
#pragma unroll
            for (int j = 0; j < 4; ++j) *(GAS f32x4*)(O + 4 * j) = xn[j];
        } else { GAS bf16_t* O = (GAS bf16_t*)a.out + t * D + cl;
            u32x4 w0, w1; w0.x = cvt_pk_bf16(xn[0][0], xn[0][1]); w0.y = cvt_pk_bf16(xn[0][2], xn[0][3]); w0.z = cvt_pk_bf16(xn[1][0], xn[1][1]); w0.w = cvt_pk_bf16(xn[1][2], xn[1][3]);
            w1.x = cvt_pk_bf16(xn[2][0], xn[2][1]); w1.y = cvt_pk_bf16(xn[2][2], xn[2][3]); w1.z = cvt_pk_bf16(xn[3][0], xn[3][1]); w1.w = cvt_pk_bf16(xn[3][2], xn[3][3]);
            *(GAS u32x4*)O = w0; *(GAS u32x4*)(O + 8) = w1;
            u32x4 h8;
            { const f32x4 h0 = xn[0] * sc[0] + sh[0], h1 = xn[1] * sc[1] + sh[1], h2 = xn[2] * sc[2] + sh[2], h3 = xn[3] * sc[3] + sh[3];
              h8.x = pk4_fp8(h0[0], h0[1], h0[2], h0[3]); h8.y = pk4_fp8(h1[0], h1[1], h1[2], h1[3]); h8.z = pk4_fp8(h2[0], h2[1], h2[2], h2[3]); h8.w = pk4_fp8(h3[0], h3[1], h3[2], h3[3]); }
            *(GAS u32x4*)(H + t * D + cl) = h8; }
    }
}

template <class Tp> __device__ __forceinline__ Tp* launder(Tp* p) { asm volatile("" : "+s"(p)); return p; }
#define IN(p) (lo <= (p) && (p) < hi)
#ifndef PH_MASK
#define PH_MASK 0xffff
#endif
#define PHM(k) ((PH_MASK >> (k)) & 1)
#define RELAUNDER() do { ws = launder(ws); F.ws = ws; { int _t = F.tid; asm volatile("" : "+v"(_t)); F.tid = _t; F.lane = _t & 63; F.wave = __builtin_amdgcn_readfirstlane(_t >> 6); } asm volatile("" : "+s"(F.vcu), "+s"(F.G), "+s"(bx)); } while (0)
#define SEAM(p) do { if (IN(p) && IN((p) + 1)) xcd_barrier(bar); } while (0)
template <int l> __device__ __forceinline__ void layer_body(Frame& F, const Args& args, const XcdBarrier& bar, GAS unsigned char*& ws, const int lo, const int hi, int& bx) {
        const int pb = 2 + PPL * l;
        if (PHM(2) && IN(pb + 0)) {
            RELAUNDER();
            pg8::ProbPlainT<123> P{(const GAS char*)(ws + B_H8), (const GAS char*)(ws + W_IN), D}; pg8::SchedStatic S{T / 256, NIN / 256, F.G, bx};
            pg8::EpiZ E{(GAS unsigned char*)(ws + B_U)};
            pg8::gemm_phase<11>(F.lds, F.tid, P, S, E);
        }
        SEAM(pb + 0); STAMP(2);
        if (PHM(3) && IN(pb + 1)) {
            RELAUNDER();
            rg_phase(F, args, l);
        }
        SEAM(pb + 1); STAMP(3);
        if (PHM(4) && IN(pb + 2)) {
            RELAUNDER();
            sgu_phase(F, args, l);
            for (int u = F.vcu; u < 512; u += F.G) scanfix_unit(F, u);
        }
        SEAM(pb + 2); STAMP(4);
        if (PHM(5) && IN(pb + 3)) {
            RELAUNDER();
            pg8::ProbPair P{(const GAS char*)(ws + B_YA8), (const GAS char*)(ws + B_YB8), (const GAS char*)(ws + W_A), (const GAS char*)(ws + W_B), D};
            pg8::SchedPair S{T / 256, D / 256, F.G, bx};
            pg8::EpiPair E{(const GAS unsigned char*)(ws + B_GA), (const GAS unsigned char*)(ws + B_GB), (GAS unsigned char*)(ws + B_MG8)};
            pg8::gemm_phase(F.lds, F.tid, P, S, E);
        }
        SEAM(pb + 3); STAMP(5);
        if (PHM(6) && IN(pb + 4)) {
            RELAUNDER();
            pg8::ProbPlainT<122> P{(const GAS char*)(ws + B_MG8), (const GAS char*)(ws + W_O), D}; pg8::SchedStatic S{T / 256, D / 256, F.G, bx};
            if (l == 0) { pg8::EpiOutT<true> E{(const GAS void*)args.in[0], (GAS bf16_t*)args.out, (const GAS float*)(ws + WS_ADA) + (size_t)l * 16 * NIN, (GAS float*)(ws + WS_PSTAT)}; pg8::gemm_phase(F.lds, F.tid, P, S, E); }
            else { pg8::EpiOutT<false> E{(const GAS void*)args.out, (GAS bf16_t*)args.out, (const GAS float*)(ws + WS_ADA) + (size_t)l * 16 * NIN, (GAS float*)(ws + WS_PSTAT)}; pg8::gemm_phase(F.lds, F.tid, P, S, E); }
        }
        SEAM(pb + 4); STAMP(6);
        if (PHM(7) && IN(pb + 5)) { RELAUNDER(); ln1_route_phase(F, args, l); }
        SEAM(pb + 5); STAMP(7);
#pragma unroll
        for (int s = 0; s < NSLAB; ++s) {
            const int ps = pb + 6 + 3 * s;
            int ntiles = 0;
            RELAUNDER();
            if (IN(ps) || IN(ps + 1) || IN(ps + 2)) ntiles = moe_setup(F, l, s);
            GAS unsigned char* hid = (GAS unsigned char*)(ws + B_HID8); GAS unsigned char* yb = (GAS unsigned char*)(ws + B_Y);
            const LAS int* CN = (const LAS int*)(F.lds + L_CNT); const LAS int* TB = (const LAS int*)(F.lds + L_TBASE); const LAS unsigned short* TM = (const LAS unsigned short*)(F.lds + L_TMAP);
            if (PHM(8) && IN(ps)) {
                RELAUNDER();
                pg8::ProbMoe1 P{(const GAS char*)(ws + B_H8) + (size_t)s * SLAB_T * D, (const GAS char*)(ws + W_E13), (const GAS unsigned*)(ws + WS_TOKE) + (size_t)s * 64 * ECAP, CN, D};
                pg8::SchedMoe<2> S{ntiles, F.G, F.vcu, TM, TB};
                pg8::EpiMoe1 E{hid, (const GAS float*)(ws + WS_WTE) + (size_t)s * 64 * ECAP, CN};
                pg8::gemm_phase<13>(F.lds, F.tid, P, S, E);
            }
            SEAM(ps); STAMP(8);
            if (PHM(9) && IN(ps + 1)) {
                RELAUNDER();
                pg8::ProbMoe2 P{(const GAS char*)hid, (const GAS char*)(ws + W_E2), DE};
                pg8::SchedMoe<4> S{ntiles, F.G, F.vcu, TM, TB};
                pg8::EpiMoe2 E{yb};
                pg8::gemm_phase<15>(F.lds, F.tid, P, S, E);
            }
            SEAM(ps + 1); STAMP(9);
            if (PHM(10) && IN(ps + 2)) {
                RELAUNDER();
                combine_phase(F, args, l, s);
                if (s == NSLAB - 1 && l < DEPTH - 1) { __syncthreads(); convert_layer(F, args, l + 1); }
            }
            if (ps + 2 < NPH - 1) SEAM(ps + 2);
            STAMP(10);
        }
}
__global__ void __launch_bounds__(512, 2) mk_fwd(Args args) {
    extern __shared__ __attribute__((aligned(16))) unsigned char lds_raw[];
    Frame F;
    F.lds = (LAS unsigned char*)lds_raw; F.tid = threadIdx.x; F.lane = F.tid & 63; F.wave = __builtin_amdgcn_readfirstlane(F.tid >> 6);
    F.G = gridDim.x; { const int bx = blockIdx.x; F.vcu = (F.G % 8 == 0) ? (bx % 8) * (F.G / 8) + bx / 8 : bx; }
    F.ws = (GAS unsigned char*)args.ws;
    GAS unsigned char* ws = (GAS unsigned char*)args.ws;
    volatile LAS unsigned* MISC = (volatile LAS unsigned*)(F.lds + L_MISC);
    if (F.tid < 32) MISC[F.tid] = 0u;
    __syncthreads();
    XcdBarrier bar = xcd_barrier_post((GAS unsigned*)(ws + WS_CTL) + CW_BAR, MISC + 8);
    const int lo = args.ph_lo, hi = args.ph_hi;
    int bx = (int)blockIdx.x;
    if (PROBE_SET != 0 && blockIdx.x == 0 && threadIdx.x == 0) { volatile LAS unsigned long long* _m = (volatile LAS unsigned long long*)(F.lds + L_MISC + 64); _m[0] = __builtin_amdgcn_s_memrealtime(); _m[1] = 0ull; }

    if (PHM(0) && IN(0)) { RELAUNDER(); ada_phase(F, args); __syncthreads(); convert_layer(F, args, 0); }
    SEAM(0); STAMP(0);
    if (PHM(1) && IN(1)) { RELAUNDER(); modulate0(F, args); }
    SEAM(1); STAMP(1);

    layer_body<0>(F, args, bar, ws, lo, hi, bx); layer_body<1>(F, args, bar, ws, lo, hi, bx); layer_body<2>(F, args, bar, ws, lo, hi, bx); layer_body<3>(F, args, bar, ws, lo, hi, bx);
    if (PROBE_SET != 0 && blockIdx.x == 0 && threadIdx.x == 0) { volatile LAS unsigned long long* _m = (volatile LAS unsigned long long*)(F.lds + L_MISC + 64); const unsigned long long t0 = __builtin_amdgcn_s_memrealtime(), w = _m[1] * PROBE_MUL;
        while (__builtin_amdgcn_s_memrealtime() - t0 < w) __builtin_amdgcn_s_sleep(8); }
#undef IN
#undef SEAM
}

extern "C" void kernel_launch(void* const* d_in, const int* in_sizes, int n_in, void* d_out, int out_size, void* d_ws, size_t ws_size, hipStream_t stream) {
    static int grid = 0;
    if (grid == 0) {
        if (n_in != 31 || out_size != T * D || ws_size < WS_END) { fprintf(stderr, "kernel_launch: unexpected shapes (n_in %d, out %d, ws %zu < %zu)\n", n_in, out_size, ws_size, (size_t)WS_END); grid = -1; return; }
        int dev = 0, cus = 0, per_cu = 0;
        if (hipGetDevice(&dev) != hipSuccess || hipDeviceGetAttribute(&cus, hipDeviceAttributeMultiprocessorCount, dev) != hipSuccess) { grid = -1; return; }
        if (hipFuncSetAttribute((const void*)mk_fwd, hipFuncAttributeMaxDynamicSharedMemorySize, LDS_BYTES) != hipSuccess) { fprintf(stderr, "kernel_launch: hipFuncSetAttribute failed\n"); grid = -1; return; }
        if (hipOccupancyMaxActiveBlocksPerMultiprocessor(&per_cu, (const void*)mk_fwd, 512, LDS_BYTES) != hipSuccess || per_cu < 1) { fprintf(stderr, "kernel_launch: occupancy query says %d\n", per_cu); }
        (void)hipGetLastError();
        if (cus != 256) { fprintf(stderr, "kernel_launch: built for a 256-CU device (got %d CUs); nothing launched\n", cus); grid = -1; return; }
        grid = cus;
    }
    if (grid < 0) return;
    (void)in_sizes;
    hipMemsetAsync((char*)d_ws + WS_CTL, 0, CTL_BYTES, stream);
    Args a{};
    for (int i = 0; i < 31; ++i) a.in[i] = (const float*)d_in[i];
    a.out = (float*)d_out; a.ws = (unsigned char*)d_ws;
#if MK_MULTI
    for (int p = 0; p < NPH; ++p) { a.ph_lo = p; a.ph_hi = p + 1; hipLaunchKernelGGL(mk_fwd, dim3(grid), dim3(512), LDS_BYTES, stream, a); }
#else
    a.ph_lo = 0; a.ph_hi = NPH;
    hipLaunchKernelGGL(mk_fwd, dim3(grid), dim3(512), LDS_BYTES, stream, a);
#endif
}
```

```cpp
#include <hip/hip_runtime.h>
#include <cstdio>
#include <cstdint>

#ifndef MFMA_SCALED
#define MFMA_SCALED 0
#endif
#define PG8_SEGPRIO 0
#ifndef MK_MULTI
#define MK_MULTI 0
#endif

#define GAS __attribute__((address_space(1)))
#define LAS __attribute__((address_space(3)))
typedef unsigned short bf16_t;
typedef short bf16x8 __attribute__((ext_vector_type(8)));
typedef float f32x4 __attribute__((ext_vector_type(4)));
typedef float f32x2 __attribute__((ext_vector_type(2)));
typedef unsigned u32x4 __attribute__((ext_vector_type(4)));
typedef unsigned u32x2 __attribute__((ext_vector_type(2)));
typedef int i32x4 __attribute__((ext_vector_type(4)));
typedef int i32x8 __attribute__((ext_vector_type(8)));

constexpr int D = 1024, BATCH = 16, SEQ = 4096, T = BATCH * SEQ, DEPTH = 4;
constexpr int NIN = 6144, NE = 64, DE = 256;
constexpr int NSLAB = 1, SLAB_T = T / NSLAB;
constexpr int ECAP = SLAB_T;
constexpr float LN_EPS = 1e-5f;
constexpr float ALPHA = 1.6817928305074290f;
constexpr float LOG2E = 1.4426950408889634f;
constexpr int PPL = 6 + 3 * NSLAB, NPH = 2 + PPL * DEPTH;

constexpr size_t MiB = 1u << 20;
constexpr size_t WS_CTL = 0, CTL_BYTES = 1 * MiB;
constexpr size_t WS_ADA = 1 * MiB;
constexpr size_t WS_MISC = 3 * MiB;
constexpr size_t WS_VSTAT = 4 * MiB;
constexpr size_t WS_PSTAT = 5 * MiB;
constexpr size_t WS_CARRY = 13 * MiB;
constexpr size_t WS_POS = 17 * MiB;
constexpr size_t WS_TOKE = 19 * MiB;
constexpr size_t WS_WTE = 35 * MiB;
constexpr size_t WS_W = 51 * MiB;
constexpr size_t W_IN = WS_W;
constexpr size_t W_A = W_IN + 6 * MiB;
constexpr size_t W_B = W_A + 1 * MiB;
constexpr size_t W_O = W_B + 1 * MiB;
constexpr size_t W_E13 = W_O + 1 * MiB;
constexpr size_t W_E2 = W_E13 + 33 * MiB;
constexpr size_t W_RGA = W_E2 + 17 * MiB;
constexpr size_t W_RGX = W_RGA + 256 * 1024;
constexpr size_t W_SG = W_RGX + 256 * 1024;
constexpr size_t W_RH = W_SG + 256 * 1024;
constexpr size_t W_RL = W_RH + 128 * 1024;
constexpr size_t WS_BIG = 112 * MiB;
constexpr size_t BIGSZ = 128 * MiB;
constexpr size_t B_U = WS_BIG, B_V = WS_BIG + 1 * BIGSZ, B_RG = WS_BIG + 2 * BIGSZ, B_RI = WS_BIG + 3 * BIGSZ, B_GA = WS_BIG + 4 * BIGSZ, B_GB = WS_BIG + 5 * BIGSZ, B_HL = WS_BIG + 6 * BIGSZ, B_CA = WS_BIG + 7 * BIGSZ;
constexpr size_t B_H8 = WS_BIG + 8 * BIGSZ;
constexpr size_t B_YA8 = B_RI, B_YB8 = B_RI + 64 * MiB;
constexpr size_t B_MG8 = B_U;
constexpr size_t B_HID8 = B_HL, B_Y = B_U;
constexpr size_t B_XL = B_GB;
constexpr size_t WS_END = B_H8 + 64 * MiB;
static_assert(W_RL + 128 * 1024 <= WS_BIG, "weights region");
constexpr size_t HID_ROWS_MAX = (size_t)SLAB_T * 9 + 65 * 256;
static_assert(HID_ROWS_MAX * 256 <= 2 * BIGSZ && HID_ROWS_MAX * 1024 <= 5 * BIGSZ, "MoE overlay");
constexpr float DSC(float sa) { return MFMA_SCALED ? 1.0f : 1.0f / (sa * 64.f); }
constexpr float SC_W2 = 16.f;
constexpr float SC_W = 64.f, SC_H = 16.f, SC_Y = 8.f, SC_MG = 32.f, SC_HID = 8.f, SC_YO = 128.f, SC_Z = 16.f, SC_G = 256.f, SC_HL = 16.f, SC_CA = 256.f;

constexpr int CW_BAR = 4096;
constexpr int CW_CNT = 16384;

constexpr int SCR_BYTES = 147456;
constexpr int L_MISC = SCR_BYTES;
constexpr int L_TBASE = L_MISC + 128;
constexpr int L_CNT = L_TBASE + 384;
constexpr int L_TMAP = L_CNT + 512;
constexpr int LDS_BYTES = SCR_BYTES + 6144;
static_assert(L_TMAP + 5120 <= LDS_BYTES && (T * 9) / 256 + 65 <= 2560, "LDS map");

#define LDS_WAIT() asm volatile("s_waitcnt lgkmcnt(0)" ::: "memory")
#define VM_WAIT() asm volatile("s_waitcnt vmcnt(0)" ::: "memory")
__device__ __forceinline__ unsigned cvt_pk_bf16(float lo, float hi) { unsigned r; asm("v_cvt_pk_bf16_f32 %0, %1, %2" : "=v"(r) : "v"(lo), "v"(hi)); return r; }
__device__ __forceinline__ unsigned pk4_fp8(float a, float b, float c, float d) {
    a = __builtin_amdgcn_fmed3f(a, -448.f, 448.f); b = __builtin_amdgcn_fmed3f(b, -448.f, 448.f); c = __builtin_amdgcn_fmed3f(c, -448.f, 448.f); d = __builtin_amdgcn_fmed3f(d, -448.f, 448.f);
    int w = __builtin_amdgcn_cvt_pk_fp8_f32(a, b, 0, false); w = __builtin_amdgcn_cvt_pk_fp8_f32(c, d, w, true); return (unsigned)w; }
__device__ __forceinline__ unsigned pk4_fp8_nc(float a, float b, float c, float d) {
    int w = __builtin_amdgcn_cvt_pk_fp8_f32(a, b, 0, false); w = __builtin_amdgcn_cvt_pk_fp8_f32(c, d, w, true); return (unsigned)w; }
__device__ __forceinline__ void unpack4_fp8(unsigned w, float (&f)[4]) { const f32x2 lo = __builtin_amdgcn_cvt_pk_f32_fp8((int)w, false), hi = __builtin_amdgcn_cvt_pk_f32_fp8((int)w, true); f[0] = lo.x; f[1] = lo.y; f[2] = hi.x; f[3] = hi.y; }
__device__ __forceinline__ void unpack8_fp8(const u32x2 w, float (&f)[8]) { float a[4], b[4]; unpack4_fp8(w.x, a); unpack4_fp8(w.y, b);
#pragma unroll
    for (int j = 0; j < 4; ++j) { f[j] = a[j]; f[4 + j] = b[j]; } }
__device__ __forceinline__ void unpack16_fp8(const u32x4 w, float (&f)[16]) { float a[8], b[8]; unpack8_fp8((u32x2){w.x, w.y}, a); unpack8_fp8((u32x2){w.z, w.w}, b);
#pragma unroll
    for (int j = 0; j < 8; ++j) { f[j] = a[j]; f[8 + j] = b[j]; } }
__device__ __forceinline__ float bf_lo(unsigned w) { return __uint_as_float(w << 16); }
__device__ __forceinline__ float bf_hi(unsigned w) { return __uint_as_float(w & 0xffff0000u); }
__device__ __forceinline__ float fsigmoid(float x) { return __builtin_amdgcn_rcpf(1.0f + __builtin_amdgcn_exp2f(-LOG2E * x)); }
template <int CTRL> __device__ __forceinline__ float dpp_add(float v) { return v + __int_as_float(__builtin_amdgcn_update_dpp(0, __float_as_int(v), CTRL, 0xf, 0xf, true)); }
template <int CTRL> __device__ __forceinline__ int dpp_i(int v) { return __builtin_amdgcn_update_dpp(0, v, CTRL, 0xf, 0xf, true); }
template <int CTRL> __device__ __forceinline__ float dpp_f(float v) { return __int_as_float(dpp_i<CTRL>(__float_as_int(v))); }
__device__ __forceinline__ float rlane(float v, int l) { return __int_as_float(__builtin_amdgcn_readlane(__float_as_int(v), l)); }
__device__ __forceinline__ float wave_sum(float v) {
    v = dpp_add<0xB1>(v); v = dpp_add<0x4E>(v); v = dpp_add<0x141>(v); v = dpp_add<0x140>(v);
    return (rlane(v, 0) + rlane(v, 16)) + (rlane(v, 32) + rlane(v, 48));
}
__device__ __forceinline__ f32x2 gelu_pk(f32x2 v) {
    const f32x2 av = __builtin_elementwise_min(__builtin_elementwise_abs(v), (f32x2){4.5f, 4.5f});
    const f32x2 t = av * 0.4444444444f + (-1.0f);
    f32x2 q = t * 3.951919514e-02f + (-1.927818768e-02f);
    q = q * t + (-1.653166270e-01f); q = q * t + 1.674144965e-01f; q = q * t + 1.899891083e-01f; q = q * t + (-4.229837828e-01f);
    q = q * t + 2.122498017e-01f; q = q * t + 1.402255593e-01f; q = q * t + (-2.492420617e-01f); q = q * t + 1.346304704e-01f; q = q * t + (-2.719805609e-02f);
    return __builtin_elementwise_max(v, (f32x2){0.f, 0.f}) + q;
}
__device__ __forceinline__ f32x2 gelu16_pk(f32x2 v) {
    constexpr float KT = DSC(SC_H) / 4.5f, KM = SC_Z * DSC(SC_H); static_assert(SC_Z == 16.f, "polynomial carries the x16");
    float s0, s1;
    asm("v_mul_f32_e64 %0, |%1|, %2 clamp" : "=v"(s0) : "v"(v.x), "s"(KT));
    asm("v_mul_f32_e64 %0, |%1|, %2 clamp" : "=v"(s1) : "v"(v.y), "s"(KT));
    const f32x2 t = (f32x2){s0, s1};
    f32x2 q = t * (-2.724598309e+02f) + 1.343870688e+03f;
    q = q * t + (-2.690302968e+03f); q = q * t + 2.722895127e+03f; q = q * t + (-1.343784371e+03f); q = q * t + 1.599681120e+02f;
    q = q * t + 1.153520608e+02f; q = q * t + (-3.553613442e+01f); q = q * t + (-2.555093946e-03f);
    return __builtin_elementwise_max(v, (f32x2){0.f, 0.f}) * KM + q;
}
__device__ __forceinline__ void unpack8(const u32x4 v, float (&f)[8]) { f[0] = bf_lo(v.x); f[1] = bf_hi(v.x); f[2] = bf_lo(v.y); f[3] = bf_hi(v.y); f[4] = bf_lo(v.z); f[5] = bf_hi(v.z); f[6] = bf_lo(v.w); f[7] = bf_hi(v.w); }
__device__ __forceinline__ u32x4 pack8(const float (&f)[8]) { u32x4 o; o.x = cvt_pk_bf16(f[0], f[1]); o.y = cvt_pk_bf16(f[2], f[3]); o.z = cvt_pk_bf16(f[4], f[5]); o.w = cvt_pk_bf16(f[6], f[7]); return o; }
__device__ __forceinline__ float gelu1(float x) { f32x2 r = gelu_pk((f32x2){x, x}); return r.x; }

#define XB_TMO      128
#define XB_XCNT(j)  (256  + 64 * (j))
#define XB_XSUB(j)  (1280 + 64 * (j))
#define XB_XGEN(j)  (2304 + 64 * (j))
#define XB_TOP      3328
#define XB_TOPGEN   3392
#define XCD_BAR_WORDS 3456
#define XB_SPIN_CAP (1u << 20)
__device__ __forceinline__ unsigned xb_ld(GAS unsigned* p)              { return __hip_atomic_load(p, __ATOMIC_RELAXED, __HIP_MEMORY_SCOPE_AGENT); }
__device__ __forceinline__ unsigned xb_add(GAS unsigned* p, unsigned v) { return __hip_atomic_fetch_add(p, v, __ATOMIC_RELAXED, __HIP_MEMORY_SCOPE_AGENT); }
__device__ __forceinline__ unsigned xb_xcc_id() { return (unsigned)__builtin_amdgcn_s_getreg((3 << 11) | 20) & 0xFu; }
#define XB_SPIN(cond, bar) do { unsigned _sp = 0; while (cond) { __builtin_amdgcn_s_sleep(1); \
    if ((++_sp & 255u) == 0u) { if (xb_ld(&(bar)[XB_TMO])) break; if (_sp > XB_SPIN_CAP) { (void)xb_add(&(bar)[XB_TMO], 1u); break; } } } } while (0)
struct XcdBarrier { GAS unsigned* bar; unsigned x; volatile LAS unsigned* st; };
__device__ __forceinline__ XcdBarrier xcd_barrier_post(GAS unsigned* bar, volatile LAS unsigned* st) {
    XcdBarrier b; b.bar = bar; b.x = xb_xcc_id(); b.st = st;
    if (threadIdx.x == 0) (void)xb_add(&bar[XB_XCNT(b.x)], 1u);
    return b;
}
__device__ __forceinline__ void xcd_barrier_complete(GAS unsigned* bar, unsigned x, unsigned& nloc, unsigned& nx) {
    const unsigned G = gridDim.x * gridDim.y * gridDim.z;
    unsigned sum, cnt, mine, sp = 0u;
    for (;;) {
        sum = 0u; cnt = 0u; mine = 0u;
#pragma unroll
        for (unsigned j = 0; j < 16; ++j) { const unsigned c = xb_ld(&bar[XB_XCNT(j)]); sum += c; cnt += (c > 0u) ? 1u : 0u; mine = (j == x) ? c : mine; }
        if (sum == G) break;
        __builtin_amdgcn_s_sleep(1);
        if ((++sp & 255u) == 0u) { if (xb_ld(&bar[XB_TMO])) break; if (sp > XB_SPIN_CAP) { (void)xb_add(&bar[XB_TMO], 1u); break; } }
    }
    nloc = mine > 0u ? mine : 1u; nx = cnt > 0u ? cnt : 1u;
}
__device__ __forceinline__ void xcd_barrier(const XcdBarrier& b) {
    asm volatile("s_waitcnt vmcnt(0)" ::: "memory");
    __syncthreads();
    if (threadIdx.x == 0) {
        GAS unsigned* bar = b.bar; unsigned bx_ = b.x; asm volatile("" : "+s"(bar), "+s"(bx_));
        __builtin_amdgcn_s_waitcnt(0);
        unsigned nloc = b.st[0], nx = b.st[1];
        if (nloc == 0u) { xcd_barrier_complete(bar, bx_, nloc, nx); b.st[0] = nloc; b.st[1] = nx; }
        const unsigned old = xb_add(&bar[XB_XSUB(bx_)], 1u);
        const unsigned gen = old / nloc;
        if (old + 1u == (gen + 1u) * nloc) {
            __builtin_amdgcn_fence(__ATOMIC_RELEASE, "agent");
            asm volatile("s_waitcnt vmcnt(0)" ::: "memory");
            const unsigned og = xb_add(&bar[XB_TOP], 1u);
            const unsigned tg = og / nx;
            if (og + 1u == (tg + 1u) * nx) xb_add(&bar[XB_TOPGEN], 1u);
            else XB_SPIN(xb_ld(&bar[XB_TOPGEN]) == tg, bar);
            __builtin_amdgcn_fence(__ATOMIC_ACQUIRE, "agent");
            xb_add(&bar[XB_XGEN(bx_)], 1u);
            asm volatile("s_waitcnt vmcnt(0)" ::: "memory");
        } else {
            XB_SPIN(xb_ld(&bar[XB_XGEN(bx_)]) == gen, bar);
            __builtin_amdgcn_fence(__ATOMIC_ACQUIRE, "agent");
            asm volatile("s_waitcnt vmcnt(0)" ::: "memory");
        }
    }
    __syncthreads();
}

#ifndef PROBE_SET
#define PROBE_SET 0
#endif
#ifndef PROBE_MUL
#define PROBE_MUL 1
#endif
#define STAMP(ty) do { if (PROBE_SET != 0 && blockIdx.x == 0 && threadIdx.x == 0) { volatile LAS unsigned long long* _m = (volatile LAS unsigned long long*)(F.lds + L_MISC + 64); \
        const unsigned long long _n = __builtin_amdgcn_s_memrealtime(); if ((PROBE_SET >> (ty)) & 1) _m[1] += _n - _m[0]; _m[0] = _n; } } while (0)
struct Args { const float* in[31]; float* out; unsigned char* ws; int ph_lo, ph_hi; };
#define GSTAMP(ldsp, ty) do { if (PROBE_SET != 0 && (ty) >= 0 && blockIdx.x == 0 && threadIdx.x == 0) { volatile LAS unsigned long long* _m = (volatile LAS unsigned long long*)((ldsp) + L_MISC + 64); \
        const unsigned long long _n = __builtin_amdgcn_s_memrealtime(); if ((PROBE_SET >> ((ty) & 31)) & 1) _m[1] += _n - _m[0]; _m[0] = _n; } } while (0)
namespace pg8 {
constexpr int BM = 256, BK = 64, HALF = 128, HTB = HALF * BK * 2, STAGE_BYTES = 8 * HTB, NXCD = 8, WGM = 8;
__device__ __forceinline__ int lds_byte(int r, int c) { const int st = (r >> 4) * 2 + (c >> 5), rr = r & 15, cc = c & 31, ob = rr * 64 + cc * 2; return st * 1024 + (ob ^ (((ob >> 9) & 1) << 5)); }
__device__ __forceinline__ void stage_rc(int b, int& R, int& C) { const int st = b / 1024, sb = b % 1024, swz = sb ^ (((sb >> 9) & 1) << 5); R = (st >> 1) * 16 + swz / 64; C = (st & 1) * 32 + (swz % 64) / 2; }
__device__ __forceinline__ int perm32(int rho) { const int n = rho >> 4, i = rho & 15; return 8 * (i >> 2) + 4 * n + (i & 3); }

struct Unit { int pm, pn, aux, j; };

__device__ __forceinline__ void tile_of(int wgid, int nM, int nN, int& pm, int& pn) {
    const int nwg = nM * nN; { const int q = nwg / NXCD, r = nwg % NXCD, xcd = wgid % NXCD, off = wgid / NXCD; wgid = (xcd < r ? xcd * (q + 1) : r * (q + 1) + (xcd - r) * q) + off; }
    const int nig = WGM * nN, gid = wgid / nig, fm = gid * WGM, gsz = (nM - fm) < WGM ? (nM - fm) : WGM;
    pm = fm + ((wgid % nig) % gsz); pn = (wgid % nig) / gsz;
}
struct SchedStatic {
    int nM, nN, G, c;
    __device__ __forceinline__ bool next(int i, Unit& u) const { const long L = (long)i * G + c; if (L >= (long)nM * nN) return false; tile_of((int)L, nM, nN, u.pm, u.pn); u.aux = 0; u.j = 0; return true; }
};
struct SchedPair {
    int nM, nN, G, c;
    __device__ __forceinline__ bool next(int i, Unit& u) const { const long L = (long)(i >> 1) * G + c; if (L >= (long)nM * nN) return false; tile_of((int)L, nM, nN, u.pm, u.pn); u.aux = i & 1; u.j = 0; return true; }
};
template <int NCT> struct SchedMoe {
    int ntiles, G, c; const LAS unsigned short* tmap; const LAS int* tbase;
    __device__ __forceinline__ bool next(int i, Unit& u) const {
        const long L = (long)i * G + c; const int tile = (int)(L / NCT); if (tile >= ntiles) return false;
        u.pm = tile; u.pn = (int)(L % NCT); u.aux = __builtin_amdgcn_readfirstlane((int)tmap[tile]); u.j = tile - __builtin_amdgcn_readfirstlane(tbase[u.aux]); return true;
    }
};

#define E8M0x4(e) ((int)(((unsigned)(e)) * 0x01010101u))
template <int EA> struct ProbPlainT {
    static constexpr bool GATHER = false; static constexpr int SCA = E8M0x4(EA), SCB = E8M0x4(121);
    const GAS char* A; const GAS char* Bt; int K;
    __device__ __forceinline__ const GAS char* a_base(const Unit& u) const { return A + (size_t)u.pm * 256 * K; }
    __device__ __forceinline__ const GAS char* b_base(const Unit& u) const { return Bt + (size_t)u.pn * 256 * K; }
    __device__ __forceinline__ void gather(const Unit&, const int (&)[2], const int (&)[2], unsigned (&)[2][2]) const {}
};
struct ProbPair {
    static constexpr bool GATHER = false; static constexpr int SCA = E8M0x4(124), SCB = E8M0x4(121);
    const GAS char* A0; const GAS char* A1; const GAS char* B0; const GAS char* B1; int K;
    __device__ __forceinline__ const GAS char* a_base(const Unit& u) const { return (u.aux ? A1 : A0) + (size_t)u.pm * 256 * K; }
    __device__ __forceinline__ const GAS char* b_base(const Unit& u) const { return (u.aux ? B1 : B0) + (size_t)u.pn * 256 * K; }
    __device__ __forceinline__ void gather(const Unit&, const int (&)[2], const int (&)[2], unsigned (&)[2][2]) const {}
};
struct ProbMoe1 {
    static constexpr bool GATHER = true; static constexpr int SCA = E8M0x4(123), SCB = E8M0x4(121);
    const GAS char* A; const GAS char* W; const GAS unsigned* tok; const LAS int* cnt; int K;
    __device__ __forceinline__ const GAS char* a_base(const Unit&) const { return A; }
    __device__ __forceinline__ const GAS char* b_base(const Unit& u) const { return W + (size_t)u.aux * (512 * 1024) + (size_t)u.pn * 256 * 1024; }
    __device__ __forceinline__ void gather(const Unit& u, const int (&R)[2], const int (&C2)[2], unsigned (&vo)[2][2]) const {
        const int c = cnt[u.aux];
#pragma unroll
        for (int h = 0; h < 2; ++h)
#pragma unroll
            for (int i = 0; i < 2; ++i) { const int p = u.j * 256 + h * 128 + R[i]; unsigned tk = 0u;
                if (p < c) tk = (u.aux == 64) ? (unsigned)p : __builtin_nontemporal_load(tok + (size_t)u.aux * ECAP + p);
                vo[h][i] = tk * 1024u + (unsigned)C2[i]; }
    }
};
struct ProbMoe2 {
    static constexpr bool GATHER = false; static constexpr int SCA = E8M0x4(124), SCB = E8M0x4(121);
    const GAS char* A; const GAS char* W; int K;
    __device__ __forceinline__ const GAS char* a_base(const Unit& u) const { return A + (size_t)u.pm * 256 * 256; }
    __device__ __forceinline__ const GAS char* b_base(const Unit& u) const { return W + (size_t)u.aux * (1024 * 256) + (size_t)u.pn * 256 * 256; }
    __device__ __forceinline__ void gather(const Unit&, const int (&)[2], const int (&)[2], unsigned (&)[2][2]) const {}
};

typedef f32x4 Acc[2][2][4][2];

struct EpiZ {
    static constexpr int PERM = 2; static constexpr bool NOKEEP = true;
    GAS unsigned char* out0;
    __device__ __forceinline__ bool keep(const Unit&) const { return false; }
    template <int ACT> __device__ __forceinline__ void run(const Acc& acc, GAS unsigned char* base, int row0, int col0) const {
#pragma unroll
        for (int ai = 0; ai < 2; ++ai)
#pragma unroll
            for (int m = 0; m < 4; ++m) { const size_t eo = (size_t)(row0 + ai * HALF + m * 16) * D + col0; u32x4 w; unsigned wq[4];
#pragma unroll
                for (int q = 0; q < 4; ++q) { f32x4 v = acc[ai][q >> 1][m][q & 1];
                    if (ACT == 0) v = v * (SC_Z * DSC(SC_H));
                    if (ACT == 1) { const f32x2 a = gelu16_pk((f32x2){v[0], v[1]}), c = gelu16_pk((f32x2){v[2], v[3]}); v = (f32x4){a.x, a.y, c.x, c.y}; }
                    if (ACT == 2) { static_assert(SC_G == 256.f, "SC_G * sigmoid(x) = 1 / (2^-8 + 2^(-x log2 e - 8))");
                        const f32x4 ex = v * (-LOG2E * DSC(SC_H)) + (-8.0f);
#pragma unroll
                        for (int j = 0; j < 4; ++j) v[j] = __builtin_amdgcn_rcpf(__builtin_amdgcn_exp2f(ex[j]) + 0.00390625f); }
                    wq[q] = (ACT == 2) ? pk4_fp8_nc(v[0], v[1], v[2], v[3]) : pk4_fp8(v[0], v[1], v[2], v[3]); }
                w.x = wq[0]; w.y = wq[1]; w.z = wq[2]; w.w = wq[3];
                __builtin_nontemporal_store(w, (GAS u32x4*)(base + eo)); }
    }
    struct Pre {}; __device__ __forceinline__ void prefetch(Pre&, const Unit&, int, int, int, int) const {}
    __device__ __forceinline__ void operator()(Acc& acc, const Unit& u, int wr, int wc, int fr, int fq, const Pre& pre) const {
        const int part = u.pn >> 2; GAS unsigned char* base = out0 + (size_t)part * BIGSZ;
        const int row0 = u.pm * BM + wr * 64 + fr, col0 = (u.pn & 3) * BM + wc * 64 + 16 * fq;
        if (part < 3) run<1>(acc, base, row0, col0); else if (part == 3) run<0>(acc, base, row0, col0); else run<2>(acc, base, row0, col0);
    }
};
struct EpiPair {
    static constexpr int PERM = 2; static constexpr bool NOKEEP = false;
    const GAS unsigned char* GA; const GAS unsigned char* GB; GAS unsigned char* MG;
    __device__ __forceinline__ bool keep(const Unit& u) const { return u.aux == 0; }
    struct Pre { u32x4 gb[2], ga[2]; };
    __device__ __forceinline__ void ldg(u32x4 (&gb)[2], u32x4 (&ga)[2], const Unit& u, int row0, int col0, int h) const {
#pragma unroll
        for (int mm = 0; mm < 2; ++mm) { const size_t off = (size_t)(row0 + (h >> 1) * HALF + ((h & 1) * 2 + mm) * 16) * D + col0; gb[mm] = *(const GAS u32x4*)(GB + off); ga[mm] = gb[mm]; if (u.aux == 0) ga[mm] = *(const GAS u32x4*)(GA + off); }
    }
    __device__ __forceinline__ void prefetch(Pre& pre, const Unit& u, int wr, int wc, int fr, int fq) const { ldg(pre.gb, pre.ga, u, u.pm * BM + wr * 64 + fr, u.pn * BM + wc * 64 + 16 * fq, 0); }
    __device__ __forceinline__ void operator()(Acc& acc, const Unit& u, int wr, int wc, int fr, int fq, const Pre& pre) const {
        const int row0 = u.pm * BM + wr * 64 + fr, col0 = u.pn * BM + wc * 64 + 16 * fq;
        u32x4 gb[2][2], ga[2][2];
#pragma unroll
        for (int mm = 0; mm < 2; ++mm) { gb[0][mm] = pre.gb[mm]; ga[0][mm] = pre.ga[mm]; }
#pragma unroll
        for (int h = 0; h < 4; ++h) { const int ai = h >> 1;
            if (h < 3) ldg(gb[(h + 1) & 1], ga[(h + 1) & 1], u, row0, col0, h + 1);
            asm volatile("" ::: "memory");
#pragma unroll
            for (int mm = 0; mm < 2; ++mm) { const int m = (h & 1) * 2 + mm; const size_t off = (size_t)(row0 + ai * HALF + m * 16) * D + col0;
                float sb[16]; unpack16_fp8(gb[h & 1][mm], sb);
#pragma unroll
                for (int j = 0; j < 16; ++j) sb[j] = fmaxf(sb[j], 1e-9f);
                if (u.aux == 0) { float sa[16]; unpack16_fp8(ga[h & 1][mm], sa);
#pragma unroll
                    for (int q = 0; q < 4; ++q)
#pragma unroll
                        for (int j = 0; j < 4; ++j) acc[ai][q >> 1][m][q & 1][j] *= sa[4 * q + j] * __builtin_amdgcn_rcpf(sb[4 * q + j]);
                } else { u32x4 w; unsigned wq[4];
#pragma unroll
                    for (int q = 0; q < 4; ++q) { f32x4 v = acc[ai][q >> 1][m][q & 1];
#pragma unroll
                        for (int j = 0; j < 4; ++j) v[j] *= sb[4 * q + j] * (SC_MG / SC_G * DSC(SC_Y));
                        wq[q] = pk4_fp8(v[0], v[1], v[2], v[3]); }
                    w.x = wq[0]; w.y = wq[1]; w.z = wq[2]; w.w = wq[3];
                    *(GAS u32x4*)(MG + off) = w; } }
            asm volatile("" ::: "memory"); }
    }
};
template <bool XF32> struct EpiOutT {
    static constexpr int PERM = 2; static constexpr bool NOKEEP = true;
    const GAS void* xsrc; GAS bf16_t* xdst; const GAS float* ada_l; GAS float* pstat;
    __device__ __forceinline__ bool keep(const Unit&) const { return false; }
    struct Pre { f32x4 g[4]; u32x4 x[2][2]; };
    __device__ __forceinline__ void prefetch(Pre& pre, const Unit& u, int wr, int wc, int fr, int fq) const {
        const int row0 = u.pm * BM + wr * 64 + fr, col0 = u.pn * BM + wc * 64 + 16 * fq; const int b = u.pm >> 4;
        const GAS float* gate = ada_l + (size_t)b * NIN + 2 * D + col0;
#pragma unroll
        for (int q = 0; q < 4; ++q) pre.g[q] = *(const GAS f32x4*)(gate + 4 * q);
#pragma unroll
        for (int mm = 0; mm < 2; ++mm) { pre.x[mm][0] = (u32x4){0u, 0u, 0u, 0u}; pre.x[mm][1] = pre.x[mm][0];
            if (!XF32) { const size_t off = (size_t)(row0 + mm * 16) * D + col0; pre.x[mm][0] = *(const GAS u32x4*)((const GAS bf16_t*)xsrc + off); pre.x[mm][1] = *(const GAS u32x4*)((const GAS bf16_t*)xsrc + off + 8); } }
    }
    __device__ __forceinline__ void operator()(Acc& acc, const Unit& u, int wr, int wc, int fr, int fq, const Pre& pre) const {
        const int row0 = u.pm * BM + wr * 64 + fr, col0 = u.pn * BM + wc * 64 + 16 * fq; const int b = u.pm >> 4;
        f32x4 g[4];
#pragma unroll
        for (int q = 0; q < 4; ++q) g[q] = pre.g[q] * DSC(SC_MG);
        u32x4 xr[2][2][2];
#pragma unroll
        for (int mm = 0; mm < 2; ++mm) { xr[0][mm][0] = pre.x[mm][0]; xr[0][mm][1] = pre.x[mm][1]; }
#pragma unroll
        for (int bt = 0; bt < 4; ++bt) { const int ai = bt >> 1, m0 = (bt & 1) * 2;
            f32x4 xv[2][4];
            if (XF32) {
#pragma unroll
                for (int mm = 0; mm < 2; ++mm) { const size_t off = (size_t)(row0 + ai * HALF + (m0 + mm) * 16) * D + col0;
#pragma unroll
                    for (int q = 0; q < 4; ++q) xv[mm][q] = *(const GAS f32x4*)((const GAS float*)xsrc + off + 4 * q); }
            } else {
                if (bt < 3) { const int ain = (bt + 1) >> 1, m0n = ((bt + 1) & 1) * 2;
#pragma unroll
                    for (int mm = 0; mm < 2; ++mm) { const size_t off = (size_t)(row0 + ain * HALF + (m0n + mm) * 16) * D + col0;
                        xr[(bt + 1) & 1][mm][0] = *(const GAS u32x4*)((const GAS bf16_t*)xsrc + off); xr[(bt + 1) & 1][mm][1] = *(const GAS u32x4*)((const GAS bf16_t*)xsrc + off + 8); } }
#pragma unroll
                for (int mm = 0; mm < 2; ++mm) { float f[8]; unpack8(xr[bt & 1][mm][0], f); xv[mm][0] = (f32x4){f[0], f[1], f[2], f[3]}; xv[mm][1] = (f32x4){f[4], f[5], f[6], f[7]};
                    unpack8(xr[bt & 1][mm][1], f); xv[mm][2] = (f32x4){f[0], f[1], f[2], f[3]}; xv[mm][3] = (f32x4){f[4], f[5], f[6], f[7]}; }
            }
#pragma unroll
            for (int mm = 0; mm < 2; ++mm) { const int m = m0 + mm; const int row = row0 + ai * HALF + m * 16; const size_t off = (size_t)row * D + col0; float s = 0.f, q2 = 0.f;
                u32x4 w0, w1; unsigned wq[8];
#pragma unroll
                for (int q = 0; q < 4; ++q) { const f32x4 v = xv[mm][q] * ALPHA + g[q] * acc[ai][q >> 1][m][q & 1]; wq[2 * q] = cvt_pk_bf16(v[0], v[1]); wq[2 * q + 1] = cvt_pk_bf16(v[2], v[3]); }
                w0.x = wq[0]; w0.y = wq[1]; w0.z = wq[2]; w0.w = wq[3]; w1.x = wq[4]; w1.y = wq[5]; w1.z = wq[6]; w1.w = wq[7];
                *(GAS u32x4*)(xdst + off) = w0; *(GAS u32x4*)(xdst + off + 8) = w1;
                { float r[8]; unpack8(w0, r);
#pragma unroll
                  for (int j = 0; j < 8; ++j) { s += r[j]; q2 += r[j] * r[j]; }
                  unpack8(w1, r);
#pragma unroll
                  for (int j = 0; j < 8; ++j) { s += r[j]; q2 += r[j] * r[j]; } }
                s += __shfl_xor(s, 16); s += __shfl_xor(s, 32); q2 += __shfl_xor(q2, 16); q2 += __shfl_xor(q2, 32);
                if (fq == 0) *(GAS f32x2*)(pstat + ((size_t)row * 16 + u.pn * 4 + wc) * 2) = (f32x2){s, q2}; }
            if (XF32) asm volatile("" ::: "memory"); }
    }
};
struct EpiMoe1 {
    static constexpr int PERM = 2; static constexpr bool NOKEEP = true;
    GAS unsigned char* hid; const GAS float* wts; const LAS int* cnt;
    __device__ __forceinline__ bool keep(const Unit&) const { return false; }
    struct Pre { float wrow[2][4]; };
    __device__ __forceinline__ void prefetch(Pre& pre, const Unit& u, int wr, int wc, int fr, int fq) const {
        const int e = u.aux, c = cnt[e];
#pragma unroll
        for (int ai = 0; ai < 2; ++ai)
#pragma unroll
            for (int m = 0; m < 4; ++m) { const int p = u.j * 256 + ai * HALF + wr * 64 + m * 16 + fr; float w = 0.f; if (p < c) w = (e == 64) ? 1.0f : wts[(size_t)e * ECAP + p]; pre.wrow[ai][m] = w; }
    }
    __device__ __forceinline__ void operator()(Acc& acc, const Unit& u, int wr, int wc, int fr, int fq, const Pre& pre) const {
        const int e = u.aux, c = cnt[e]; const int hc0 = u.pn * 128 + wc * 32 + 8 * fq;
#pragma unroll
        for (int ai = 0; ai < 2; ++ai)
#pragma unroll
            for (int m = 0; m < 4; ++m) { const int r = ai * HALF + wr * 64 + m * 16 + fr; const float ws2 = pre.wrow[ai][m] * (SC_HID * DSC(SC_H) * DSC(SC_H));
                GAS unsigned char* rowp = hid + (size_t)(u.pm * 256 + r) * DE + hc0; float h[8];
#pragma unroll
                for (int q = 0; q < 4; ++q) { const f32x4 v = acc[ai][q >> 1][m][q & 1];
                    const float r0 = __builtin_amdgcn_rcpf(1.0f + __builtin_amdgcn_exp2f(v[0] * (-LOG2E * DSC(SC_H)))) * ws2, r1 = __builtin_amdgcn_rcpf(1.0f + __builtin_amdgcn_exp2f(v[2] * (-LOG2E * DSC(SC_H)))) * ws2;
                    h[2 * q] = (v[0] * v[1]) * r0; h[2 * q + 1] = (v[2] * v[3]) * r1; }
                u32x2 o; o.x = pk4_fp8(h[0], h[1], h[2], h[3]); o.y = pk4_fp8(h[4], h[5], h[6], h[7]); *(GAS u32x2*)rowp = o; }
    }
};
struct EpiMoe2 {
    static constexpr int PERM = 2; static constexpr bool NOKEEP = true;
    GAS unsigned char* y;
    __device__ __forceinline__ bool keep(const Unit&) const { return false; }
    struct Pre {}; __device__ __forceinline__ void prefetch(Pre&, const Unit&, int, int, int, int) const {}
    __device__ __forceinline__ void operator()(Acc& acc, const Unit& u, int wr, int wc, int fr, int fq, const Pre& pre) const {
        const int row0 = u.pm * BM + wr * 64 + fr, col0 = u.pn * BM + wc * 64 + 16 * fq;
        static_assert(SC_HID * SC_W2 == SC_YO && !MFMA_SCALED, "E6 accumulators must already be in y's fp8 units");
        float mx = 0.f;
#pragma unroll
        for (int ai = 0; ai < 2; ++ai)
#pragma unroll
            for (int m = 0; m < 4; ++m)
#pragma unroll
                for (int q = 0; q < 4; ++q) { const f32x4 v = acc[ai][q >> 1][m][q & 1]; mx = fmaxf(fmaxf(fabsf(v[0]), fabsf(v[1])), mx); mx = fmaxf(fmaxf(fabsf(v[2]), fabsf(v[3])), mx); }
        const bool big = __builtin_amdgcn_ballot_w64(!(mx <= 448.f)) != 0ull;
        if (!big) {
#pragma unroll
            for (int ai = 0; ai < 2; ++ai)
#pragma unroll
                for (int m = 0; m < 4; ++m) { GAS unsigned char* rowp = y + (size_t)(row0 + ai * HALF + m * 16) * D + col0; u32x4 w;
                    { const f32x4 v0 = acc[ai][0][m][0], v1 = acc[ai][0][m][1], v2 = acc[ai][1][m][0], v3 = acc[ai][1][m][1];
                      w.x = pk4_fp8_nc(v0[0], v0[1], v0[2], v0[3]); w.y = pk4_fp8_nc(v1[0], v1[1], v1[2], v1[3]); w.z = pk4_fp8_nc(v2[0], v2[1], v2[2], v2[3]); w.w = pk4_fp8_nc(v3[0], v3[1], v3[2], v3[3]); }
                    __builtin_nontemporal_store(w, (GAS u32x4*)rowp); }
        } else {
#pragma unroll
            for (int ai = 0; ai < 2; ++ai)
#pragma unroll
                for (int m = 0; m < 4; ++m) { GAS unsigned char* rowp = y + (size_t)(row0 + ai * HALF + m * 16) * D + col0; u32x4 w;
                    { const f32x4 v0 = acc[ai][0][m][0], v1 = acc[ai][0][m][1], v2 = acc[ai][1][m][0], v3 = acc[ai][1][m][1];
                      w.x = pk4_fp8(v0[0], v0[1], v0[2], v0[3]); w.y = pk4_fp8(v1[0], v1[1], v1[2], v1[3]); w.z = pk4_fp8(v2[0], v2[1], v2[2], v2[3]); w.w = pk4_fp8(v3[0], v3[1], v3[2], v3[3]); }
                    __builtin_nontemporal_store(w, (GAS u32x4*)rowp); }
        }
    }
};

__device__ __forceinline__ void stage2(LAS unsigned char* dst, const GAS char* g0, const GAS char* g1) {
    __builtin_amdgcn_global_load_lds((const GAS unsigned*)g0, (LAS unsigned*)dst, 16, 0, 0);
    __builtin_amdgcn_global_load_lds((const GAS unsigned*)g1, (LAS unsigned*)(dst + 1024), 16, 0, 0);
}

template <int PK = -1, class Prob, class Epi, class Sched>
__device__ __forceinline__ void gemm_phase(LAS unsigned char* lds, const int tid, const Prob& P, const Sched& S, const Epi& E) {
    constexpr bool GATHER = Prob::GATHER;
    const int wid = __builtin_amdgcn_readfirstlane(tid >> 6), lane = tid & 63, wr = wid >> 2, wc = wid & 3, fr = lane & 15, fq = lane >> 4;
    const int K = P.K, nt = K / 128;
    unsigned voffA[2], voffB[2], voffB1[2]; int RA[2], CA2[2];
#pragma unroll
    for (int i = 0; i < 2; ++i) { int R, C; stage_rc((2 * wid + i) * 1024 + lane * 16, R, C);   const int Rb = Epi::PERM ? ((R & ~31) + perm32(R & 31)) : R;
        voffA[i] = (unsigned)(R * K + C * 2); voffB[i] = (unsigned)(Rb * K + C * 2); voffB1[i] = 0u; RA[i] = R; CA2[i] = C * 2;
        if (Epi::PERM == 2) { const int w_ = R >> 5, n_ = (R >> 4) & 1, q_ = (R >> 2) & 3, j_ = R & 3, src = 64 * w_ + 16 * q_ + 4 * n_ + j_;
            voffB[i] = (unsigned)(src * K + C * 2); voffB1[i] = (unsigned)((src + 8) * K + C * 2); } }
    const size_t kstep = (size_t)(BK * 2);
    const size_t hstep = (size_t)HALF * K;
    const unsigned ldsw = (unsigned)wid * 2048u;
    const int aoff = lds_byte(wr * 64 + fr, fq * 8), boff = lds_byte(wc * 32 + fr, fq * 8);
#define PG8_SA(b, h) (((b) * 2 + (h)) * HTB)
#define PG8_SB(b, h) ((4 + (b) * 2 + (h)) * HTB)
#define PG8_STG_B(bufoff, pb) stage2(lds + (bufoff) + ldsw, (pb) + voffB[0], (pb) + voffB[1])
#define PG8_STG_B1(bufoff, pb) do { if (Epi::PERM == 2) stage2(lds + (bufoff) + ldsw, (pb) + voffB1[0], (pb) + voffB1[1]); else stage2(lds + (bufoff) + ldsw, (pb) + hstep + voffB[0], (pb) + hstep + voffB[1]); } while (0)
#define PG8_STG_A(bufoff, NXT, h, kb) do { const GAS char* _b = ((NXT) ? nA : cA) + (kb) + (GATHER ? (size_t)0 : (size_t)(h) * hstep); \
        const unsigned _o0 = GATHER ? ((NXT) ? nvA[h][0] : vA[h][0]) : voffA[0], _o1 = GATHER ? ((NXT) ? nvA[h][1] : vA[h][1]) : voffA[1]; \
        stage2(lds + (bufoff) + ldsw, _b + _o0, _b + _o1); } while (0)
#define PG8_LDA(dst, b, h) do { _Pragma("unroll") for (int m = 0; m < 4; ++m) _Pragma("unroll") for (int k = 0; k < 2; ++k) dst[m][k] = *(const LAS bf16x8*)(lds + PG8_SA(b, h) + aoff + m * 2048 + k * 1024); } while (0)
#define PG8_LDB(dst, b, h) do { _Pragma("unroll") for (int n = 0; n < 2; ++n) _Pragma("unroll") for (int k = 0; k < 2; ++k) dst[n][k] = *(const LAS bf16x8*)(lds + PG8_SB(b, h) + boff + n * 2048 + k * 1024); } while (0)
#define PG8_CAT(x) __builtin_shufflevector(__builtin_bit_cast(i32x4, (x)[0]), __builtin_bit_cast(i32x4, (x)[1]), 0, 1, 2, 3, 4, 5, 6, 7)
#define PG8_MMA(ai, bj, At, Bt) do { if (PG8_SEGPRIO) __builtin_amdgcn_s_setprio(1); _Pragma("unroll") for (int m = 0; m < 4; ++m) _Pragma("unroll") for (int n = 0; n < 2; ++n) \
        { if (MFMA_SCALED) asm volatile("v_mfma_scale_f32_16x16x128_f8f6f4 %0, %1, %2, %0, %3, %4 op_sel_hi:[0,0,0]" : "+v"(acc[ai][bj][m][n]) : "v"(PG8_CAT(Bt[n])), "v"(PG8_CAT(At[m])), "v"(scb), "v"(sca)); \
          else asm volatile("v_mfma_f32_16x16x128_f8f6f4 %0, %1, %2, %0" : "+v"(acc[ai][bj][m][n]) : "v"(PG8_CAT(Bt[n])), "v"(PG8_CAT(At[m]))); } if (PG8_SEGPRIO) __builtin_amdgcn_s_setprio(0); } while (0)
#define PG8_MMAZ(ai, bj, At, Bt) do { if (PG8_SEGPRIO) __builtin_amdgcn_s_setprio(1); _Pragma("unroll") for (int m = 0; m < 4; ++m) _Pragma("unroll") for (int n = 0; n < 2; ++n) \
        { asm volatile("v_mfma_f32_16x16x128_f8f6f4 %0, %1, %2, 0" : "+v"(acc[ai][bj][m][n]) : "v"(PG8_CAT(Bt[n])), "v"(PG8_CAT(At[m]))); } if (PG8_SEGPRIO) __builtin_amdgcn_s_setprio(0); } while (0)
#define PG8_WAIT_V(n) asm volatile("s_waitcnt vmcnt(" #n ")" ::: "memory")
#define PG8_WAIT_L(n) asm volatile("s_waitcnt lgkmcnt(" #n ")" ::: "memory")
#define PG8_BAR __builtin_amdgcn_s_barrier()
#define PG8_SCHED __builtin_amdgcn_sched_barrier(0)
#define PG8_TRIP(t, MM) do { \
            const bool last = (t == nt - 2); \
            const size_t kb1 = (size_t)(t + 1) * kstep; \
            const size_t kb2 = last ? (size_t)0 : (size_t)(t + 2) * kstep, kb3 = kb2 + kstep; \
            const GAS char* b2 = (last ? nB : cB) + kb2; const GAS char* b3 = b2 + kstep; \
            if (GATHER && t == 0 && has_next) P.gather(nxt, RA, CA2, nvA); \
            PG8_LDB(B0, 0, 0); PG8_LDB(B1, 0, 1); PG8_SCHED; PG8_LDA(At, 0, 0); PG8_STG_A(PG8_SA(1, 1), false, 1, kb1); \
            PG8_WAIT_V(8); PG8_WAIT_L(0); PG8_BAR; MM(0, 0, At, B0); MM(0, 1, At, B1); PG8_BAR; PG8_SCHED; \
            PG8_LDA(At, 0, 1); PG8_STG_B(PG8_SB(0, 0), b2); PG8_STG_B1(PG8_SB(0, 1), b2); PG8_STG_A(PG8_SA(0, 0), last, 0, kb2); \
            PG8_WAIT_V(8); PG8_WAIT_L(0); PG8_BAR; MM(1, 0, At, B0); MM(1, 1, At, B1); PG8_BAR; PG8_SCHED; \
            PG8_LDB(B0, 1, 0); PG8_LDB(B1, 1, 1); PG8_SCHED; PG8_LDA(At, 1, 0); PG8_STG_A(PG8_SA(0, 1), last, 1, kb2); \
            PG8_WAIT_V(8); PG8_WAIT_L(0); PG8_BAR; PG8_MMA(0, 0, At, B0); PG8_MMA(0, 1, At, B1); PG8_BAR; PG8_SCHED; \
            PG8_LDA(At, 1, 1); PG8_STG_B(PG8_SB(1, 0), b3); PG8_STG_B1(PG8_SB(1, 1), b3); PG8_STG_A(PG8_SA(1, 0), last, 0, kb3); \
            PG8_WAIT_V(8); PG8_WAIT_L(0); PG8_BAR; PG8_MMA(1, 0, At, B0); PG8_MMA(1, 1, At, B1); PG8_BAR; PG8_SCHED; \
        } while (0)
    constexpr bool ZC = !MFMA_SCALED && Epi::NOKEEP;
    Unit cur, nxt; int ui = 0;
    if (!S.next(0, cur)) return;
    if (!PG8_SEGPRIO && wr == 1) __builtin_amdgcn_s_setprio(1);
    const int sca = Prob::SCA, scb = Prob::SCB;
    Acc acc;
#pragma unroll
    for (int a = 0; a < 2; ++a)
#pragma unroll
        for (int b = 0; b < 2; ++b)
#pragma unroll
            for (int m = 0; m < 4; ++m)
#pragma unroll
                for (int n = 0; n < 2; ++n) acc[a][b][m][n] = (f32x4){0.f, 0.f, 0.f, 0.f};
    bf16x8 At[4][2], B0[2][2], B1[2][2];
    unsigned vA[2][2] = {{0u, 0u}, {0u, 0u}}, nvA[2][2] = {{0u, 0u}, {0u, 0u}};
    const GAS char* cA = P.a_base(cur); const GAS char* cB = P.b_base(cur);
    const GAS char* nA = cA;
    if (GATHER) { P.gather(cur, RA, CA2, vA); }
    {
        const bool F = false;
        PG8_STG_B(PG8_SB(0, 0), cB); PG8_STG_B1(PG8_SB(0, 1), cB); PG8_STG_A(PG8_SA(0, 0), F, 0, (size_t)0); PG8_STG_A(PG8_SA(0, 1), F, 1, (size_t)0);
        if (wr == 1) PG8_BAR;
        PG8_WAIT_V(2); PG8_BAR;
        PG8_STG_B(PG8_SB(1, 0), cB + kstep); PG8_STG_A(PG8_SA(1, 0), F, 0, kstep); PG8_STG_B1(PG8_SB(1, 1), cB + kstep);
        PG8_WAIT_V(6); PG8_BAR;
    }
    for (;;) {
        const bool has_next = S.next(ui + 1, nxt);
        nA = has_next ? P.a_base(nxt) : cA; const GAS char* nB = has_next ? P.b_base(nxt) : cB;
        if (GATHER && !has_next) {
#pragma unroll
            for (int h = 0; h < 2; ++h) { nvA[h][0] = vA[h][0]; nvA[h][1] = vA[h][1]; } }
        if (ZC) { PG8_TRIP(0, PG8_MMAZ); for (int t = 2; t < nt; t += 2) PG8_TRIP(t, PG8_MMA); }
        else { for (int t = 0; t < nt; t += 2) PG8_TRIP(t, PG8_MMA); }
        GSTAMP(lds, PK);
        typename Epi::Pre pre; E.prefetch(pre, cur, wr, wc, fr, fq);
        if (wr == 0) PG8_BAR;
        asm volatile("s_nop 15\n\ts_nop 15\n\ts_nop 15" ::: "memory");
        E(acc, cur, wr, wc, fr, fq, pre);
        GSTAMP(lds, PK < 0 ? -1 : PK + 1);
        if (!has_next) break;
        if (!ZC && !E.keep(cur)) {
#pragma unroll
            for (int a = 0; a < 2; ++a)
#pragma unroll
                for (int b = 0; b < 2; ++b)
#pragma unroll
                    for (int m = 0; m < 4; ++m)
#pragma unroll
                        for (int n = 0; n < 2; ++n) acc[a][b][m][n] = (f32x4){0.f, 0.f, 0.f, 0.f};
        }
        cur = nxt; cA = nA; cB = nB; ++ui;
        if (GATHER) {
#pragma unroll
            for (int h = 0; h < 2; ++h) { vA[h][0] = nvA[h][0]; vA[h][1] = nvA[h][1]; } }
        if (wr == 1) PG8_BAR;
    }
    PG8_WAIT_V(0);
    PG8_BAR;
    if (!PG8_SEGPRIO) __builtin_amdgcn_s_setprio(0);
#undef PG8_SA
#undef PG8_SB
#undef PG8_STG_A
#undef PG8_STG_B
#undef PG8_STG_B1
#undef PG8_LDA
#undef PG8_LDB
#undef PG8_MMA
#undef PG8_MMAZ
#undef PG8_TRIP
#undef PG8_CAT
#undef PG8_WAIT_V
#undef PG8_WAIT_L
#undef PG8_BAR
#undef PG8_SCHED
}
}

struct Frame {
    LAS unsigned char* lds; int tid, lane, wave, vcu, G;
    GAS unsigned char* ws;
};
#define NWAVES 8

__device__ __forceinline__ void transpose_item(const GAS float* W, int N, GAS bf16_t* WT, int ldo, int row_mul, int row_add, LAS float* scr, int item, int lane) {
    const int nblk = N / 32, kb = item / nblk, nb = item % nblk, k0 = 64 * kb, n0 = 32 * nb;
#pragma unroll 8
    for (int i = 0; i < 32; ++i) { const int kk = 2 * i + (lane >> 5); scr[kk * 33 + (lane & 31)] = W[(size_t)(k0 + kk) * N + n0 + (lane & 31)]; }
    LDS_WAIT(); asm volatile("" ::: "memory");
    const int c = lane & 7;
#pragma unroll
    for (int j = 0; j < 4; ++j) { const int n = (lane >> 3) + 8 * j; const LAS float* s = scr + (8 * c) * 33 + n;
        u32x4 o; o.x = cvt_pk_bf16(s[0 * 33], s[1 * 33]); o.y = cvt_pk_bf16(s[2 * 33], s[3 * 33]); o.z = cvt_pk_bf16(s[4 * 33], s[5 * 33]); o.w = cvt_pk_bf16(s[6 * 33], s[7 * 33]);
        *(GAS u32x4*)(WT + (size_t)((n0 + n) * row_mul + row_add) * ldo + k0 + 8 * c) = o; }
    LDS_WAIT(); asm volatile("" ::: "memory");
}

__device__ __forceinline__ void transpose_item8(const GAS float* W, int N, GAS unsigned char* WT, int ldo, int row_mul, int row_add, LAS float* scr, int item, int lane, const float wsc = SC_W) {
    const int nblk = N / 32, kb = item / nblk, nb = item % nblk, k0 = 64 * kb, n0 = 32 * nb;
    { const int q4 = 4 * (lane & 7), r8 = lane >> 3; f32x4 v[8];
#pragma unroll
      for (int i = 0; i < 8; ++i) v[i] = *(const GAS f32x4*)(W + (size_t)(k0 + 8 * i + r8) * N + n0 + q4);
#pragma unroll
      for (int i = 0; i < 8; ++i) { LAS float* d = scr + (8 * i + r8) * 33 + q4; d[0] = v[i][0] * wsc; d[1] = v[i][1] * wsc; d[2] = v[i][2] * wsc; d[3] = v[i][3] * wsc; } }
    LDS_WAIT(); asm volatile("" ::: "memory");
    const int c = lane & 7;
#pragma unroll
    for (int j = 0; j < 4; ++j) { const int n = (lane >> 3) + 8 * j; const LAS float* q = scr + (8 * c) * 33 + n;
        u32x2 o; o.x = pk4_fp8(q[0 * 33], q[1 * 33], q[2 * 33], q[3 * 33]); o.y = pk4_fp8(q[4 * 33], q[5 * 33], q[6 * 33], q[7 * 33]);
        *(GAS u32x2*)(WT + (size_t)((n0 + n) * row_mul + row_add) * ldo + k0 + 8 * c) = o; }
    LDS_WAIT(); asm volatile("" ::: "memory");
}

__device__ __forceinline__ void convert_layer(const Frame& F, const Args& a, int l) {
    LAS float* scr = (LAS float*)(F.lds + F.wave * 16384);
    const int gw = F.vcu * NWAVES + F.wave, NGW = F.G * NWAVES;
    GAS unsigned char* ws = F.ws;
    constexpr int I_IN = 16 * 192, I_SQ = 16 * 32, I_E1 = 16 * 8, I_E2 = 4 * 32, I_RG = 2 * 4;
    constexpr int N0 = I_IN, N1 = N0 + 3 * I_SQ, N2 = N1 + 64 * I_E1, N3 = N2 + 64 * I_E1, N4 = N3 + 2 * I_E1, N5 = N4 + 64 * I_E2, N6 = N5 + I_E2, N7 = N6 + 8 * I_RG, N8 = N7 + 8 * I_RG;
    for (int it = gw; it < N8; it += NGW) {
        if (it < N0) { transpose_item8(((const GAS float*)a.in[4]) + (size_t)l * D * NIN, NIN, (GAS unsigned char*)(ws + W_IN), D, 1, 0, scr, it, F.lane); }
        else if (it < N1) { const int r = it - N0, w = r / I_SQ, ii = r % I_SQ; const GAS float* src = ((const GAS float*)a.in[16 + w]) + (size_t)l * D * D; GAS unsigned char* dst = (GAS unsigned char*)(ws + (w == 0 ? W_A : (w == 1 ? W_B : W_O)));
            transpose_item8(src, D, dst, D, 1, 0, scr, ii, F.lane); }
        else if (it < N2) { const int r = it - N1, e = r / I_E1, ii = r % I_E1; transpose_item8(((const GAS float*)a.in[23]) + ((size_t)l * NE + e) * D * DE, DE, (GAS unsigned char*)(ws + W_E13) + (size_t)e * 512 * D, D, 2, 0, scr, ii, F.lane); }
        else if (it < N3) { const int r = it - N2, e = r / I_E1, ii = r % I_E1; transpose_item8(((const GAS float*)a.in[24]) + ((size_t)l * NE + e) * D * DE, DE, (GAS unsigned char*)(ws + W_E13) + (size_t)e * 512 * D, D, 2, 1, scr, ii, F.lane); }
        else if (it < N4) { const int r = it - N3, w = r / I_E1, ii = r % I_E1; transpose_item8(((const GAS float*)a.in[26 + w]) + (size_t)l * D * DE, DE, (GAS unsigned char*)(ws + W_E13) + (size_t)64 * 512 * D, D, 2, w, scr, ii, F.lane); }
        else if (it < N5) { const int r = it - N4, e = r / I_E2, ii = r % I_E2; transpose_item8(((const GAS float*)a.in[25]) + ((size_t)l * NE + e) * DE * D, D, (GAS unsigned char*)(ws + W_E2) + (size_t)e * D * DE, DE, 1, 0, scr, ii, F.lane, SC_W2); }
        else if (it < N6) { const int ii = it - N5; transpose_item8(((const GAS float*)a.in[28]) + (size_t)l * DE * D, D, (GAS unsigned char*)(ws + W_E2) + (size_t)64 * D * DE, DE, 1, 0, scr, ii, F.lane, SC_W2); }
        else if (it < N7) { const int r = it - N6, h = r / I_RG, ii = r % I_RG; transpose_item(((const GAS float*)a.in[11]) + ((size_t)l * 8 + h) * 128 * 128, 128, (GAS bf16_t*)(ws + W_RGA) + (size_t)h * 128 * 128, 128, 1, 0, scr, ii, F.lane); }
        else { const int r = it - N7, h = r / I_RG, ii = r % I_RG; transpose_item(((const GAS float*)a.in[13]) + ((size_t)l * 8 + h) * 128 * 128, 128, (GAS bf16_t*)(ws + W_RGX) + (size_t)h * 128 * 128, 128, 1, 0, scr, ii, F.lane); }
    }
    const int gt = F.vcu * 512 + F.tid, NGT = F.G * 512;
    for (int i = gt; i < 8 * 128 * 128; i += NGT) { const int s = i & 127, t = (i >> 7) & 127; const float v = ((const GAS float*)a.in[7])[(size_t)l * 8 * 128 * 128 + i];
        ((GAS bf16_t*)(ws + W_SG))[i] = (bf16_t)(cvt_pk_bf16(s <= t ? v : 0.f, 0.f) & 0xffffu); }
    for (int i = gt; i < 64 * 1024; i += NGT) { const int c = i >> 6, e = i & 63; const float v = ((const GAS float*)a.in[21])[(size_t)l * D * 64 + i];
        const unsigned hi = cvt_pk_bf16(v, 0.f) & 0xffffu; const float r = v - __uint_as_float(hi << 16);
        ((GAS bf16_t*)(ws + W_RH))[e * D + c] = (bf16_t)hi; ((GAS bf16_t*)(ws + W_RL))[e * D + c] = (bf16_t)(cvt_pk_bf16(r, 0.f) & 0xffffu); }
    for (int i = gt; i < D; i += NGT) ((GAS float*)(ws + WS_MISC))[i] = 8.0f * log1pf(expf(-((const GAS float*)a.in[15])[(size_t)l * D + i]));
}

__device__ __forceinline__ void ada_phase(const Frame& F, const Args& a) {
    LAS float* sc = (LAS float*)F.lds;
    LAS float* red = (LAS float*)(F.lds + 65536);
    bool loaded = false;
    for (int u = F.vcu; u < 4 * 96; u += F.G) {
        if (!loaded) { for (int i = F.tid; i < 16 * D; i += 512) { const int b = i >> 10, k = i & 1023; const float v = ((const GAS float*)a.in[1])[i]; sc[k * 16 + b] = v * fsigmoid(v); } loaded = true; __syncthreads(); }
        const int l = u / 96, j0 = (u % 96) * 64, jj = F.tid & 63, ks = F.tid >> 6;
        float acc[16];
#pragma unroll
        for (int b = 0; b < 16; ++b) acc[b] = 0.f;
        const GAS float* wp = ((const GAS float*)a.in[2]) + ((size_t)l * D + ks * 128) * NIN + j0 + jj;
#pragma unroll 4
        for (int k = 0; k < 128; ++k) { const float w = wp[(size_t)k * NIN]; const LAS f32x4* s4 = (const LAS f32x4*)(sc + (ks * 128 + k) * 16);
#pragma unroll
            for (int q = 0; q < 4; ++q) { const f32x4 sv = s4[q]; acc[4 * q] += sv[0] * w; acc[4 * q + 1] += sv[1] * w; acc[4 * q + 2] += sv[2] * w; acc[4 * q + 3] += sv[3] * w; } }
#pragma unroll
        for (int b = 0; b < 16; ++b) red[(ks * 16 + b) * 64 + jj] = acc[b];
        __syncthreads();
#pragma unroll
        for (int p = 0; p < 2; ++p) { const int o = F.tid + 512 * p, b = o >> 6, j = o & 63; float s = 0.f;
#pragma unroll
            for (int k2 = 0; k2 < 8; ++k2) s += red[(k2 * 16 + b) * 64 + j];
            ((GAS float*)(F.ws + WS_ADA))[((size_t)l * 16 + b) * NIN + j0 + j] = s + ((const GAS float*)a.in[3])[(size_t)l * NIN + j0 + j]; }
        __syncthreads();
    }
}

__device__ __forceinline__ void modulate0(const Frame& F, const Args& a) {
    const GAS float* ada = (const GAS float*)(F.ws + WS_ADA); GAS unsigned char* H = (GAS unsigned char*)(F.ws + B_H8);
    const size_t NG = (size_t)T * D / 8;
    for (size_t i = (size_t)F.vcu * 512 + F.tid; i < NG; i += (size_t)F.G * 512) {
        const size_t t = i >> 7; const int c = (int)(i & 127) * 8; const int b = (int)(t >> 12);
        const GAS float* xp = ((const GAS float*)a.in[0]) + t * D + c; const f32x4 x0 = *(const GAS f32x4*)xp, x1 = *(const GAS f32x4*)(xp + 4);
        const GAS float* sh = ada + (size_t)b * NIN + c; const f32x4 h0 = *(const GAS f32x4*)sh, h1 = *(const GAS f32x4*)(sh + 4), s0 = *(const GAS f32x4*)(sh + D), s1 = *(const GAS f32x4*)(sh + D + 4);
        const f32x4 r0 = (x0 * (s0 + 1.0f) + h0) * SC_H, r1 = (x1 * (s1 + 1.0f) + h1) * SC_H;
        u32x2 o; o.x = pk4_fp8(r0[0], r0[1], r0[2], r0[3]); o.y = pk4_fp8(r1[0], r1[1], r1[2], r1[3]);
        *(GAS u32x2*)(H + t * D + c) = o;
    }
}


__device__ __forceinline__ void vstats_phase(const Frame& F) {
    const GAS unsigned char* V = (const GAS unsigned char*)(F.ws + B_V); GAS f32x2* vs = (GAS f32x2*)(F.ws + WS_VSTAT);
    const int gw = F.vcu * NWAVES + F.wave, NGW = F.G * NWAVES;
    for (int row = gw; row < T; row += NGW) {
        const u32x4 rw = *(const GAS u32x4*)(V + (size_t)row * D + 16 * F.lane); float f[16];
        { float t8[8]; unpack8_fp8((u32x2){rw.x, rw.y}, t8);
#pragma unroll
          for (int j = 0; j < 8; ++j) f[j] = t8[j] * (1.0f / SC_Z);
          unpack8_fp8((u32x2){rw.z, rw.w}, t8);
#pragma unroll
          for (int j = 0; j < 8; ++j) f[8 + j] = t8[j] * (1.0f / SC_Z); }
        float s = 0.f;
#pragma unroll
        for (int j = 0; j < 16; ++j) s += f[j];
        const float mean = wave_sum(s) * (1.0f / D); float q = 0.f;
#pragma unroll
        for (int j = 0; j < 16; ++j) { const float d = f[j] - mean; q += d * d; }
        const float rstd = rsqrtf(wave_sum(q) * (1.0f / D) + LN_EPS);
        if (F.lane == 0) vs[row] = (f32x2){mean, rstd};
    }
}

__device__ __forceinline__ void vstat_row(const u32x4 rw, GAS f32x2* dst, int lane) {
    float f[16];
    { float t8[8]; unpack8_fp8((u32x2){rw.x, rw.y}, t8);
#pragma unroll
      for (int j = 0; j < 8; ++j) f[j] = t8[j] * (1.0f / SC_Z);
      unpack8_fp8((u32x2){rw.z, rw.w}, t8);
#pragma unroll
      for (int j = 0; j < 8; ++j) f[8 + j] = t8[j] * (1.0f / SC_Z); }
    float s = 0.f;
#pragma unroll
    for (int j = 0; j < 16; ++j) s += f[j];
    const float mean = wave_sum(s) * (1.0f / D); float q = 0.f;
#pragma unroll
    for (int j = 0; j < 16; ++j) { const float d = f[j] - mean; q += d * d; }
    const float rstd = rsqrtf(wave_sum(q) * (1.0f / D) + LN_EPS);
    if (lane == 0) *dst = (f32x2){mean, rstd};
}
__device__ __forceinline__ void rg_phase(const Frame& F, const Args& a, int l) {
    LAS unsigned char* lds = F.lds; const int tid0 = F.tid, wid = F.wave, wr = wid >> 2, wc = wid & 3;
    GAS unsigned char* ws = F.ws;
    const int hd = F.vcu & 7, g0 = F.vcu >> 3, gstep = F.G >> 3;
    const GAS bf16_t* RI = (const GAS bf16_t*)(ws + B_RI);
    GAS bf16_t* HL = (GAS bf16_t*)(ws + B_HL); GAS bf16_t* CA = (GAS bf16_t*)(ws + B_CA);
    LAS unsigned char* At = lds;
    LAS float* CST = (LAS float*)(lds + 143360);
    const int c0 = hd * 128 + (tid0 & 15) * 8;
    __syncthreads();
    for (int i = tid0; i < 8 * 128; i += 512) { const int r = i >> 7, c = hd * 128 + (i & 127); float v;
        if (r < 4) v = ((const GAS float*)a.in[9])[((size_t)l * 4 + r) * D + c] * (1.0f / SC_Z); else if (r == 4) v = ((const GAS float*)a.in[10])[(size_t)l * D + c];
        else if (r == 5) v = ((const GAS float*)a.in[12])[(size_t)l * D + c]; else if (r == 6) v = ((const GAS float*)a.in[14])[(size_t)l * D + c]; else v = ((const GAS float*)(ws + WS_MISC))[c];
        CST[i] = v; }
    bf16x8 ba[2][4], bx[2][4];
#pragma unroll
    for (int n = 0; n < 2; ++n)
#pragma unroll
        for (int kk = 0; kk < 4; ++kk) { const size_t o = ((size_t)hd * 128 + wc * 32 + n * 16 + (tid0 & 15)) * 128 + kk * 32 + ((tid0 & 63) >> 4) * 8;
            ba[n][kk] = *(const GAS bf16x8*)((const GAS bf16_t*)(ws + W_RGA) + o); bx[n][kk] = *(const GAS bf16x8*)((const GAS bf16_t*)(ws + W_RGX) + o); }
    __syncthreads();
    u32x2 rv[4][4];
    const __amdgpu_buffer_rsrc_t rsRI = __builtin_amdgcn_make_buffer_rsrc((void*)(a.ws + B_RI), 0, 0x4000000, 0x00020000);
    const __amdgpu_buffer_rsrc_t rsHL = __builtin_amdgcn_make_buffer_rsrc((void*)(a.ws + B_HL), 0, 0x8000000, 0x00020000);
    const __amdgpu_buffer_rsrc_t rsCA = __builtin_amdgcn_make_buffer_rsrc((void*)(a.ws + B_CA), 0, 0x8000000, 0x00020000);
    const int vo = ((tid0 >> 4) * D + c0) * 2;
#define RG_LOAD(gc_) do { const int _nch = (gc_) & 31; const int _t0 = (gc_) * 128; \
        _Pragma("unroll") for (int p = 0; p < 4; ++p) { const int t = (tid0 >> 4) + 32 * p; \
            _Pragma("unroll") for (int k = 0; k < 4; ++k) { const int tt = t - 3 + k; rv[p][k] = (u32x2){0u, 0u}; \
                if (tt >= 0 || _nch > 0) rv[p][k] = __builtin_amdgcn_raw_buffer_load_b64(rsRI, vo >> 1, (_t0 + 32 * p + k - 3) * D, 0); } } } while (0)
    if (g0 < 512) RG_LOAD(g0);
    for (int gc = g0; gc < 512; gc += gstep) {
        const size_t t0 = (size_t)gc * 128;
        int tq = tid0; asm volatile("" : "+v"(tq));
        const int tid = tq, lane = tq & 63, fr = lane & 15, fq = lane >> 4, cb = tq & 15;
        const int vit = (gc - g0) / gstep; const size_t vrow = (size_t)(F.vcu * NWAVES + wid) * 32 + 2 * vit;
        const u32x4 vsa = *(const GAS u32x4*)((const GAS unsigned char*)(ws + B_V) + vrow * D + 16 * lane), vsb = *(const GAS u32x4*)((const GAS unsigned char*)(ws + B_V) + (vrow + 1) * D + 16 * lane);
#pragma unroll
        for (int p = 0; p < 4; ++p) { const int t = (tid >> 4) + 32 * p; float r[8];
            { const f32x4 b0 = *(const LAS f32x4*)(CST + 4 * 128 + cb * 8), b1 = *(const LAS f32x4*)(CST + 4 * 128 + cb * 8 + 4);
#pragma unroll
              for (int j = 0; j < 4; ++j) { r[j] = b0[j]; r[4 + j] = b1[j]; } }
#pragma unroll
            for (int k = 0; k < 4; ++k) { float v[8]; unpack8_fp8(rv[p][k], v); const f32x4 w0 = *(const LAS f32x4*)(CST + k * 128 + cb * 8), w1 = *(const LAS f32x4*)(CST + k * 128 + cb * 8 + 4);
#pragma unroll
                for (int j = 0; j < 4; ++j) { r[j] += w0[j] * v[j]; r[4 + j] += w1[j] * v[4 + j]; } }
            *(LAS u32x4*)(At + t * 272 + cb * 16) = pack8(r); }
        __syncthreads();
        f32x4 ga[4][2], gx[4][2];
#pragma unroll
        for (int m = 0; m < 4; ++m)
#pragma unroll
            for (int n = 0; n < 2; ++n) { ga[m][n] = (f32x4){0.f, 0.f, 0.f, 0.f}; gx[m][n] = (f32x4){0.f, 0.f, 0.f, 0.f}; }
#pragma unroll
        for (int kk = 0; kk < 4; ++kk) { bf16x8 af[4];
#pragma unroll
            for (int m = 0; m < 4; ++m) af[m] = *(const LAS bf16x8*)(At + (wr * 64 + m * 16 + fr) * 272 + (kk * 32 + fq * 8) * 2);
#pragma unroll
            for (int m = 0; m < 4; ++m)
#pragma unroll
                for (int n = 0; n < 2; ++n) { ga[m][n] = __builtin_amdgcn_mfma_f32_16x16x32_bf16(ba[n][kk], af[m], ga[m][n], 0, 0, 0); gx[m][n] = __builtin_amdgcn_mfma_f32_16x16x32_bf16(bx[n][kk], af[m], gx[m][n], 0, 0, 0); } }
#pragma unroll
        for (int n = 0; n < 2; ++n) { const int j0 = wc * 32 + n * 16 + 4 * fq;
            const f32x4 bav = *(const LAS f32x4*)(CST + 5 * 128 + j0), bxv = *(const LAS f32x4*)(CST + 6 * 128 + j0), spv = *(const LAS f32x4*)(CST + 7 * 128 + j0);
#pragma unroll
            for (int m = 0; m < 4; ++m) { const int t = wr * 64 + m * 16 + fr; const u32x2 rw = *(const LAS u32x2*)(At + t * 272 + j0 * 2);
                const float rin[4] = {bf_lo(rw.x), bf_hi(rw.x), bf_lo(rw.y), bf_hi(rw.y)};
#pragma unroll
                for (int r = 0; r < 4; ++r) { const float rg = fsigmoid(ga[m][n][r] + bav[r]), ig = fsigmoid(gx[m][n][r] + bxv[r]);
                    const float av = __builtin_amdgcn_exp2f(-(spv[r] * LOG2E) * rg);
                    const float om = 1.0f - av * av;
                    ga[m][n][r] = av; gx[m][n][r] = sqrtf(fmaxf(om, 0.f)) * ig * rin[r]; } } }
        __syncthreads();
        LAS float* PA = (LAS float*)lds; LAS float* PI = (LAS float*)(lds + 67584);
#pragma unroll
        for (int m = 0; m < 4; ++m)
#pragma unroll
            for (int n = 0; n < 2; ++n) { const int t = wr * 64 + m * 16 + fr, j0 = wc * 32 + n * 16 + 4 * fq; *(LAS f32x4*)(PA + t * 132 + j0) = ga[m][n]; *(LAS f32x4*)(PI + t * 132 + j0) = gx[m][n]; }
        __syncthreads();
        vstat_row(vsa, (GAS f32x2*)(ws + WS_VSTAT) + vrow, lane); vstat_row(vsb, (GAS f32x2*)(ws + WS_VSTAT) + vrow + 1, lane);
        if (gc + gstep < 512) RG_LOAD(gc + gstep);
        LAS f32x2* SE = (LAS f32x2*)(lds + 135168); LAS float* CRC = (LAS float*)(lds + 135168 + 4096); LAS float* CRH = CRC + 512;
        const int c = tid & 127, seg = tid >> 7; float h = 0.f, cum = 1.f;
#pragma unroll 8
        for (int tt = 0; tt < 32; ++tt) { const int t = seg * 32 + tt; const float av = PA[t * 132 + c], xv = PI[t * 132 + c]; h = av * h + xv; cum *= av; PI[t * 132 + c] = h; PA[t * 132 + c] = cum; }
        SE[seg * 128 + c] = (f32x2){cum, h};
        __syncthreads();
        { float ch = 0.f, cc = 1.f;
          for (int sg2 = 0; sg2 < seg; ++sg2) { const f32x2 e = SE[sg2 * 128 + c]; ch = e.x * ch + e.y; cc *= e.x; }
          CRC[seg * 128 + c] = cc; CRH[seg * 128 + c] = ch;
          if (seg == 3) { GAS float* cr = (GAS float*)(ws + WS_CARRY) + (size_t)gc * 2 * D + hd * 128 + c; cr[0] = cum * cc; cr[D] = h + cum * ch; } }
        __syncthreads();
#pragma unroll 1
        for (int p = 0; p < 4; ++p) { const int t = (tid >> 4) + 32 * p, sg = t >> 5; float oh[8], oc[8];
            { const f32x4 cu0 = *(const LAS f32x4*)(PA + t * 132 + cb * 8), cu1 = *(const LAS f32x4*)(PA + t * 132 + cb * 8 + 4), hv0 = *(const LAS f32x4*)(PI + t * 132 + cb * 8), hv1 = *(const LAS f32x4*)(PI + t * 132 + cb * 8 + 4);
              const f32x4 cc0 = *(const LAS f32x4*)(CRC + sg * 128 + cb * 8), cc1 = *(const LAS f32x4*)(CRC + sg * 128 + cb * 8 + 4), ch0 = *(const LAS f32x4*)(CRH + sg * 128 + cb * 8), ch1 = *(const LAS f32x4*)(CRH + sg * 128 + cb * 8 + 4);
              const f32x4 h0 = hv0 + cu0 * ch0, h1 = hv1 + cu1 * ch1, c0v = cu0 * cc0, c1v = cu1 * cc1;
#pragma unroll
              for (int j = 0; j < 4; ++j) { oh[j] = h0[j]; oh[4 + j] = h1[j]; oc[j] = c0v[j]; oc[4 + j] = c1v[j]; } }
            { u32x2 wh8, wc8; wh8.x = pk4_fp8(oh[0] * SC_HL, oh[1] * SC_HL, oh[2] * SC_HL, oh[3] * SC_HL); wh8.y = pk4_fp8(oh[4] * SC_HL, oh[5] * SC_HL, oh[6] * SC_HL, oh[7] * SC_HL);
              wc8.x = pk4_fp8(oc[0] * SC_CA, oc[1] * SC_CA, oc[2] * SC_CA, oc[3] * SC_CA); wc8.y = pk4_fp8(oc[4] * SC_CA, oc[5] * SC_CA, oc[6] * SC_CA, oc[7] * SC_CA);
              __builtin_amdgcn_raw_buffer_store_b64(wh8, rsHL, vo >> 1, ((int)t0 + 32 * p) * D, 0); __builtin_amdgcn_raw_buffer_store_b64(wc8, rsCA, vo >> 1, ((int)t0 + 32 * p) * D, 0); } }
        __syncthreads();
    }
#undef RG_LOAD
}

__device__ __forceinline__ void sgu_phase(const Frame& F, const Args& a, int l) {
    LAS unsigned char* lds = F.lds; const int tid0 = F.tid, wid = F.wave, wr = wid >> 2, wc = wid & 3;
    GAS unsigned char* ws = F.ws;
    const int g = F.vcu & 7, g0 = F.vcu >> 3, gstep = F.G >> 3;
    const GAS unsigned char* U = (const GAS unsigned char*)(ws + B_U); GAS unsigned char* YA = (GAS unsigned char*)(ws + B_YA8); const GAS unsigned char* V = (const GAS unsigned char*)(ws + B_V); const GAS f32x2* vs = (const GAS f32x2*)(ws + WS_VSTAT);
    LAS unsigned char* Wt = lds; LAS unsigned char* Vs = lds + 34816;
    float gam[8], bet[8], bsr[4];
    { const int cb0 = tid0 & 15, c00 = g * 128 + cb0 * 8;
      const GAS float* p = ((const GAS float*)a.in[5]) + (size_t)l * D + c00; const f32x4 w0 = *(const GAS f32x4*)p, w1 = *(const GAS f32x4*)(p + 4); const GAS float* q = ((const GAS float*)a.in[6]) + (size_t)l * D + c00; const f32x4 b0 = *(const GAS f32x4*)q, b1 = *(const GAS f32x4*)(q + 4);
#pragma unroll
      for (int j = 0; j < 4; ++j) { gam[j] = w0[j] * (1.0f / SC_Z); gam[4 + j] = w1[j] * (1.0f / SC_Z); bet[j] = b0[j]; bet[4 + j] = b1[j]; }
#pragma unroll
      for (int m = 0; m < 4; ++m) bsr[m] = ((const GAS float*)a.in[8])[((size_t)l * 8 + g) * 128 + wr * 64 + m * 16 + (tid0 & 15)];
      __syncthreads();
#pragma unroll
      for (int p2 = 0; p2 < 4; ++p2) { const int row = (tid0 >> 4) + 32 * p2;
        *(LAS u32x4*)(Wt + row * 272 + cb0 * 16) = *(const GAS u32x4*)((const GAS bf16_t*)(ws + W_SG) + ((size_t)g * 128 + row) * 128 + cb0 * 8); } }
    u32x2 vraw[4]; f32x2 stv[4]; u32x2 uraw[4];
#define SG_LOAD(gc_) do { const size_t _t0 = (size_t)(gc_) * 128; \
        _Pragma("unroll") for (int p2 = 0; p2 < 4; ++p2) { const int row = (tid0 >> 4) + 32 * p2; vraw[p2] = *(const GAS u32x2*)(V + (_t0 + row) * D + g * 128 + (tid0 & 15) * 8); stv[p2] = vs[_t0 + row]; } \
        _Pragma("unroll") for (int m = 0; m < 4; ++m) uraw[m] = *(const GAS u32x2*)(U + (_t0 + wr * 64 + m * 16 + (tid0 & 15)) * D + g * 128 + wc * 32 + 8 * ((tid0 & 63) >> 4)); } while (0)
    if (g0 < 512) SG_LOAD(g0);
    for (int gc = g0; gc < 512; gc += gstep) {
        const size_t t0 = (size_t)gc * 128;
        int tq = tid0; asm volatile("" : "+v"(tq));
        const int lane = tq & 63, fr = lane & 15, fq = lane >> 4, cb = tq & 15;
#pragma unroll
        for (int p2 = 0; p2 < 4; ++p2) { const int row = (tq >> 4) + 32 * p2; float v[8]; unpack8_fp8(vraw[p2], v); const float ms = stv[p2].x * SC_Z, rs = stv[p2].y;
#pragma unroll
            for (int j = 0; j < 8; ++j) v[j] = (v[j] - ms) * rs * gam[j] + bet[j];
            const u32x4 o = pack8(v); *(LAS u32x2*)(Vs + row * 264 + cb * 16) = (u32x2){o.x, o.y}; *(LAS u32x2*)(Vs + row * 264 + cb * 16 + 8) = (u32x2){o.z, o.w}; }
        u32x2 ucur[4];
#pragma unroll
        for (int m = 0; m < 4; ++m) ucur[m] = uraw[m];
        __syncthreads();
        if (gc + gstep < 512) SG_LOAD(gc + gstep);
        f32x4 acc[4][2];
#pragma unroll
        for (int m = 0; m < 4; ++m)
#pragma unroll
            for (int n = 0; n < 2; ++n) acc[m][n] = (f32x4){0.f, 0.f, 0.f, 0.f};
#pragma unroll
        for (int kk = 0; kk < 4; ++kk) {
            bf16x8 af[4], bfr[2];
#pragma unroll
            for (int m = 0; m < 4; ++m) af[m] = *(const LAS bf16x8*)(Wt + (wr * 64 + m * 16 + fr) * 272 + (kk * 32 + fq * 8) * 2);
#pragma unroll
            for (int n = 0; n < 2; ++n) { const int cc = wc * 32 + 8 * (fr >> 2) + 4 * n + (fr & 3);
#pragma unroll
                for (int e = 0; e < 8; ++e) bfr[n][e] = (short)*(const LAS unsigned short*)(Vs + (kk * 32 + fq * 8 + e) * 264 + cc * 2); }
#pragma unroll
            for (int m = 0; m < 4; ++m)
#pragma unroll
                for (int n = 0; n < 2; ++n) acc[m][n] = __builtin_amdgcn_mfma_f32_16x16x32_bf16(bfr[n], af[m], acc[m][n], 0, 0, 0);
        }
#pragma unroll
        for (int m = 0; m < 4; ++m) { const int t = wr * 64 + m * 16 + fr; const float bs = bsr[m]; const size_t eo = (t0 + t) * D + g * 128 + wc * 32 + 8 * fq; float uf[8]; unpack8_fp8(ucur[m], uf);
            u32x2 o; o.x = pk4_fp8(uf[0] * (acc[m][0][0] + bs) * (SC_Y / SC_Z), uf[1] * (acc[m][0][1] + bs) * (SC_Y / SC_Z), uf[2] * (acc[m][0][2] + bs) * (SC_Y / SC_Z), uf[3] * (acc[m][0][3] + bs) * (SC_Y / SC_Z));
            o.y = pk4_fp8(uf[4] * (acc[m][1][0] + bs) * (SC_Y / SC_Z), uf[5] * (acc[m][1][1] + bs) * (SC_Y / SC_Z), uf[6] * (acc[m][1][2] + bs) * (SC_Y / SC_Z), uf[7] * (acc[m][1][3] + bs) * (SC_Y / SC_Z));
            *(GAS u32x2*)(YA + eo) = o; }
        __syncthreads();
    }
#undef SG_LOAD
}

__device__ __forceinline__ void scanfix_unit(const Frame& F, int gc) {
    GAS unsigned char* ws = F.ws; const int tid = F.tid;
    const GAS unsigned char* RG = (const GAS unsigned char*)(ws + B_RG); GAS unsigned char* YB = (GAS unsigned char*)(ws + B_YB8); const GAS unsigned char* HL = (const GAS unsigned char*)(ws + B_HL); const GAS unsigned char* CA = (const GAS unsigned char*)(ws + B_CA);
    LAS float* hin = (LAS float*)F.lds;
    const int nch = gc & 31, cbk = tid & 63, tseg = tid >> 6;
    if (tid < 128) { float h[8];
#pragma unroll
        for (int j = 0; j < 8; ++j) h[j] = 0.f;
        const GAS float* cr = (const GAS float*)(ws + WS_CARRY) + (size_t)(gc - nch) * 2 * D + tid * 8;
        for (int n = 0; n < nch; ++n) { const f32x4 p0 = *(const GAS f32x4*)(cr + (size_t)n * 2 * D), p1 = *(const GAS f32x4*)(cr + (size_t)n * 2 * D + 4), h0 = *(const GAS f32x4*)(cr + (size_t)n * 2 * D + D), h1 = *(const GAS f32x4*)(cr + (size_t)n * 2 * D + D + 4);
#pragma unroll
            for (int j = 0; j < 4; ++j) { h[j] = p0[j] * h[j] + h0[j]; h[4 + j] = p1[j] * h[4 + j] + h1[j]; } }
#pragma unroll
        for (int j = 0; j < 8; ++j) hin[tid * 8 + j] = h[j] * (1.0f / SC_CA); }
    __syncthreads();
    float hi[16];
#pragma unroll
    for (int j = 0; j < 16; ++j) hi[j] = hin[cbk * 16 + j];
    const size_t base = ((size_t)gc * 128 + tseg * 16) * D + cbk * 16;
    u32x4 rg[4], hl[4], ca[4];
#define SF_LOAD(t0_) do { _Pragma("unroll") for (int q = 0; q < 4; ++q) { const size_t o = base + (size_t)((t0_) + q) * D; rg[q] = *(const GAS u32x4*)(RG + o); hl[q] = *(const GAS u32x4*)(HL + o); ca[q] = *(const GAS u32x4*)(CA + o); } } while (0)
    SF_LOAD(0);
    for (int tb = 0; tb < 16; tb += 4) {
        u32x4 w[4];
#pragma unroll
        for (int q = 0; q < 4; ++q) { float g[16], h[16], c[16]; unpack16_fp8(rg[q], g); unpack16_fp8(hl[q], h); unpack16_fp8(ca[q], c);
#pragma unroll
            for (int j = 0; j < 16; ++j) g[j] = g[j] * (h[j] * (1.0f / SC_HL) + c[j] * hi[j]) * (SC_Y / SC_Z);
            w[q].x = pk4_fp8(g[0], g[1], g[2], g[3]); w[q].y = pk4_fp8(g[4], g[5], g[6], g[7]); w[q].z = pk4_fp8(g[8], g[9], g[10], g[11]); w[q].w = pk4_fp8(g[12], g[13], g[14], g[15]); }
        if (tb + 4 < 16) SF_LOAD(tb + 4);
#pragma unroll
        for (int q = 0; q < 4; ++q) *(GAS u32x4*)(YB + base + (size_t)(tb + q) * D) = w[q];
    }
#undef SF_LOAD
    __syncthreads();
}

__device__ __forceinline__ void ln1_route_phase(const Frame& F, const Args& a, int l) {
    LAS unsigned char* lds = F.lds; const int tid = F.tid, lane = F.lane, wid = F.wave, fr = lane & 15, fq = lane >> 4;
    GAS unsigned char* ws = F.ws;
    LAS float* VEC = (LAS float*)lds;
    LAS float* LG = (LAS float*)(lds + 16384);
    LAS float* ST = (LAS float*)(lds + 49664);
    LAS float* RB = (LAS float*)(lds + 50688);
    LAS int* LCNT = (LAS int*)(lds + 50944);
    LAS int* GBS = (LAS int*)(lds + 51200);
    LAS int* AE = (LAS int*)(lds + 51456);
    LAS int* AR = (LAS int*)(lds + 55552);
    LAS float* AW = (LAS float*)(lds + 59648);
    LAS float* STG = (LAS float*)(lds + 65536);
    const __amdgpu_buffer_rsrc_t rsX = __builtin_amdgcn_make_buffer_rsrc((void*)a.out, 0, T * D * 2, 0x00020000);
    const __amdgpu_buffer_rsrc_t rsXO = __builtin_amdgcn_make_buffer_rsrc(l == DEPTH - 1 ? (void*)(a.ws + B_XL) : (void*)a.out, 0, T * D * 2, 0x00020000);
    const __amdgpu_buffer_rsrc_t rsH = __builtin_amdgcn_make_buffer_rsrc((void*)(a.ws + B_H8), 0, T * D, 0x00020000);
    bf16x8 wh[4][4], wl[4][4];
#pragma unroll
    for (int kq = 0; kq < 4; ++kq)
#pragma unroll
        for (int n = 0; n < 4; ++n) { const size_t o = (size_t)(n * 16 + fr) * D + wid * 128 + kq * 32 + fq * 8;
            wh[kq][n] = *(const GAS bf16x8*)((const GAS bf16_t*)(ws + W_RH) + o); wl[kq][n] = *(const GAS bf16x8*)((const GAS bf16_t*)(ws + W_RL) + o); }
    for (int unit = F.vcu; unit < T / 128; unit += F.G) {
    const int r0 = unit * 128, b = r0 >> 12, slab = r0 / SLAB_T;
    int tq = tid; asm volatile("" : "+v"(tq));
    const GAS float* ada = (const GAS float*)(ws + WS_ADA) + ((size_t)l * 16 + b) * NIN;
    __syncthreads();
    for (int i = tq; i < D; i += 512) { VEC[i] = ((const GAS float*)a.in[19])[(size_t)l * D + i]; VEC[D + i] = ((const GAS float*)a.in[20])[(size_t)l * D + i]; VEC[2 * D + i] = 1.0f + ada[4 * D + i]; VEC[3 * D + i] = ada[3 * D + i]; }
    if (tq < 64) { RB[tq] = ((const GAS float*)a.in[22])[(size_t)l * 64 + tq]; LCNT[tq] = 0; }
    if (tq < 128) { const GAS f32x4* ps = (const GAS f32x4*)((const GAS float*)(ws + WS_PSTAT) + (size_t)(r0 + tq) * 32); float sm = 0.f, q = 0.f;
#pragma unroll
        for (int j = 0; j < 8; ++j) { const f32x4 p4 = ps[j]; sm += p4[0] + p4[2]; q += p4[1] + p4[3]; }
        const float mean = sm * (1.0f / D), var = fmaxf(q * (1.0f / D) - mean * mean, 0.f); ST[2 * tq] = mean; ST[2 * tq + 1] = rsqrtf(var + LN_EPS); }
    __syncthreads();
    {
        const int vo = ((r0 + fr) * D + wid * 128 + fq * 8) * 2, ho = (r0 + fr) * D + wid * 128 + fq * 8;
#define T6_LD(dst, st_) do { const int _s = (st_) < 32 ? (st_) : 31; dst = __builtin_amdgcn_raw_buffer_load_b128(rsX, vo, ((_s >> 2) * 16 * D + (_s & 3) * 32) * 2, 0); } while (0)
#define T6_STEP(st_, xr_) do { const int rt_ = (st_) >> 2, kq_ = (st_) & 3; const int c = wid * 128 + kq_ * 32 + fq * 8; \
        const float mean = ST[2 * (rt_ * 16 + fr)], rstd = ST[2 * (rt_ * 16 + fr) + 1]; \
        const f32x4 g0 = *(const LAS f32x4*)(VEC + c), g1 = *(const LAS f32x4*)(VEC + c + 4), b0 = *(const LAS f32x4*)(VEC + D + c), b1 = *(const LAS f32x4*)(VEC + D + c + 4); \
        const f32x4 s0 = *(const LAS f32x4*)(VEC + 2 * D + c), s1 = *(const LAS f32x4*)(VEC + 2 * D + c + 4), h0 = *(const LAS f32x4*)(VEC + 3 * D + c), h1 = *(const LAS f32x4*)(VEC + 3 * D + c + 4); \
        float xf_[8]; unpack8(xr_, xf_); const f32x4 xq0 = (f32x4){xf_[0], xf_[1], xf_[2], xf_[3]}, xq1 = (f32x4){xf_[4], xf_[5], xf_[6], xf_[7]}; \
        const f32x4 n0 = (xq0 - mean) * rstd * g0 + b0, n1 = (xq1 - mean) * rstd * g1 + b1; \
        { u32x4 xw; xw.x = cvt_pk_bf16(n0[0], n0[1]); xw.y = cvt_pk_bf16(n0[2], n0[3]); xw.z = cvt_pk_bf16(n1[0], n1[1]); xw.w = cvt_pk_bf16(n1[2], n1[3]); __builtin_amdgcn_raw_buffer_store_b128(xw, rsXO, vo, (rt_ * 16 * D + kq_ * 32) * 2, 0); } \
        const f32x4 f0 = n0 * s0 + h0, f1 = n1 * s1 + h1; \
        u32x4 hi; hi.x = cvt_pk_bf16(f0[0], f0[1]); hi.y = cvt_pk_bf16(f0[2], f0[3]); hi.z = cvt_pk_bf16(f1[0], f1[1]); hi.w = cvt_pk_bf16(f1[2], f1[3]); \
        { u32x2 h8; h8.x = pk4_fp8(f0[0] * SC_H, f0[1] * SC_H, f0[2] * SC_H, f0[3] * SC_H); h8.y = pk4_fp8(f1[0] * SC_H, f1[1] * SC_H, f1[2] * SC_H, f1[3] * SC_H); __builtin_amdgcn_raw_buffer_store_b64(h8, rsH, ho, rt_ * 16 * D + kq_ * 32, 0); } \
        u32x4 lo; lo.x = cvt_pk_bf16(f0[0] - bf_lo(hi.x), f0[1] - bf_hi(hi.x)); lo.y = cvt_pk_bf16(f0[2] - bf_lo(hi.y), f0[3] - bf_hi(hi.y)); \
        lo.z = cvt_pk_bf16(f1[0] - bf_lo(hi.z), f1[1] - bf_hi(hi.z)); lo.w = cvt_pk_bf16(f1[2] - bf_lo(hi.w), f1[3] - bf_hi(hi.w)); \
        const bf16x8 ah = __builtin_bit_cast(bf16x8, hi), al = __builtin_bit_cast(bf16x8, lo); \
        _Pragma("unroll") for (int n = 0; n < 4; ++n) { \
            acc[n] = __builtin_amdgcn_mfma_f32_16x16x32_bf16(wh[kq_][n], ah, acc[n], 0, 0, 0); \
            acc[n] = __builtin_amdgcn_mfma_f32_16x16x32_bf16(wl[kq_][n], ah, acc[n], 0, 0, 0); \
            acc[n] = __builtin_amdgcn_mfma_f32_16x16x32_bf16(wh[kq_][n], al, acc[n], 0, 0, 0); } } while (0)
        u32x4 xa, xb, xc, xd;
        for (int rt = 0; rt < 8; ++rt) {
            f32x4 acc[4];
#pragma unroll
            for (int n = 0; n < 4; ++n) acc[n] = (f32x4){0.f, 0.f, 0.f, 0.f};
            T6_LD(xa, rt * 4 + 0); T6_LD(xb, rt * 4 + 1); T6_LD(xc, rt * 4 + 2); T6_LD(xd, rt * 4 + 3);
            T6_STEP(rt * 4 + 0, xa); T6_STEP(rt * 4 + 1, xb); T6_STEP(rt * 4 + 2, xc); T6_STEP(rt * 4 + 3, xd);
            { LAS float* sg = STG + ((rt & 1) * 8 + wid) * (16 * 68) + fr * 68 + 4 * fq;
#pragma unroll
              for (int n = 0; n < 4; ++n) *(LAS f32x4*)(sg + 16 * n) = acc[n]; }
            __syncthreads();
#pragma unroll
            for (int p2 = 0; p2 < 2; ++p2) { const int o = tid + 512 * p2, r = o >> 6, e = o & 63; const LAS float* sp = STG + (rt & 1) * 8 * (16 * 68) + r * 68 + e; float sum = 0.f;
#pragma unroll
                for (int w = 0; w < 8; ++w) sum += sp[w * (16 * 68)];
                LG[(rt * 16 + r) * 65 + e] = sum; }
        }
#undef T6_LD
#undef T6_STEP
    }
    __syncthreads();
    {
        const int ti = lane >> 2, sub = lane & 3, tokl = wid * 16 + ti; const LAS float* lg = LG + tokl * 65 + 16 * sub;
        float bsv[16]; float g0a = -INFINITY, g0b = -INFINITY, g1a = -INFINITY, g1b = -INFINITY;
#pragma unroll
        for (int j = 0; j < 16; ++j) { const float v = fsigmoid(lg[j]) + RB[16 * sub + j]; bsv[j] = v;
            if (j < 8) { if (v > g0a) { g0b = g0a; g0a = v; } else if (v > g0b) g0b = v; } else { if (v > g1a) { g1b = g1a; g1a = v; } else if (v > g1b) g1b = v; } }
        const float gsa = g0a + g0b, gsb = g1a + g1b;
        float gs[8];
        gs[0] = dpp_f<0x00>(gsa); gs[1] = dpp_f<0x00>(gsb); gs[2] = dpp_f<0x55>(gsa); gs[3] = dpp_f<0x55>(gsb);
        gs[4] = dpp_f<0xAA>(gsa); gs[5] = dpp_f<0xAA>(gsb); gs[6] = dpp_f<0xFF>(gsa); gs[7] = dpp_f<0xFF>(gsb);
        unsigned keep = 0u;
#pragma unroll
        for (int it = 0; it < 4; ++it) { float best = -INFINITY; int bi = 0;
#pragma unroll
            for (int g = 0; g < 8; ++g) { const bool ok = !((keep >> g) & 1u) && (gs[g] > best); best = ok ? gs[g] : best; bi = ok ? g : bi; }
            keep |= 1u << bi; }
        unsigned avail = (((keep >> (2 * sub)) & 1u) ? 0x00ffu : 0u) | (((keep >> (2 * sub + 1)) & 1u) ? 0xff00u : 0u);
        float ssum = 0.f;
#pragma unroll 1
        for (int k = 0; k < 8; ++k) { float best = -INFINITY; int bi = 1 << 20;
#pragma unroll
            for (int j = 0; j < 16; ++j) { const bool ok = ((avail >> j) & 1u) && (bsv[j] > best); best = ok ? bsv[j] : best; bi = ok ? (16 * sub + j) : bi; }
            { const float ov = dpp_f<0xB1>(best); const int oi = dpp_i<0xB1>(bi); const bool tk = (ov > best) || (ov == best && oi < bi); best = tk ? ov : best; bi = tk ? oi : bi; }
            { const float ov = dpp_f<0x4E>(best); const int oi = dpp_i<0x4E>(bi); const bool tk = (ov > best) || (ov == best && oi < bi); best = tk ? ov : best; bi = tk ? oi : bi; }
            bi &= 63;
            if ((bi >> 4) == sub) avail &= ~(1u << (bi & 15));
            const float sc = fsigmoid(LG[tokl * 65 + bi]); ssum += sc;
            if (sub == 0) { AE[tokl * 8 + k] = bi; AW[tokl * 8 + k] = sc; } }
        LDS_WAIT(); asm volatile("" ::: "memory");
        const float inv = 2.5f / ssum;
#pragma unroll
        for (int kk2 = 0; kk2 < 2; ++kk2) { const int k = sub + 4 * kk2; const int e = AE[tokl * 8 + k]; AW[tokl * 8 + k] *= inv; AR[tokl * 8 + k] = __hip_atomic_fetch_add(LCNT + e, 1, __ATOMIC_RELAXED, __HIP_MEMORY_SCOPE_WORKGROUP); }
    }
    __syncthreads();
    if (tq < 64) { const int cl = LCNT[tq]; int base = 0;
        if (cl > 0) base = (int)__hip_atomic_fetch_add((GAS unsigned*)(ws + WS_CTL) + CW_CNT + (l * NSLAB + slab) * 64 + tq, (unsigned)cl, __ATOMIC_RELAXED, __HIP_MEMORY_SCOPE_AGENT);
        GBS[tq] = base; }
    __syncthreads();
#pragma unroll
    for (int p = 0; p < 2; ++p) { const int i = tq + 512 * p, tokl = i >> 3; const int e = AE[i], pos = GBS[e] + AR[i]; const int t = r0 + tokl;
        ((GAS unsigned*)(ws + WS_TOKE))[((size_t)slab * 64 + e) * ECAP + pos] = (unsigned)(t - slab * SLAB_T);
        ((GAS float*)(ws + WS_WTE))[((size_t)slab * 64 + e) * ECAP + pos] = AW[i];
        ((GAS unsigned*)(ws + WS_POS))[(size_t)t * 8 + (i & 7)] = ((unsigned)e << 16) | (unsigned)pos; }
    __syncthreads();
    }
}

__device__ __forceinline__ int moe_setup(const Frame& F, int l, int slab) {
    LAS int* TB = (LAS int*)(F.lds + L_TBASE); LAS int* CN = (LAS int*)(F.lds + L_CNT); LAS unsigned short* TM = (LAS unsigned short*)(F.lds + L_TMAP);
    __syncthreads();
    if (F.wave == 0) {
        const int e = F.lane; const int cnt = (int)__hip_atomic_load((GAS unsigned*)(F.ws + WS_CTL) + CW_CNT + (l * NSLAB + slab) * 64 + e, __ATOMIC_RELAXED, __HIP_MEMORY_SCOPE_AGENT);
        const int ntl = (cnt + 255) >> 8; int incl = ntl;
#pragma unroll
        for (int o = 1; o < 64; o <<= 1) { const int v = __shfl_up(incl, o); if (e >= o) incl += v; }
        const int excl = incl - ntl; TB[e] = excl; CN[e] = cnt;
        const int total = __shfl(incl, 63);
        if (e == 0) { TB[64] = total; TB[65] = total + SLAB_T / 256; CN[64] = SLAB_T; }
        for (int i = excl; i < incl; ++i) TM[i] = (unsigned short)e;
        for (int i = e; i < SLAB_T / 256; i += 64) TM[total + i] = (unsigned short)64;
    }
    __syncthreads();
    return TB[65];
}

__device__ __forceinline__ void combine_phase(const Frame& F, const Args& a, int l, int slab) {
    GAS unsigned char* ws = F.ws; const LAS int* TB = (const LAS int*)(F.lds + L_TBASE);
    const GAS unsigned char* Y = (const GAS unsigned char*)(ws + B_Y);
    const GAS bf16_t* XI = (l == DEPTH - 1) ? (const GAS bf16_t*)(ws + B_XL) : (const GAS bf16_t*)a.out;
    GAS unsigned char* H = (GAS unsigned char*)(ws + B_H8);
    constexpr int TPW = SLAB_T / 2048;
    const int gw = F.vcu * NWAVES + F.wave; const int tl0 = gw * TPW; if (tl0 >= SLAB_T) return;
    const int b = (slab * SLAB_T + tl0) >> 12; const int cl = 16 * F.lane;
    const GAS float* ada = (const GAS float*)(ws + WS_ADA) + ((size_t)l * 16 + b) * NIN;
    const GAS float* adan = (const GAS float*)(ws + WS_ADA) + ((size_t)(l < DEPTH - 1 ? l + 1 : l) * 16 + b) * NIN;
    f32x4 g2[4], gm[4], bt[4], sc[4], sh[4];
#pragma unroll
    for (int j = 0; j < 4; ++j) { const int c = cl + 4 * j; g2[j] = *(const GAS f32x4*)(ada + 5 * D + c) * (1.0f / SC_YO); gm[j] = *(const GAS f32x4*)(((const GAS float*)a.in[29]) + (size_t)l * D + c); bt[j] = *(const GAS f32x4*)(((const GAS float*)a.in[30]) + (size_t)l * D + c);
        sc[j] = (*(const GAS f32x4*)(adan + D + c) + 1.0f) * SC_H; sh[j] = *(const GAS f32x4*)(adan + c) * SC_H; }
    const int shbase = TB[64] * 256;
    for (int i = 0; i < TPW; ++i) { const int tl = tl0 + i; const size_t t = (size_t)slab * SLAB_T + tl;
        const GAS unsigned* pp = (const GAS unsigned*)(ws + WS_POS) + t * 8;
        u32x4 yv[9];
#pragma unroll
        for (int k = 0; k < 9; ++k) { size_t rowi;
            if (k < 8) { const unsigned pk = (unsigned)__builtin_amdgcn_readfirstlane((int)pp[k]); rowi = (size_t)TB[pk >> 16] * 256 + (pk & 0xffffu); } else rowi = (size_t)shbase + tl;
            yv[k] = *(const GAS u32x4*)(Y + rowi * D + cl); }
        const u32x4 xr0 = *(const GAS u32x4*)(XI + t * D + cl), xr1 = *(const GAS u32x4*)(XI + t * D + cl + 8);
        f32x4 acc[4];
#pragma unroll
        for (int j = 0; j < 4; ++j) acc[j] = (f32x4){0.f, 0.f, 0.f, 0.f};
#pragma unroll
        for (int k = 0; k < 9; ++k) { const unsigned w[4] = {yv[k].x, yv[k].y, yv[k].z, yv[k].w};
#pragma unroll
            for (int j = 0; j < 4; ++j) { const f32x2 lo = __builtin_amdgcn_cvt_pk_f32_fp8((int)w[j], false), hi = __builtin_amdgcn_cvt_pk_f32_fp8((int)w[j], true); acc[j] += (f32x4){lo.x, lo.y, hi.x, hi.y}; } }
        float xf[16]; { float t8[8]; unpack8(xr0, t8);
#pragma unroll
          for (int j = 0; j < 8; ++j) xf[j] = t8[j];
          unpack8(xr1, t8);
#pragma unroll
          for (int j = 0; j < 8; ++j) xf[8 + j] = t8[j]; }
        f32x4 pre[4]; float s = 0.f;
#pragma unroll
        for (int j = 0; j < 4; ++j) { const f32x4 xv = (f32x4){xf[4 * j], xf[4 * j + 1], xf[4 * j + 2], xf[4 * j + 3]}; pre[j] = xv * ALPHA + g2[j] * acc[j]; s += (pre[j][0] + pre[j][1]) + (pre[j][2] + pre[j][3]); }
        const float mean = wave_sum(s) * (1.0f / D); float q = 0.f;
#pragma unroll
        for (int j = 0; j < 4; ++j) { pre[j] = pre[j] - mean; q += (pre[j][0] * pre[j][0] + pre[j][1] * pre[j][1]) + (pre[j][2] * pre[j][2] + pre[j][3] * pre[j][3]); }
        const float rstd = rsqrtf(wave_sum(q) * (1.0f / D) + LN_EPS);
        f32x4 xn[4];
#pragma unroll
        for (int j = 0; j < 4; ++j) xn[j] = pre[j] * rstd * gm[j] + bt[j];
        if (l == DEPTH - 1) { GAS float* O = (GAS float*)a.out + t * D + cl;
#pragma unroll
            for (int j = 0; j < 4; ++j) *(GAS f32x4*)(O + 4 * j) = xn[j];
        } else { GAS bf16_t* O = (GAS bf16_t*)a.out + t * D + cl;
            u32x4 w0, w1; w0.x = cvt_pk_bf16(xn[0][0], xn[0][1]); w0.y = cvt_pk_bf16(xn[0][2], xn[0][3]); w0.z = cvt_pk_bf16(xn[1][0], xn[1][1]); w0.w = cvt_pk_bf16(xn[1][2], xn[1][3]);
            w1.x = cvt_pk_bf16(xn[2][0], xn[2][1]); w1.y = cvt_pk_bf16(xn[2][2], xn[2][3]); w1.z = cvt_pk_bf16(xn[3][0], xn[3][1]); w1.w = cvt_pk_bf16(xn[3][2], xn[3][3]);
            *(GAS u32x4*)O = w0; *(GAS u32x4*)(O + 8) = w1;
            u32x4 h8;
            { const f32x4 h0 = xn[0] * sc[0] + sh[0], h1 = xn[1] * sc[1] + sh[1], h2 = xn[2] * sc[2] + sh[2], h3 = xn[3] * sc[3] + sh[3];
              h8.x = pk4_fp8(h0[0], h0[1], h0[2], h0[3]); h8.y = pk4_fp8(h1[0], h1[1], h1[2], h1[3]); h8.z = pk4_fp8(h2[0], h2[1], h2[2], h2[3]); h8.w = pk4_fp8(h3[0], h3[1], h3[2], h3[3]); }
            *(GAS u32x4*)(H + t * D + cl) = h8; }
    }
}

template <class Tp> __device__ __forceinline__ Tp* launder(Tp* p) { asm volatile("" : "+s"(p)); return p; }
#define IN(p) (lo <= (p) && (p) < hi)
#ifndef PH_MASK
#define PH_MASK 0xffff
#endif
#define PHM(k) ((PH_MASK >> (k)) & 1)
#define RELAUNDER() do { ws = launder(ws); F.ws = ws; { int _t = F.tid; asm volatile("" : "+v"(_t)); F.tid = _t; F.lane = _t & 63; F.wave = __builtin_amdgcn_readfirstlane(_t >> 6); } asm volatile("" : "+s"(F.vcu), "+s"(F.G), "+s"(bx)); } while (0)
#define SEAM(p) do { if (IN(p) && IN((p) + 1)) xcd_barrier(bar); } while (0)
template <int l> __device__ __forceinline__ void layer_body(Frame& F, const Args& args, const XcdBarrier& bar, GAS unsigned char*& ws, const int lo, const int hi, int& bx) {
        const int pb = 2 + PPL * l;
        if (PHM(2) && IN(pb + 0)) {
            RELAUNDER();
            pg8::ProbPlainT<123> P{(const GAS char*)(ws + B_H8), (const GAS char*)(ws + W_IN), D}; pg8::SchedStatic S{T / 256, NIN / 256, F.G, bx};
            pg8::EpiZ E{(GAS unsigned char*)(ws + B_U)};
            pg8::gemm_phase<11>(F.lds, F.tid, P, S, E);
        }
        SEAM(pb + 0); STAMP(2);
        if (PHM(3) && IN(pb + 1)) {
            RELAUNDER();
            rg_phase(F, args, l);
        }
        SEAM(pb + 1); STAMP(3);
        if (PHM(4) && IN(pb + 2)) {
            RELAUNDER();
            sgu_phase(F, args, l);
            for (int u = F.vcu; u < 512; u += F.G) scanfix_unit(F, u);
        }
        SEAM(pb + 2); STAMP(4);
        if (PHM(5) && IN(pb + 3)) {
            RELAUNDER();
            pg8::ProbPair P{(const GAS char*)(ws + B_YA8), (const GAS char*)(ws + B_YB8), (const GAS char*)(ws + W_A), (const GAS char*)(ws + W_B), D};
            pg8::SchedPair S{T / 256, D / 256, F.G, bx};
            pg8::EpiPair E{(const GAS unsigned char*)(ws + B_GA), (const GAS unsigned char*)(ws + B_GB), (GAS unsigned char*)(ws + B_MG8)};
            pg8::gemm_phase(F.lds, F.tid, P, S, E);
        }
        SEAM(pb + 3); STAMP(5);
        if (PHM(6) && IN(pb + 4)) {
            RELAUNDER();
            pg8::ProbPlainT<122> P{(const GAS char*)(ws + B_MG8), (const GAS char*)(ws + W_O), D}; pg8::SchedStatic S{T / 256, D / 256, F.G, bx};
            if (l == 0) { pg8::EpiOutT<true> E{(const GAS void*)args.in[0], (GAS bf16_t*)args.out, (const GAS float*)(ws + WS_ADA) + (size_t)l * 16 * NIN, (GAS float*)(ws + WS_PSTAT)}; pg8::gemm_phase(F.lds, F.tid, P, S, E); }
            else { pg8::EpiOutT<false> E{(const GAS void*)args.out, (GAS bf16_t*)args.out, (const GAS float*)(ws + WS_ADA) + (size_t)l * 16 * NIN, (GAS float*)(ws + WS_PSTAT)}; pg8::gemm_phase(F.lds, F.tid, P, S, E); }
        }
        SEAM(pb + 4); STAMP(6);
        if (PHM(7) && IN(pb + 5)) { RELAUNDER(); ln1_route_phase(F, args, l); }
        SEAM(pb + 5); STAMP(7);
#pragma unroll
        for (int s = 0; s < NSLAB; ++s) {
            const int ps = pb + 6 + 3 * s;
            int ntiles = 0;
            RELAUNDER();
            if (IN(ps) || IN(ps + 1) || IN(ps + 2)) ntiles = moe_setup(F, l, s);
            GAS unsigned char* hid = (GAS unsigned char*)(ws + B_HID8); GAS unsigned char* yb = (GAS unsigned char*)(ws + B_Y);
            const LAS int* CN = (const LAS int*)(F.lds + L_CNT); const LAS int* TB = (const LAS int*)(F.lds + L_TBASE); const LAS unsigned short* TM = (const LAS unsigned short*)(F.lds + L_TMAP);
            if (PHM(8) && IN(ps)) {
                RELAUNDER();
                pg8::ProbMoe1 P{(const GAS char*)(ws + B_H8) + (size_t)s * SLAB_T * D, (const GAS char*)(ws + W_E13), (const GAS unsigned*)(ws + WS_TOKE) + (size_t)s * 64 * ECAP, CN, D};
                pg8::SchedMoe<2> S{ntiles, F.G, F.vcu, TM, TB};
                pg8::EpiMoe1 E{hid, (const GAS float*)(ws + WS_WTE) + (size_t)s * 64 * ECAP, CN};
                pg8::gemm_phase<13>(F.lds, F.tid, P, S, E);
            }
            SEAM(ps); STAMP(8);
            if (PHM(9) && IN(ps + 1)) {
                RELAUNDER();
                pg8::ProbMoe2 P{(const GAS char*)hid, (const GAS char*)(ws + W_E2), DE};
                pg8::SchedMoe<4> S{ntiles, F.G, F.vcu, TM, TB};
                pg8::EpiMoe2 E{yb};
                pg8::gemm_phase<15>(F.lds, F.tid, P, S, E);
            }
            SEAM(ps + 1); STAMP(9);
            if (PHM(10) && IN(ps + 2)) {
                RELAUNDER();
                combine_phase(F, args, l, s);
                if (s == NSLAB - 1 && l < DEPTH - 1) { __syncthreads(); convert_layer(F, args, l + 1); }
            }
            if (ps + 2 < NPH - 1) SEAM(ps + 2);
            STAMP(10);
        }
}
__global__ void __launch_bounds__(512, 2) mk_fwd(Args args) {
    extern __shared__ __attribute__((aligned(16))) unsigned char lds_raw[];
    Frame F;
    F.lds = (LAS unsigned char*)lds_raw; F.tid = threadIdx.x; F.lane = F.tid & 63; F.wave = __builtin_amdgcn_readfirstlane(F.tid >> 6);
    F.G = gridDim.x; { const int bx = blockIdx.x; F.vcu = (F.G % 8 == 0) ? (bx % 8) * (F.G / 8) + bx / 8 : bx; }
    F.ws = (GAS unsigned char*)args.ws;
    GAS unsigned char* ws = (GAS unsigned char*)args.ws;
    volatile LAS unsigned* MISC = (volatile LAS unsigned*)(F.lds + L_MISC);
    if (F.tid < 32) MISC[F.tid] = 0u;
    __syncthreads();
    XcdBarrier bar = xcd_barrier_post((GAS unsigned*)(ws + WS_CTL) + CW_BAR, MISC + 8);
    const int lo = args.ph_lo, hi = args.ph_hi;
    int bx = (int)blockIdx.x;
    if (PROBE_SET != 0 && blockIdx.x == 0 && threadIdx.x == 0) { volatile LAS unsigned long long* _m = (volatile LAS unsigned long long*)(F.lds + L_MISC + 64); _m[0] = __builtin_amdgcn_s_memrealtime(); _m[1] = 0ull; }

    if (PHM(0) && IN(0)) { RELAUNDER(); ada_phase(F, args); __syncthreads(); convert_layer(F, args, 0); }
    SEAM(0); STAMP(0);
    if (PHM(1) && IN(1)) { RELAUNDER(); modulate0(F, args); }
    SEAM(1); STAMP(1);

    layer_body<0>(F, args, bar, ws, lo, hi, bx); layer_body<1>(F, args, bar, ws, lo, hi, bx); layer_body<2>(F, args, bar, ws, lo, hi, bx); layer_body<3>(F, args, bar, ws, lo, hi, bx);
    if (PROBE_SET != 0 && blockIdx.x == 0 && threadIdx.x == 0) { volatile LAS unsigned long long* _m = (volatile LAS unsigned long long*)(F.lds + L_MISC + 64); const unsigned long long t0 = __builtin_amdgcn_s_memrealtime(), w = _m[1] * PROBE_MUL;
        while (__builtin_amdgcn_s_memrealtime() - t0 < w) __builtin_amdgcn_s_sleep(8); }
#undef IN
#undef SEAM
}

extern "C" void kernel_launch(void* const* d_in, const int* in_sizes, int n_in, void* d_out, int out_size, void* d_ws, size_t ws_size, hipStream_t stream) {
    static int grid = 0;
    if (grid == 0) {
        if (n_in != 31 || out_size != T * D || ws_size < WS_END) { fprintf(stderr, "kernel_launch: unexpected shapes (n_in %d, out %d, ws %zu < %zu)\n", n_in, out_size, ws_size, (size_t)WS_END); grid = -1; return; }
        int dev = 0, cus = 0, per_cu = 0;
        if (hipGetDevice(&dev) != hipSuccess || hipDeviceGetAttribute(&cus, hipDeviceAttributeMultiprocessorCount, dev) != hipSuccess) { grid = -1; return; }
        if (hipFuncSetAttribute((const void*)mk_fwd, hipFuncAttributeMaxDynamicSharedMemorySize, LDS_BYTES) != hipSuccess) { fprintf(stderr, "kernel_launch: hipFuncSetAttribute failed\n"); grid = -1; return; }
        if (hipOccupancyMaxActiveBlocksPerMultiprocessor(&per_cu, (const void*)mk_fwd, 512, LDS_BYTES) != hipSuccess || per_cu < 1) { fprintf(stderr, "kernel_launch: occupancy query says %d\n", per_cu); }
        (void)hipGetLastError();
        if (cus != 256) { fprintf(stderr, "kernel_launch: built for a 256-CU device (got %d CUs); nothing launched\n", cus); grid = -1; return; }
        grid = cus;
    }
    if (grid < 0) return;
    (void)in_sizes;
    hipMemsetAsync((char*)d_ws + WS_CTL, 0, CTL_BYTES, stream);
    Args a{};
    for (int i = 0; i < 31; ++i) a.in[i] = (const float*)d_in[i];
    a.out = (float*)d_out; a.ws = (unsigned char*)d_ws;
#if MK_MULTI
    for (int p = 0; p < NPH; ++p) { a.ph_lo = p; a.ph_hi = p + 1; hipLaunchKernelGGL(mk_fwd, dim3(grid), dim3(512), LDS_BYTES, stream, a); }
#else
    a.ph_lo = 0; a.ph_hi = NPH;
    hipLaunchKernelGGL(mk_fwd, dim3(grid), dim3(512), LDS_BYTES, stream, a);
#endif
}
```

```cpp
#include <hip/hip_runtime.h>
#include <cstdio>
#include <cstdint>

#ifndef MFMA_SCALED
#define MFMA_SCALED 0
#endif
#ifndef MK_MULTI
#define MK_MULTI 0
#endif

#define GAS __attribute__((address_space(1)))
#define LAS __attribute__((address_space(3)))
typedef unsigned short bf16_t;
typedef short bf16x8 __attribute__((ext_vector_type(8)));
typedef float f32x4 __attribute__((ext_vector_type(4)));
typedef float f32x2 __attribute__((ext_vector_type(2)));
typedef unsigned u32x4 __attribute__((ext_vector_type(4)));
typedef unsigned u32x2 __attribute__((ext_vector_type(2)));
typedef int i32x4 __attribute__((ext_vector_type(4)));
typedef int i32x8 __attribute__((ext_vector_type(8)));

constexpr int D = 1024, BATCH = 16, SEQ = 4096, T = BATCH * SEQ, DEPTH = 4;
constexpr int NIN = 6144, NE = 64, DE = 256;
constexpr int NSLAB = 1, SLAB_T = T / NSLAB;
constexpr int ECAP = SLAB_T;
constexpr float LN_EPS = 1e-5f;
constexpr float ALPHA = 1.6817928305074290f;
constexpr float LOG2E = 1.4426950408889634f;
constexpr int PPL = 6 + 3 * NSLAB, NPH = 2 + PPL * DEPTH;

constexpr size_t MiB = 1u << 20;
constexpr size_t WS_CTL = 0, CTL_BYTES = 1 * MiB;
constexpr size_t WS_ADA = 1 * MiB;
constexpr size_t WS_MISC = 3 * MiB;
constexpr size_t WS_VSTAT = 4 * MiB;
constexpr size_t WS_PSTAT = 5 * MiB;
constexpr size_t WS_CARRY = 13 * MiB;
constexpr size_t WS_POS = 17 * MiB;
constexpr size_t WS_TOKE = 19 * MiB;
constexpr size_t WS_WTE = 35 * MiB;
constexpr size_t WS_W = 51 * MiB;
constexpr size_t W_IN = WS_W;
constexpr size_t W_A = W_IN + 6 * MiB;
constexpr size_t W_B = W_A + 1 * MiB;
constexpr size_t W_O = W_B + 1 * MiB;
constexpr size_t W_E13 = W_O + 1 * MiB;
constexpr size_t W_E2 = W_E13 + 33 * MiB;
constexpr size_t W_RGA = W_E2 + 17 * MiB;
constexpr size_t W_RGX = W_RGA + 256 * 1024;
constexpr size_t W_SG = W_RGX + 256 * 1024;
constexpr size_t W_RH = W_SG + 256 * 1024;
constexpr size_t W_RL = W_RH + 128 * 1024;
constexpr size_t WS_BIG = 112 * MiB;
constexpr size_t BIGSZ = 128 * MiB;
constexpr size_t B_U = WS_BIG, B_V = WS_BIG + 1 * BIGSZ, B_RG = WS_BIG + 2 * BIGSZ, B_RI = WS_BIG + 3 * BIGSZ, B_GA = WS_BIG + 4 * BIGSZ, B_GB = WS_BIG + 5 * BIGSZ, B_HL = WS_BIG + 6 * BIGSZ, B_CA = WS_BIG + 7 * BIGSZ;
constexpr size_t B_H8 = WS_BIG + 8 * BIGSZ;
constexpr size_t B_YA8 = B_RI, B_YB8 = B_RI + 64 * MiB;
constexpr size_t B_MG8 = B_U;
constexpr size_t B_HID8 = B_HL, B_Y = B_U;
constexpr size_t B_XL = B_GB;
constexpr size_t WS_END = B_H8 + 64 * MiB;
static_assert(W_RL + 128 * 1024 <= WS_BIG, "weights region");
constexpr size_t HID_ROWS_MAX = (size_t)SLAB_T * 9 + 65 * 256;
static_assert(HID_ROWS_MAX * 256 <= 2 * BIGSZ && HID_ROWS_MAX * 1024 <= 5 * BIGSZ, "MoE overlay");
constexpr float DSC(float sa) { return MFMA_SCALED ? 1.0f : 1.0f / (sa * 64.f); }
constexpr float SC_W2 = 16.f;
constexpr float SC_W = 64.f, SC_H = 16.f, SC_Y = 8.f, SC_MG = 32.f, SC_HID = 8.f, SC_YO = 128.f, SC_Z = 16.f, SC_G = 256.f, SC_HL = 16.f, SC_CA = 256.f;

constexpr int CW_BAR = 4096;
constexpr int CW_CNT = 16384;

constexpr int SCR_BYTES = 147456;
constexpr int L_MISC = SCR_BYTES;
constexpr int L_TBASE = L_MISC + 128;
constexpr int L_CNT = L_TBASE + 384;
constexpr int L_TMAP = L_CNT + 512;
constexpr int LDS_BYTES = SCR_BYTES + 6144;
static_assert(L_TMAP + 5120 <= LDS_BYTES && (T * 9) / 256 + 65 <= 2560, "LDS map");

#define LDS_WAIT() asm volatile("s_waitcnt lgkmcnt(0)" ::: "memory")
#define VM_WAIT() asm volatile("s_waitcnt vmcnt(0)" ::: "memory")
__device__ __forceinline__ unsigned cvt_pk_bf16(float lo, float hi) { unsigned r; asm("v_cvt_pk_bf16_f32 %0, %1, %2" : "=v"(r) : "v"(lo), "v"(hi)); return r; }
__device__ __forceinline__ unsigned pk4_fp8(float a, float b, float c, float d) {
    a = __builtin_amdgcn_fmed3f(a, -448.f, 448.f); b = __builtin_amdgcn_fmed3f(b, -448.f, 448.f); c = __builtin_amdgcn_fmed3f(c, -448.f, 448.f); d = __builtin_amdgcn_fmed3f(d, -448.f, 448.f);
    int w = __builtin_amdgcn_cvt_pk_fp8_f32(a, b, 0, false); w = __builtin_amdgcn_cvt_pk_fp8_f32(c, d, w, true); return (unsigned)w; }
__device__ __forceinline__ unsigned pk4_fp8_nc(float a, float b, float c, float d) {
    int w = __builtin_amdgcn_cvt_pk_fp8_f32(a, b, 0, false); w = __builtin_amdgcn_cvt_pk_fp8_f32(c, d, w, true); return (unsigned)w; }
__device__ __forceinline__ void unpack4_fp8(unsigned w, float (&f)[4]) { const f32x2 lo = __builtin_amdgcn_cvt_pk_f32_fp8((int)w, false), hi = __builtin_amdgcn_cvt_pk_f32_fp8((int)w, true); f[0] = lo.x; f[1] = lo.y; f[2] = hi.x; f[3] = hi.y; }
__device__ __forceinline__ void unpack8_fp8(const u32x2 w, float (&f)[8]) { float a[4], b[4]; unpack4_fp8(w.x, a); unpack4_fp8(w.y, b);
#pragma unroll
    for (int j = 0; j < 4; ++j) { f[j] = a[j]; f[4 + j] = b[j]; } }
__device__ __forceinline__ void unpack16_fp8(const u32x4 w, float (&f)[16]) { float a[8], b[8]; unpack8_fp8((u32x2){w.x, w.y}, a); unpack8_fp8((u32x2){w.z, w.w}, b);
#pragma unroll
    for (int j = 0; j < 8; ++j) { f[j] = a[j]; f[8 + j] = b[j]; } }
__device__ __forceinline__ float bf_lo(unsigned w) { return __uint_as_float(w << 16); }
__device__ __forceinline__ float bf_hi(unsigned w) { return __uint_as_float(w & 0xffff0000u); }
__device__ __forceinline__ float fsigmoid(float x) { return __builtin_amdgcn_rcpf(1.0f + __builtin_amdgcn_exp2f(-LOG2E * x)); }
template <int CTRL> __device__ __forceinline__ float dpp_add(float v) { return v + __int_as_float(__builtin_amdgcn_update_dpp(0, __float_as_int(v), CTRL, 0xf, 0xf, true)); }
template <int CTRL> __device__ __forceinline__ int dpp_i(int v) { return __builtin_amdgcn_update_dpp(0, v, CTRL, 0xf, 0xf, true); }
template <int CTRL> __device__ __forceinline__ float dpp_f(float v) { return __int_as_float(dpp_i<CTRL>(__float_as_int(v))); }
__device__ __forceinline__ float rlane(float v, int l) { return __int_as_float(__builtin_amdgcn_readlane(__float_as_int(v), l)); }
__device__ __forceinline__ float wave_sum(float v) {
    v = dpp_add<0xB1>(v); v = dpp_add<0x4E>(v); v = dpp_add<0x141>(v); v = dpp_add<0x140>(v);
    return (rlane(v, 0) + rlane(v, 16)) + (rlane(v, 32) + rlane(v, 48));
}
__device__ __forceinline__ f32x2 gelu_pk(f32x2 v) {
    const f32x2 av = __builtin_elementwise_min(__builtin_elementwise_abs(v), (f32x2){4.5f, 4.5f});
    const f32x2 t = av * 0.4444444444f + (-1.0f);
    f32x2 q = t * 3.951919514e-02f + (-1.927818768e-02f);
    q = q * t + (-1.653166270e-01f); q = q * t + 1.674144965e-01f; q = q * t + 1.899891083e-01f; q = q * t + (-4.229837828e-01f);
    q = q * t + 2.122498017e-01f; q = q * t + 1.402255593e-01f; q = q * t + (-2.492420617e-01f); q = q * t + 1.346304704e-01f; q = q * t + (-2.719805609e-02f);
    return __builtin_elementwise_max(v, (f32x2){0.f, 0.f}) + q;
}
__device__ __forceinline__ f32x2 gelu16_pk(f32x2 v) {
    constexpr float KT = DSC(SC_H) / 4.5f, KM = SC_Z * DSC(SC_H); static_assert(SC_Z == 16.f, "polynomial carries the x16");
    float s0, s1;
    asm("v_mul_f32_e64 %0, |%1|, %2 clamp" : "=v"(s0) : "v"(v.x), "s"(KT));
    asm("v_mul_f32_e64 %0, |%1|, %2 clamp" : "=v"(s1) : "v"(v.y), "s"(KT));
    const f32x2 t = (f32x2){s0, s1};
    f32x2 q = t * (-2.724598309e+02f) + 1.343870688e+03f;
    q = q * t + (-2.690302968e+03f); q = q * t + 2.722895127e+03f; q = q * t + (-1.343784371e+03f); q = q * t + 1.599681120e+02f;
    q = q * t + 1.153520608e+02f; q = q * t + (-3.553613442e+01f); q = q * t + (-2.555093946e-03f);
    return __builtin_elementwise_max(v, (f32x2){0.f, 0.f}) * KM + q;
}
__device__ __forceinline__ void unpack8(const u32x4 v, float (&f)[8]) { f[0] = bf_lo(v.x); f[1] = bf_hi(v.x); f[2] = bf_lo(v.y); f[3] = bf_hi(v.y); f[4] = bf_lo(v.z); f[5] = bf_hi(v.z); f[6] = bf_lo(v.w); f[7] = bf_hi(v.w); }
__device__ __forceinline__ u32x4 pack8(const float (&f)[8]) { u32x4 o; o.x = cvt_pk_bf16(f[0], f[1]); o.y = cvt_pk_bf16(f[2], f[3]); o.z = cvt_pk_bf16(f[4], f[5]); o.w = cvt_pk_bf16(f[6], f[7]); return o; }
__device__ __forceinline__ float gelu1(float x) { f32x2 r = gelu_pk((f32x2){x, x}); return r.x; }

#define XB_TMO      128
#define XB_XCNT(j)  (256  + 64 * (j))
#define XB_XSUB(j)  (1280 + 64 * (j))
#define XB_XGEN(j)  (2304 + 64 * (j))
#define XB_TOP      3328
#define XB_TOPGEN   3392
#define XCD_BAR_WORDS 3456
#define XB_SPIN_CAP (1u << 20)
__device__ __forceinline__ unsigned xb_ld(GAS unsigned* p)              { return __hip_atomic_load(p, __ATOMIC_RELAXED, __HIP_MEMORY_SCOPE_AGENT); }
__device__ __forceinline__ unsigned xb_add(GAS unsigned* p, unsigned v) { return __hip_atomic_fetch_add(p, v, __ATOMIC_RELAXED, __HIP_MEMORY_SCOPE_AGENT); }
__device__ __forceinline__ unsigned xb_xcc_id() { return (unsigned)__builtin_amdgcn_s_getreg((3 << 11) | 20) & 0xFu; }
#define XB_SPIN(cond, bar) do { unsigned _sp = 0; while (cond) { __builtin_amdgcn_s_sleep(1); \
    if ((++_sp & 255u) == 0u) { if (xb_ld(&(bar)[XB_TMO])) break; if (_sp > XB_SPIN_CAP) { (void)xb_add(&(bar)[XB_TMO], 1u); break; } } } } while (0)
struct XcdBarrier { GAS unsigned* bar; unsigned x; volatile LAS unsigned* st; };
__device__ __forceinline__ XcdBarrier xcd_barrier_post(GAS unsigned* bar, volatile LAS unsigned* st) {
    XcdBarrier b; b.bar = bar; b.x = xb_xcc_id(); b.st = st;
    if (threadIdx.x == 0) (void)xb_add(&bar[XB_XCNT(b.x)], 1u);
    return b;
}
__device__ __forceinline__ void xcd_barrier_complete(GAS unsigned* bar, unsigned x, unsigned& nloc, unsigned& nx) {
    const unsigned G = gridDim.x * gridDim.y * gridDim.z;
    unsigned sum, cnt, mine, sp = 0u;
    for (;;) {
        sum = 0u; cnt = 0u; mine = 0u;
#pragma unroll
        for (unsigned j = 0; j < 16; ++j) { const unsigned c = xb_ld(&bar[XB_XCNT(j)]); sum += c; cnt += (c > 0u) ? 1u : 0u; mine = (j == x) ? c : mine; }
        if (sum == G) break;
        __builtin_amdgcn_s_sleep(1);
        if ((++sp & 255u) == 0u) { if (xb_ld(&bar[XB_TMO])) break; if (sp > XB_SPIN_CAP) { (void)xb_add(&bar[XB_TMO], 1u); break; } }
    }
    nloc = mine > 0u ? mine : 1u; nx = cnt > 0u ? cnt : 1u;
}
__device__ __forceinline__ void xcd_barrier(const XcdBarrier& b) {
    asm volatile("s_waitcnt vmcnt(0)" ::: "memory");
    __syncthreads();
    if (threadIdx.x == 0) {
        GAS unsigned* bar = b.bar; unsigned bx_ = b.x; asm volatile("" : "+s"(bar), "+s"(bx_));
        __builtin_amdgcn_s_waitcnt(0);
        unsigned nloc = b.st[0], nx = b.st[1];
        if (nloc == 0u) { xcd_barrier_complete(bar, bx_, nloc, nx); b.st[0] = nloc; b.st[1] = nx; }
        const unsigned old = xb_add(&bar[XB_XSUB(bx_)], 1u);
        const unsigned gen = old / nloc;
        if (old + 1u == (gen + 1u) * nloc) {
            __builtin_amdgcn_fence(__ATOMIC_RELEASE, "agent");
            asm volatile("s_waitcnt vmcnt(0)" ::: "memory");
            const unsigned og = xb_add(&bar[XB_TOP], 1u);
            const unsigned tg = og / nx;
            if (og + 1u == (tg + 1u) * nx) xb_add(&bar[XB_TOPGEN], 1u);
            else XB_SPIN(xb_ld(&bar[XB_TOPGEN]) == tg, bar);
            __builtin_amdgcn_fence(__ATOMIC_ACQUIRE, "agent");
            xb_add(&bar[XB_XGEN(bx_)], 1u);
            asm volatile("s_waitcnt vmcnt(0)" ::: "memory");
        } else {
            XB_SPIN(xb_ld(&bar[XB_XGEN(bx_)]) == gen, bar);
            __builtin_amdgcn_fence(__ATOMIC_ACQUIRE, "agent");
            asm volatile("s_waitcnt vmcnt(0)" ::: "memory");
        }
    }
    __syncthreads();
}

#ifndef PROBE_SET
#define PROBE_SET 0
#endif
#ifndef PROBE_MUL
#define PROBE_MUL 1
#endif
#define STAMP(ty) do { if (PROBE_SET != 0 && blockIdx.x == 0 && threadIdx.x == 0) { volatile LAS unsigned long long* _m = (volatile LAS unsigned long long*)(F.lds + L_MISC + 64); \
        const unsigned long long _n = __builtin_amdgcn_s_memrealtime(); if ((PROBE_SET >> (ty)) & 1) _m[1] += _n - _m[0]; _m[0] = _n; } } while (0)
struct Args { const float* in[31]; float* out; unsigned char* ws; int ph_lo, ph_hi; };
#define GSTAMP(ldsp, ty) do { if (PROBE_SET != 0 && (ty) >= 0 && blockIdx.x == 0 && threadIdx.x == 0) { volatile LAS unsigned long long* _m = (volatile LAS unsigned long long*)((ldsp) + L_MISC + 64); \
        const unsigned long long _n = __builtin_amdgcn_s_memrealtime(); if ((PROBE_SET >> ((ty) & 31)) & 1) _m[1] += _n - _m[0]; _m[0] = _n; } } while (0)
namespace pg8 {
constexpr int BM = 256, BK = 64, HALF = 128, HTB = HALF * BK * 2, STAGE_BYTES = 8 * HTB, NXCD = 8, WGM = 8;
__device__ __forceinline__ int lds_byte(int r, int c) { const int st = (r >> 4) * 2 + (c >> 5), rr = r & 15, cc = c & 31, ob = rr * 64 + cc * 2; return st * 1024 + (ob ^ (((ob >> 9) & 1) << 5)); }
__device__ __forceinline__ void stage_rc(int b, int& R, int& C) { const int st = b / 1024, sb = b % 1024, swz = sb ^ (((sb >> 9) & 1) << 5); R = (st >> 1) * 16 + swz / 64; C = (st & 1) * 32 + (swz % 64) / 2; }
__device__ __forceinline__ int perm32(int rho) { const int n = rho >> 4, i = rho & 15; return 8 * (i >> 2) + 4 * n + (i & 3); }

struct Unit { int pm, pn, aux, j; };

__device__ __forceinline__ void tile_of(int wgid, int nM, int nN, int& pm, int& pn) {
    const int nwg = nM * nN; { const int q = nwg / NXCD, r = nwg % NXCD, xcd = wgid % NXCD, off = wgid / NXCD; wgid = (xcd < r ? xcd * (q + 1) : r * (q + 1) + (xcd - r) * q) + off; }
    const int nig = WGM * nN, gid = wgid / nig, fm = gid * WGM, gsz = (nM - fm) < WGM ? (nM - fm) : WGM;
    pm = fm + ((wgid % nig) % gsz); pn = (wgid % nig) / gsz;
}
struct SchedStatic {
    int nM, nN, G, c;
    __device__ __forceinline__ bool next(int i, Unit& u) const { const long L = (long)i * G + c; if (L >= (long)nM * nN) return false; tile_of((int)L, nM, nN, u.pm, u.pn); u.aux = 0; u.j = 0; return true; }
};
struct SchedPair {
    int nM, nN, G, c;
    __device__ __forceinline__ bool next(int i, Unit& u) const { const long L = (long)(i >> 1) * G + c; if (L >= (long)nM * nN) return false; tile_of((int)L, nM, nN, u.pm, u.pn); u.aux = i & 1; u.j = 0; return true; }
};
template <int NCT> struct SchedMoe {
    int ntiles, G, c; const LAS unsigned short* tmap; const LAS int* tbase;
    __device__ __forceinline__ bool next(int i, Unit& u) const {
        const long L = (long)i * G + c; const int tile = (int)(L / NCT); if (tile >= ntiles) return false;
        u.pm = tile; u.pn = (int)(L % NCT); u.aux = __builtin_amdgcn_readfirstlane((int)tmap[tile]); u.j = tile - __builtin_amdgcn_readfirstlane(tbase[u.aux]); return true;
    }
};

#define E8M0x4(e) ((int)(((unsigned)(e)) * 0x01010101u))
template <int EA> struct ProbPlainT {
    static constexpr bool GATHER = false; static constexpr int SCA = E8M0x4(EA), SCB = E8M0x4(121);
    const GAS char* A; const GAS char* Bt; int K;
    __device__ __forceinline__ const GAS char* a_base(const Unit& u) const { return A + (size_t)u.pm * 256 * K; }
    __device__ __forceinline__ const GAS char* b_base(const Unit& u) const { return Bt + (size_t)u.pn * 256 * K; }
    __device__ __forceinline__ void gather(const Unit&, const int (&)[2], const int (&)[2], unsigned (&)[2][2]) const {}
};
struct ProbPair {
    static constexpr bool GATHER = false; static constexpr int SCA = E8M0x4(124), SCB = E8M0x4(121);
    const GAS char* A0; const GAS char* A1; const GAS char* B0; const GAS char* B1; int K;
    __device__ __forceinline__ const GAS char* a_base(const Unit& u) const { return (u.aux ? A1 : A0) + (size_t)u.pm * 256 * K; }
    __device__ __forceinline__ const GAS char* b_base(const Unit& u) const { return (u.aux ? B1 : B0) + (size_t)u.pn * 256 * K; }
    __device__ __forceinline__ void gather(const Unit&, const int (&)[2], const int (&)[2], unsigned (&)[2][2]) const {}
};
struct ProbMoe1 {
    static constexpr bool GATHER = true; static constexpr int SCA = E8M0x4(123), SCB = E8M0x4(121);
    const GAS char* A; const GAS char* W; const GAS unsigned* tok; const LAS int* cnt; int K;
    __device__ __forceinline__ const GAS char* a_base(const Unit&) const { return A; }
    __device__ __forceinline__ const GAS char* b_base(const Unit& u) const { return W + (size_t)u.aux * (512 * 1024) + (size_t)u.pn * 256 * 1024; }
    __device__ __forceinline__ void gather(const Unit& u, const int (&R)[2], const int (&C2)[2], unsigned (&vo)[2][2]) const {
        const int c = cnt[u.aux];
#pragma unroll
        for (int h = 0; h < 2; ++h)
#pragma unroll
            for (int i = 0; i < 2; ++i) { const int p = u.j * 256 + h * 128 + R[i]; unsigned tk = 0u;
                if (p < c) tk = (u.aux == 64) ? (unsigned)p : __builtin_nontemporal_load(tok + (size_t)u.aux * ECAP + p);
                vo[h][i] = tk * 1024u + (unsigned)C2[i]; }
    }
};
struct ProbMoe2 {
    static constexpr bool GATHER = false; static constexpr int SCA = E8M0x4(124), SCB = E8M0x4(121);
    const GAS char* A; const GAS char* W; int K;
    __device__ __forceinline__ const GAS char* a_base(const Unit& u) const { return A + (size_t)u.pm * 256 * 256; }
    __device__ __forceinline__ const GAS char* b_base(const Unit& u) const { return W + (size_t)u.aux * (1024 * 256) + (size_t)u.pn * 256 * 256; }
    __device__ __forceinline__ void gather(const Unit&, const int (&)[2], const int (&)[2], unsigned (&)[2][2]) const {}
};

typedef f32x4 Acc[2][2][4][2];

struct EpiZ {
    static constexpr int PERM = 2; static constexpr bool NOKEEP = true;
    GAS unsigned char* out0;
    __device__ __forceinline__ bool keep(const Unit&) const { return false; }
    template <int ACT> __device__ __forceinline__ void run(const Acc& acc, GAS unsigned char* base, int row0, int col0) const {
#pragma unroll
        for (int ai = 0; ai < 2; ++ai)
#pragma unroll
            for (int m = 0; m < 4; ++m) { const size_t eo = (size_t)(row0 + ai * HALF + m * 16) * D + col0; u32x4 w; unsigned wq[4];
#pragma unroll
                for (int q = 0; q < 4; ++q) { f32x4 v = acc[ai][q >> 1][m][q & 1];
                    if (ACT == 0) v = v * (SC_Z * DSC(SC_H));
                    if (ACT == 1) { const f32x2 a = gelu16_pk((f32x2){v[0], v[1]}), c = gelu16_pk((f32x2){v[2], v[3]}); v = (f32x4){a.x, a.y, c.x, c.y}; }
                    if (ACT == 2) { static_assert(SC_G == 256.f, "SC_G * sigmoid(x) = 1 / (2^-8 + 2^(-x log2 e - 8))");
                        const f32x4 ex = v * (-LOG2E * DSC(SC_H)) + (-8.0f);
#pragma unroll
                        for (int j = 0; j < 4; ++j) v[j] = __builtin_amdgcn_rcpf(__builtin_amdgcn_exp2f(ex[j]) + 0.00390625f); }
                    wq[q] = (ACT == 2) ? pk4_fp8_nc(v[0], v[1], v[2], v[3]) : pk4_fp8(v[0], v[1], v[2], v[3]); }
                w.x = wq[0]; w.y = wq[1]; w.z = wq[2]; w.w = wq[3];
                __builtin_nontemporal_store(w, (GAS u32x4*)(base + eo)); }
    }
    struct Pre {}; __device__ __forceinline__ void prefetch(Pre&, const Unit&, int, int, int, int) const {}
    __device__ __forceinline__ void operator()(Acc& acc, const Unit& u, int wr, int wc, int fr, int fq, const Pre& pre) const {
        const int part = u.pn >> 2; GAS unsigned char* base = out0 + (size_t)part * BIGSZ;
        const int row0 = u.pm * BM + wr * 64 + fr, col0 = (u.pn & 3) * BM + wc * 64 + 16 * fq;
        if (part < 3) run<1>(acc, base, row0, col0); else if (part == 3) run<0>(acc, base, row0, col0); else run<2>(acc, base, row0, col0);
    }
};
struct EpiPair {
    static constexpr int PERM = 2; static constexpr bool NOKEEP = false;
    const GAS unsigned char* GA; const GAS unsigned char* GB; GAS unsigned char* MG;
    __device__ __forceinline__ bool keep(const Unit& u) const { return u.aux == 0; }
    struct Pre { u32x4 gb[2], ga[2]; };
    __device__ __forceinline__ void ldg(u32x4 (&gb)[2], u32x4 (&ga)[2], const Unit& u, int row0, int col0, int h) const {
#pragma unroll
        for (int mm = 0; mm < 2; ++mm) { const size_t off = (size_t)(row0 + (h >> 1) * HALF + ((h & 1) * 2 + mm) * 16) * D + col0; gb[mm] = *(const GAS u32x4*)(GB + off); ga[mm] = gb[mm]; if (u.aux == 0) ga[mm] = *(const GAS u32x4*)(GA + off); }
    }
    __device__ __forceinline__ void prefetch(Pre& pre, const Unit& u, int wr, int wc, int fr, int fq) const { ldg(pre.gb, pre.ga, u, u.pm * BM + wr * 64 + fr, u.pn * BM + wc * 64 + 16 * fq, 0); }
    __device__ __forceinline__ void operator()(Acc& acc, const Unit& u, int wr, int wc, int fr, int fq, const Pre& pre) const {
        const int row0 = u.pm * BM + wr * 64 + fr, col0 = u.pn * BM + wc * 64 + 16 * fq;
        u32x4 gb[2][2], ga[2][2];
#pragma unroll
        for (int mm = 0; mm < 2; ++mm) { gb[0][mm] = pre.gb[mm]; ga[0][mm] = pre.ga[mm]; }
#pragma unroll
        for (int h = 0; h < 4; ++h) { const int ai = h >> 1;
            if (h < 3) ldg(gb[(h + 1) & 1], ga[(h + 1) & 1], u, row0, col0, h + 1);
            asm volatile("" ::: "memory");
#pragma unroll
            for (int mm = 0; mm < 2; ++mm) { const int m = (h & 1) * 2 + mm; const size_t off = (size_t)(row0 + ai * HALF + m * 16) * D + col0;
                float sb[16]; unpack16_fp8(gb[h & 1][mm], sb);
#pragma unroll
                for (int j = 0; j < 16; ++j) sb[j] = fmaxf(sb[j], 1e-9f);
                if (u.aux == 0) { float sa[16]; unpack16_fp8(ga[h & 1][mm], sa);
#pragma unroll
                    for (int q = 0; q < 4; ++q)
#pragma unroll
                        for (int j = 0; j < 4; ++j) acc[ai][q >> 1][m][q & 1][j] *= sa[4 * q + j] * __builtin_amdgcn_rcpf(sb[4 * q + j]);
                } else { u32x4 w; unsigned wq[4];
#pragma unroll
                    for (int q = 0; q < 4; ++q) { f32x4 v = acc[ai][q >> 1][m][q & 1];
#pragma unroll
                        for (int j = 0; j < 4; ++j) v[j] *= sb[4 * q + j] * (SC_MG / SC_G * DSC(SC_Y));
                        wq[q] = pk4_fp8(v[0], v[1], v[2], v[3]); }
                    w.x = wq[0]; w.y = wq[1]; w.z = wq[2]; w.w = wq[3];
                    *(GAS u32x4*)(MG + off) = w; } }
            asm volatile("" ::: "memory"); }
    }
};
template <bool XF32> struct EpiOutT {
    static constexpr int PERM = 2; static constexpr bool NOKEEP = true;
    const GAS void* xsrc; GAS bf16_t* xdst; const GAS float* ada_l; GAS float* pstat;
    __device__ __forceinline__ bool keep(const Unit&) const { return false; }
    struct Pre { f32x4 g[4]; u32x4 x[2][2]; };
    __device__ __forceinline__ void prefetch(Pre& pre, const Unit& u, int wr, int wc, int fr, int fq) const {
        const int row0 = u.pm * BM + wr * 64 + fr, col0 = u.pn * BM + wc * 64 + 16 * fq; const int b = u.pm >> 4;
        const GAS float* gate = ada_l + (size_t)b * NIN + 2 * D + col0;
#pragma unroll
        for (int q = 0; q < 4; ++q) pre.g[q] = *(const GAS f32x4*)(gate + 4 * q);
#pragma unroll
        for (int mm = 0; mm < 2; ++mm) { pre.x[mm][0] = (u32x4){0u, 0u, 0u, 0u}; pre.x[mm][1] = pre.x[mm][0];
            if (!XF32) { const size_t off = (size_t)(row0 + mm * 16) * D + col0; pre.x[mm][0] = *(const GAS u32x4*)((const GAS bf16_t*)xsrc + off); pre.x[mm][1] = *(const GAS u32x4*)((const GAS bf16_t*)xsrc + off + 8); } }
    }
    __device__ __forceinline__ void operator()(Acc& acc, const Unit& u, int wr, int wc, int fr, int fq, const Pre& pre) const {
        const int row0 = u.pm * BM + wr * 64 + fr, col0 = u.pn * BM + wc * 64 + 16 * fq; const int b = u.pm >> 4;
        f32x4 g[4];
#pragma unroll
        for (int q = 0; q < 4; ++q) g[q] = pre.g[q] * DSC(SC_MG);
        u32x4 xr[2][2][2];
#pragma unroll
        for (int mm = 0; mm < 2; ++mm) { xr[0][mm][0] = pre.x[mm][0]; xr[0][mm][1] = pre.x[mm][1]; }
#pragma unroll
        for (int bt = 0; bt < 4; ++bt) { const int ai = bt >> 1, m0 = (bt & 1) * 2;
            f32x4 xv[2][4];
            if (XF32) {
#pragma unroll
                for (int mm = 0; mm < 2; ++mm) { const size_t off = (size_t)(row0 + ai * HALF + (m0 + mm) * 16) * D + col0;
#pragma unroll
                    for (int q = 0; q < 4; ++q) xv[mm][q] = *(const GAS f32x4*)((const GAS float*)xsrc + off + 4 * q); }
            } else {
                if (bt < 3) { const int ain = (bt + 1) >> 1, m0n = ((bt + 1) & 1) * 2;
#pragma unroll
                    for (int mm = 0; mm < 2; ++mm) { const size_t off = (size_t)(row0 + ain * HALF + (m0n + mm) * 16) * D + col0;
                        xr[(bt + 1) & 1][mm][0] = *(const GAS u32x4*)((const GAS bf16_t*)xsrc + off); xr[(bt + 1) & 1][mm][1] = *(const GAS u32x4*)((const GAS bf16_t*)xsrc + off + 8); } }
#pragma unroll
                for (int mm = 0; mm < 2; ++mm) { float f[8]; unpack8(xr[bt & 1][mm][0], f); xv[mm][0] = (f32x4){f[0], f[1], f[2], f[3]}; xv[mm][1] = (f32x4){f[4], f[5], f[6], f[7]};
                    unpack8(xr[bt & 1][mm][1], f); xv[mm][2] = (f32x4){f[0], f[1], f[2], f[3]}; xv[mm][3] = (f32x4){f[4], f[5], f[6], f[7]}; }
            }
#pragma unroll
            for (int mm = 0; mm < 2; ++mm) { const int m = m0 + mm; const int row = row0 + ai * HALF + m * 16; const size_t off = (size_t)row * D + col0; float s = 0.f, q2 = 0.f;
                u32x4 w0, w1; unsigned wq[8];
#pragma unroll
                for (int q = 0; q < 4; ++q) { const f32x4 v = xv[mm][q] * ALPHA + g[q] * acc[ai][q >> 1][m][q & 1]; wq[2 * q] = cvt_pk_bf16(v[0], v[1]); wq[2 * q + 1] = cvt_pk_bf16(v[2], v[3]); }
                w0.x = wq[0]; w0.y = wq[1]; w0.z = wq[2]; w0.w = wq[3]; w1.x = wq[4]; w1.y = wq[5]; w1.z = wq[6]; w1.w = wq[7];
                *(GAS u32x4*)(xdst + off) = w0; *(GAS u32x4*)(xdst + off + 8) = w1;
                { float r[8]; unpack8(w0, r);
#pragma unroll
                  for (int j = 0; j < 8; ++j) { s += r[j]; q2 += r[j] * r[j]; }
                  unpack8(w1, r);
#pragma unroll
                  for (int j = 0; j < 8; ++j) { s += r[j]; q2 += r[j] * r[j]; } }
                s += __shfl_xor(s, 16); s += __shfl_xor(s, 32); q2 += __shfl_xor(q2, 16); q2 += __shfl_xor(q2, 32);
                if (fq == 0) *(GAS f32x2*)(pstat + ((size_t)row * 16 + u.pn * 4 + wc) * 2) = (f32x2){s, q2}; }
            if (XF32) asm volatile("" ::: "memory"); }
    }
};
struct EpiMoe1 {
    static constexpr int PERM = 2; static constexpr bool NOKEEP = true;
    GAS unsigned char* hid; const GAS float* wts; const LAS int* cnt;
    __device__ __forceinline__ bool keep(const Unit&) const { return false; }
    struct Pre { float wrow[2][4]; };
    __device__ __forceinline__ void prefetch(Pre& pre, const Unit& u, int wr, int wc, int fr, int fq) const {
        const int e = u.aux, c = cnt[e];
#pragma unroll
        for (int ai = 0; ai < 2; ++ai)
#pragma unroll
            for (int m = 0; m < 4; ++m) { const int p = u.j * 256 + ai * HALF + wr * 64 + m * 16 + fr; float w = 0.f; if (p < c) w = (e == 64) ? 1.0f : wts[(size_t)e * ECAP + p]; pre.wrow[ai][m] = w; }
    }
    __device__ __forceinline__ void operator()(Acc& acc, const Unit& u, int wr, int wc, int fr, int fq, const Pre& pre) const {
        const int e = u.aux, c = cnt[e]; const int hc0 = u.pn * 128 + wc * 32 + 8 * fq;
#pragma unroll
        for (int ai = 0; ai < 2; ++ai)
#pragma unroll
            for (int m = 0; m < 4; ++m) { const int r = ai * HALF + wr * 64 + m * 16 + fr; const float ws2 = pre.wrow[ai][m] * (SC_HID * DSC(SC_H) * DSC(SC_H));
                GAS unsigned char* rowp = hid + (size_t)(u.pm * 256 + r) * DE + hc0; float h[8];
#pragma unroll
                for (int q = 0; q < 4; ++q) { const f32x4 v = acc[ai][q >> 1][m][q & 1];
                    const float r0 = __builtin_amdgcn_rcpf(1.0f + __builtin_amdgcn_exp2f(v[0] * (-LOG2E * DSC(SC_H)))) * ws2, r1 = __builtin_amdgcn_rcpf(1.0f + __builtin_amdgcn_exp2f(v[2] * (-LOG2E * DSC(SC_H)))) * ws2;
                    h[2 * q] = (v[0] * v[1]) * r0; h[2 * q + 1] = (v[2] * v[3]) * r1; }
                u32x2 o; o.x = pk4_fp8(h[0], h[1], h[2], h[3]); o.y = pk4_fp8(h[4], h[5], h[6], h[7]); *(GAS u32x2*)rowp = o; }
    }
};
struct EpiMoe2 {
    static constexpr int PERM = 2; static constexpr bool NOKEEP = true;
    GAS unsigned char* y;
    __device__ __forceinline__ bool keep(const Unit&) const { return false; }
    struct Pre {}; __device__ __forceinline__ void prefetch(Pre&, const Unit&, int, int, int, int) const {}
    __device__ __forceinline__ void operator()(Acc& acc, const Unit& u, int wr, int wc, int fr, int fq, const Pre& pre) const {
        const int row0 = u.pm * BM + wr * 64 + fr, col0 = u.pn * BM + wc * 64 + 16 * fq;
        static_assert(SC_HID * SC_W2 == SC_YO && !MFMA_SCALED, "E6 accumulators must already be in y's fp8 units");
        float mx = 0.f;
#pragma unroll
        for (int ai = 0; ai < 2; ++ai)
#pragma unroll
            for (int m = 0; m < 4; ++m)
#pragma unroll
                for (int q = 0; q < 4; ++q) { const f32x4 v = acc[ai][q >> 1][m][q & 1]; mx = fmaxf(fmaxf(fabsf(v[0]), fabsf(v[1])), mx); mx = fmaxf(fmaxf(fabsf(v[2]), fabsf(v[3])), mx); }
        const bool big = __builtin_amdgcn_ballot_w64(!(mx <= 448.f)) != 0ull;
        if (!big) {
#pragma unroll
            for (int ai = 0; ai < 2; ++ai)
#pragma unroll
                for (int m = 0; m < 4; ++m) { GAS unsigned char* rowp = y + (size_t)(row0 + ai * HALF + m * 16) * D + col0; u32x4 w;
                    { const f32x4 v0 = acc[ai][0][m][0], v1 = acc[ai][0][m][1], v2 = acc[ai][1][m][0], v3 = acc[ai][1][m][1];
                      w.x = pk4_fp8_nc(v0[0], v0[1], v0[2], v0[3]); w.y = pk4_fp8_nc(v1[0], v1[1], v1[2], v1[3]); w.z = pk4_fp8_nc(v2[0], v2[1], v2[2], v2[3]); w.w = pk4_fp8_nc(v3[0], v3[1], v3[2], v3[3]); }
                    __builtin_nontemporal_store(w, (GAS u32x4*)rowp); }
        } else {
#pragma unroll
            for (int ai = 0; ai < 2; ++ai)
#pragma unroll
                for (int m = 0; m < 4; ++m) { GAS unsigned char* rowp = y + (size_t)(row0 + ai * HALF + m * 16) * D + col0; u32x4 w;
                    { const f32x4 v0 = acc[ai][0][m][0], v1 = acc[ai][0][m][1], v2 = acc[ai][1][m][0], v3 = acc[ai][1][m][1];
                      w.x = pk4_fp8(v0[0], v0[1], v0[2], v0[3]); w.y = pk4_fp8(v1[0], v1[1], v1[2], v1[3]); w.z = pk4_fp8(v2[0], v2[1], v2[2], v2[3]); w.w = pk4_fp8(v3[0], v3[1], v3[2], v3[3]); }
                    __builtin_nontemporal_store(w, (GAS u32x4*)rowp); }
        }
    }
};

__device__ __forceinline__ void stage2(LAS unsigned char* dst, const GAS char* g0, const GAS char* g1) {
    __builtin_amdgcn_global_load_lds((const GAS unsigned*)g0, (LAS unsigned*)dst, 16, 0, 0);
    __builtin_amdgcn_global_load_lds((const GAS unsigned*)g1, (LAS unsigned*)(dst + 1024), 16, 0, 0);
}

template <int PK = -1, class Prob, class Epi, class Sched>
__device__ __forceinline__ void gemm_phase(LAS unsigned char* lds, const int tid, const Prob& P, const Sched& S, const Epi& E) {
    constexpr bool GATHER = Prob::GATHER;
    const int wid = __builtin_amdgcn_readfirstlane(tid >> 6), lane = tid & 63, wr = wid >> 2, wc = wid & 3, fr = lane & 15, fq = lane >> 4;
    const int K = P.K, nt = K / 128;
    unsigned voffA[2], voffB[2], voffB1[2]; int RA[2], CA2[2];
#pragma unroll
    for (int i = 0; i < 2; ++i) { int R, C; stage_rc((2 * wid + i) * 1024 + lane * 16, R, C);   const int Rb = Epi::PERM ? ((R & ~31) + perm32(R & 31)) : R;
        voffA[i] = (unsigned)(R * K + C * 2); voffB[i] = (unsigned)(Rb * K + C * 2); voffB1[i] = 0u; RA[i] = R; CA2[i] = C * 2;
        if (Epi::PERM == 2) { const int w_ = R >> 5, n_ = (R >> 4) & 1, q_ = (R >> 2) & 3, j_ = R & 3, src = 64 * w_ + 16 * q_ + 4 * n_ + j_;
            voffB[i] = (unsigned)(src * K + C * 2); voffB1[i] = (unsigned)((src + 8) * K + C * 2); } }
    const size_t kstep = (size_t)(BK * 2);
    const size_t hstep = (size_t)HALF * K;
    const unsigned ldsw = (unsigned)wid * 2048u;
    const int aoff = lds_byte(wr * 64 + fr, fq * 8), boff = lds_byte(wc * 32 + fr, fq * 8);
#define PG8_SA(b, h) (((b) * 2 + (h)) * HTB)
#define PG8_SB(b, h) ((4 + (b) * 2 + (h)) * HTB)
#define PG8_STG_B(bufoff, pb) stage2(lds + (bufoff) + ldsw, (pb) + voffB[0], (pb) + voffB[1])
#define PG8_STG_B1(bufoff, pb) do { if (Epi::PERM == 2) stage2(lds + (bufoff) + ldsw, (pb) + voffB1[0], (pb) + voffB1[1]); else stage2(lds + (bufoff) + ldsw, (pb) + hstep + voffB[0], (pb) + hstep + voffB[1]); } while (0)
#define PG8_STG_A(bufoff, NXT, h, kb) do { const GAS char* _b = ((NXT) ? nA : cA) + (kb) + (GATHER ? (size_t)0 : (size_t)(h) * hstep); \
        const unsigned _o0 = GATHER ? ((NXT) ? nvA[h][0] : vA[h][0]) : voffA[0], _o1 = GATHER ? ((NXT) ? nvA[h][1] : vA[h][1]) : voffA[1]; \
        stage2(lds + (bufoff) + ldsw, _b + _o0, _b + _o1); } while (0)
#define PG8_LDA(dst, b, h) do { _Pragma("unroll") for (int m = 0; m < 4; ++m) _Pragma("unroll") for (int k = 0; k < 2; ++k) dst[m][k] = *(const LAS bf16x8*)(lds + PG8_SA(b, h) + aoff + m * 2048 + k * 1024); } while (0)
#define PG8_LDB(dst, b, h) do { _Pragma("unroll") for (int n = 0; n < 2; ++n) _Pragma("unroll") for (int k = 0; k < 2; ++k) dst[n][k] = *(const LAS bf16x8*)(lds + PG8_SB(b, h) + boff + n * 2048 + k * 1024); } while (0)
#define PG8_CAT(x) __builtin_shufflevector(__builtin_bit_cast(i32x4, (x)[0]), __builtin_bit_cast(i32x4, (x)[1]), 0, 1, 2, 3, 4, 5, 6, 7)
#define PG8_MMA(ai, bj, At, Bt) do { __builtin_amdgcn_s_setprio(1); _Pragma("unroll") for (int m = 0; m < 4; ++m) _Pragma("unroll") for (int n = 0; n < 2; ++n) \
        { if (MFMA_SCALED) asm volatile("v_mfma_scale_f32_16x16x128_f8f6f4 %0, %1, %2, %0, %3, %4 op_sel_hi:[0,0,0]" : "+v"(acc[ai][bj][m][n]) : "v"(PG8_CAT(Bt[n])), "v"(PG8_CAT(At[m])), "v"(scb), "v"(sca)); \
          else asm volatile("v_mfma_f32_16x16x128_f8f6f4 %0, %1, %2, %0" : "+v"(acc[ai][bj][m][n]) : "v"(PG8_CAT(Bt[n])), "v"(PG8_CAT(At[m]))); } __builtin_amdgcn_s_setprio(0); } while (0)
#define PG8_MMAZ(ai, bj, At, Bt) do { __builtin_amdgcn_s_setprio(1); _Pragma("unroll") for (int m = 0; m < 4; ++m) _Pragma("unroll") for (int n = 0; n < 2; ++n) \
        { asm volatile("v_mfma_f32_16x16x128_f8f6f4 %0, %1, %2, 0" : "+v"(acc[ai][bj][m][n]) : "v"(PG8_CAT(Bt[n])), "v"(PG8_CAT(At[m]))); } __builtin_amdgcn_s_setprio(0); } while (0)
#define PG8_WAIT_V(n) asm volatile("s_waitcnt vmcnt(" #n ")" ::: "memory")
#define PG8_WAIT_L(n) asm volatile("s_waitcnt lgkmcnt(" #n ")" ::: "memory")
#define PG8_BAR __builtin_amdgcn_s_barrier()
#define PG8_SCHED __builtin_amdgcn_sched_barrier(0)
#define PG8_TRIP(t, MM) do { \
            const bool last = (t == nt - 2); \
            const size_t kb1 = (size_t)(t + 1) * kstep; \
            const size_t kb2 = last ? (size_t)0 : (size_t)(t + 2) * kstep, kb3 = kb2 + kstep; \
            const GAS char* b2 = (last ? nB : cB) + kb2; const GAS char* b3 = b2 + kstep; \
            if (GATHER && t == 0 && has_next) P.gather(nxt, RA, CA2, nvA); \
            PG8_LDB(B0, 0, 0); PG8_LDB(B1, 0, 1); PG8_SCHED; PG8_LDA(At, 0, 0); PG8_STG_A(PG8_SA(1, 1), false, 1, kb1); \
            PG8_WAIT_V(8); PG8_WAIT_L(0); PG8_BAR; MM(0, 0, At, B0); MM(0, 1, At, B1); PG8_BAR; PG8_SCHED; \
            PG8_LDA(At, 0, 1); PG8_STG_B(PG8_SB(0, 0), b2); PG8_STG_B1(PG8_SB(0, 1), b2); PG8_STG_A(PG8_SA(0, 0), last, 0, kb2); \
            PG8_WAIT_V(8); PG8_WAIT_L(0); PG8_BAR; MM(1, 0, At, B0); MM(1, 1, At, B1); PG8_BAR; PG8_SCHED; \
            PG8_LDB(B0, 1, 0); PG8_LDB(B1, 1, 1); PG8_SCHED; PG8_LDA(At, 1, 0); PG8_STG_A(PG8_SA(0, 1), last, 1, kb2); \
            PG8_WAIT_V(8); PG8_WAIT_L(0); PG8_BAR; PG8_MMA(0, 0, At, B0); PG8_MMA(0, 1, At, B1); PG8_BAR; PG8_SCHED; \
            PG8_LDA(At, 1, 1); PG8_STG_B(PG8_SB(1, 0), b3); PG8_STG_B1(PG8_SB(1, 1), b3); PG8_STG_A(PG8_SA(1, 0), last, 0, kb3); \
            PG8_WAIT_V(8); PG8_WAIT_L(0); PG8_BAR; PG8_MMA(1, 0, At, B0); PG8_MMA(1, 1, At, B1); PG8_BAR; PG8_SCHED; \
        } while (0)
    constexpr bool ZC = !MFMA_SCALED && Epi::NOKEEP;
    Unit cur, nxt; int ui = 0;
    if (!S.next(0, cur)) return;
    const int sca = Prob::SCA, scb = Prob::SCB;
    Acc acc;
#pragma unroll
    for (int a = 0; a < 2; ++a)
#pragma unroll
        for (int b = 0; b < 2; ++b)
#pragma unroll
            for (int m = 0; m < 4; ++m)
#pragma unroll
                for (int n = 0; n < 2; ++n) acc[a][b][m][n] = (f32x4){0.f, 0.f, 0.f, 0.f};
    bf16x8 At[4][2], B0[2][2], B1[2][2];
    unsigned vA[2][2] = {{0u, 0u}, {0u, 0u}}, nvA[2][2] = {{0u, 0u}, {0u, 0u}};
    const GAS char* cA = P.a_base(cur); const GAS char* cB = P.b_base(cur);
    const GAS char* nA = cA;
    if (GATHER) { P.gather(cur, RA, CA2, vA); }
    {
        const bool F = false;
        PG8_STG_B(PG8_SB(0, 0), cB); PG8_STG_B1(PG8_SB(0, 1), cB); PG8_STG_A(PG8_SA(0, 0), F, 0, (size_t)0); PG8_STG_A(PG8_SA(0, 1), F, 1, (size_t)0);
        if (wr == 1) PG8_BAR;
        PG8_WAIT_V(2); PG8_BAR;
        PG8_STG_B(PG8_SB(1, 0), cB + kstep); PG8_STG_A(PG8_SA(1, 0), F, 0, kstep); PG8_STG_B1(PG8_SB(1, 1), cB + kstep);
        PG8_WAIT_V(6); PG8_BAR;
    }
    for (;;) {
        const bool has_next = S.next(ui + 1, nxt);
        nA = has_next ? P.a_base(nxt) : cA; const GAS char* nB = has_next ? P.b_base(nxt) : cB;
        if (GATHER && !has_next) {
#pragma unroll
            for (int h = 0; h < 2; ++h) { nvA[h][0] = vA[h][0]; nvA[h][1] = vA[h][1]; } }
        if (ZC) { PG8_TRIP(0, PG8_MMAZ); for (int t = 2; t < nt; t += 2) PG8_TRIP(t, PG8_MMA); }
        else { for (int t = 0; t < nt; t += 2) PG8_TRIP(t, PG8_MMA); }
        GSTAMP(lds, PK);
        typename Epi::Pre pre; E.prefetch(pre, cur, wr, wc, fr, fq);
        if (wr == 0) PG8_BAR;
        asm volatile("s_nop 15\n\ts_nop 15\n\ts_nop 15" ::: "memory");
        E(acc, cur, wr, wc, fr, fq, pre);
        GSTAMP(lds, PK < 0 ? -1 : PK + 1);
        if (!has_next) break;
        if (!ZC && !E.keep(cur)) {
#pragma unroll
            for (int a = 0; a < 2; ++a)
#pragma unroll
                for (int b = 0; b < 2; ++b)
#pragma unroll
                    for (int m = 0; m < 4; ++m)
#pragma unroll
                        for (int n = 0; n < 2; ++n) acc[a][b][m][n] = (f32x4){0.f, 0.f, 0.f, 0.f};
        }
        cur = nxt; cA = nA; cB = nB; ++ui;
        if (GATHER) {
#pragma unroll
            for (int h = 0; h < 2; ++h) { vA[h][0] = nvA[h][0]; vA[h][1] = nvA[h][1]; } }
        if (wr == 1) PG8_BAR;
    }
    PG8_WAIT_V(0);
    PG8_BAR;
#undef PG8_SA
#undef PG8_SB
#undef PG8_STG_A
#undef PG8_STG_B
#undef PG8_STG_B1
#undef PG8_LDA
#undef PG8_LDB
#undef PG8_MMA
#undef PG8_MMAZ
#undef PG8_TRIP
#undef PG8_CAT
#undef PG8_WAIT_V
#undef PG8_WAIT_L
#undef PG8_BAR
#undef PG8_SCHED
}
}

struct Frame {
    LAS unsigned char* lds; int tid, lane, wave, vcu, G;
    GAS unsigned char* ws;
};
#define NWAVES 8

__device__ __forceinline__ void transpose_item(const GAS float* W, int N, GAS bf16_t* WT, int ldo, int row_mul, int row_add, LAS float* scr, int item, int lane) {
    const int nblk = N / 32, kb = item / nblk, nb = item % nblk, k0 = 64 * kb, n0 = 32 * nb;
#pragma unroll 8
    for (int i = 0; i < 32; ++i) { const int kk = 2 * i + (lane >> 5); scr[kk * 33 + (lane & 31)] = W[(size_t)(k0 + kk) * N + n0 + (lane & 31)]; }
    LDS_WAIT(); asm volatile("" ::: "memory");
    const int c = lane & 7;
#pragma unroll
    for (int j = 0; j < 4; ++j) { const int n = (lane >> 3) + 8 * j; const LAS float* s = scr + (8 * c) * 33 + n;
        u32x4 o; o.x = cvt_pk_bf16(s[0 * 33], s[1 * 33]); o.y = cvt_pk_bf16(s[2 * 33], s[3 * 33]); o.z = cvt_pk_bf16(s[4 * 33], s[5 * 33]); o.w = cvt_pk_bf16(s[6 * 33], s[7 * 33]);
        *(GAS u32x4*)(WT + (size_t)((n0 + n) * row_mul + row_add) * ldo + k0 + 8 * c) = o; }
    LDS_WAIT(); asm volatile("" ::: "memory");
}

__device__ __forceinline__ void transpose_item8(const GAS float* W, int N, GAS unsigned char* WT, int ldo, int row_mul, int row_add, LAS float* scr, int item, int lane, const float wsc = SC_W) {
    const int nblk = N / 32, kb = item / nblk, nb = item % nblk, k0 = 64 * kb, n0 = 32 * nb;
    { const int q4 = 4 * (lane & 7), r8 = lane >> 3; f32x4 v[8];
#pragma unroll
      for (int i = 0; i < 8; ++i) v[i] = *(const GAS f32x4*)(W + (size_t)(k0 + 8 * i + r8) * N + n0 + q4);
#pragma unroll
      for (int i = 0; i < 8; ++i) { LAS float* d = scr + (8 * i + r8) * 33 + q4; d[0] = v[i][0] * wsc; d[1] = v[i][1] * wsc; d[2] = v[i][2] * wsc; d[3] = v[i][3] * wsc; } }
    LDS_WAIT(); asm volatile("" ::: "memory");
    const int c = lane & 7;
#pragma unroll
    for (int j = 0; j < 4; ++j) { const int n = (lane >> 3) + 8 * j; const LAS float* q = scr + (8 * c) * 33 + n;
        u32x2 o; o.x = pk4_fp8(q[0 * 33], q[1 * 33], q[2 * 33], q[3 * 33]); o.y = pk4_fp8(q[4 * 33], q[5 * 33], q[6 * 33], q[7 * 33]);
        *(GAS u32x2*)(WT + (size_t)((n0 + n) * row_mul + row_add) * ldo + k0 + 8 * c) = o; }
    LDS_WAIT(); asm volatile("" ::: "memory");
}

__device__ __forceinline__ void convert_layer(const Frame& F, const Args& a, int l) {
    LAS float* scr = (LAS float*)(F.lds + F.wave * 16384);
    const int gw = F.vcu * NWAVES + F.wave, NGW = F.G * NWAVES;
    GAS unsigned char* ws = F.ws;
    constexpr int I_IN = 16 * 192, I_SQ = 16 * 32, I_E1 = 16 * 8, I_E2 = 4 * 32, I_RG = 2 * 4;
    constexpr int N0 = I_IN, N1 = N0 + 3 * I_SQ, N2 = N1 + 64 * I_E1, N3 = N2 + 64 * I_E1, N4 = N3 + 2 * I_E1, N5 = N4 + 64 * I_E2, N6 = N5 + I_E2, N7 = N6 + 8 * I_RG, N8 = N7 + 8 * I_RG;
    for (int it = gw; it < N8; it += NGW) {
        if (it < N0) { transpose_item8(((const GAS float*)a.in[4]) + (size_t)l * D * NIN, NIN, (GAS unsigned char*)(ws + W_IN), D, 1, 0, scr, it, F.lane); }
        else if (it < N1) { const int r = it - N0, w = r / I_SQ, ii = r % I_SQ; const GAS float* src = ((const GAS float*)a.in[16 + w]) + (size_t)l * D * D; GAS unsigned char* dst = (GAS unsigned char*)(ws + (w == 0 ? W_A : (w == 1 ? W_B : W_O)));
            transpose_item8(src, D, dst, D, 1, 0, scr, ii, F.lane); }
        else if (it < N2) { const int r = it - N1, e = r / I_E1, ii = r % I_E1; transpose_item8(((const GAS float*)a.in[23]) + ((size_t)l * NE + e) * D * DE, DE, (GAS unsigned char*)(ws + W_E13) + (size_t)e * 512 * D, D, 2, 0, scr, ii, F.lane); }
        else if (it < N3) { const int r = it - N2, e = r / I_E1, ii = r % I_E1; transpose_item8(((const GAS float*)a.in[24]) + ((size_t)l * NE + e) * D * DE, DE, (GAS unsigned char*)(ws + W_E13) + (size_t)e * 512 * D, D, 2, 1, scr, ii, F.lane); }
        else if (it < N4) { const int r = it - N3, w = r / I_E1, ii = r % I_E1; transpose_item8(((const GAS float*)a.in[26 + w]) + (size_t)l * D * DE, DE, (GAS unsigned char*)(ws + W_E13) + (size_t)64 * 512 * D, D, 2, w, scr, ii, F.lane); }
        else if (it < N5) { const int r = it - N4, e = r / I_E2, ii = r % I_E2; transpose_item8(((const GAS float*)a.in[25]) + ((size_t)l * NE + e) * DE * D, D, (GAS unsigned char*)(ws + W_E2) + (size_t)e * D * DE, DE, 1, 0, scr, ii, F.lane, SC_W2); }
        else if (it < N6) { const int ii = it - N5; transpose_item8(((const GAS float*)a.in[28]) + (size_t)l * DE * D, D, (GAS unsigned char*)(ws + W_E2) + (size_t)64 * D * DE, DE, 1, 0, scr, ii, F.lane, SC_W2); }
        else if (it < N7) { const int r = it - N6, h = r / I_RG, ii = r % I_RG; transpose_item(((const GAS float*)a.in[11]) + ((size_t)l * 8 + h) * 128 * 128, 128, (GAS bf16_t*)(ws + W_RGA) + (size_t)h * 128 * 128, 128, 1, 0, scr, ii, F.lane); }
        else { const int r = it - N7, h = r / I_RG, ii = r % I_RG; transpose_item(((const GAS float*)a.in[13]) + ((size_t)l * 8 + h) * 128 * 128, 128, (GAS bf16_t*)(ws + W_RGX) + (size_t)h * 128 * 128, 128, 1, 0, scr, ii, F.lane); }
    }
    const int gt = F.vcu * 512 + F.tid, NGT = F.G * 512;
    for (int i = gt; i < 8 * 128 * 128; i += NGT) { const int s = i & 127, t = (i >> 7) & 127; const float v = ((const GAS float*)a.in[7])[(size_t)l * 8 * 128 * 128 + i];
        ((GAS bf16_t*)(ws + W_SG))[i] = (bf16_t)(cvt_pk_bf16(s <= t ? v : 0.f, 0.f) & 0xffffu); }
    for (int i = gt; i < 64 * 1024; i += NGT) { const int c = i >> 6, e = i & 63; const float v = ((const GAS float*)a.in[21])[(size_t)l * D * 64 + i];
        const unsigned hi = cvt_pk_bf16(v, 0.f) & 0xffffu; const float r = v - __uint_as_float(hi << 16);
        ((GAS bf16_t*)(ws + W_RH))[e * D + c] = (bf16_t)hi; ((GAS bf16_t*)(ws + W_RL))[e * D + c] = (bf16_t)(cvt_pk_bf16(r, 0.f) & 0xffffu); }
    for (int i = gt; i < D; i += NGT) ((GAS float*)(ws + WS_MISC))[i] = 8.0f * log1pf(expf(-((const GAS float*)a.in[15])[(size_t)l * D + i]));
}

__device__ __forceinline__ void ada_phase(const Frame& F, const Args& a) {
    LAS float* sc = (LAS float*)F.lds;
    LAS float* red = (LAS float*)(F.lds + 65536);
    bool loaded = false;
    for (int u = F.vcu; u < 4 * 96; u += F.G) {
        if (!loaded) { for (int i = F.tid; i < 16 * D; i += 512) { const int b = i >> 10, k = i & 1023; const float v = ((const GAS float*)a.in[1])[i]; sc[k * 16 + b] = v * fsigmoid(v); } loaded = true; __syncthreads(); }
        const int l = u / 96, j0 = (u % 96) * 64, jj = F.tid & 63, ks = F.tid >> 6;
        float acc[16];
#pragma unroll
        for (int b = 0; b < 16; ++b) acc[b] = 0.f;
        const GAS float* wp = ((const GAS float*)a.in[2]) + ((size_t)l * D + ks * 128) * NIN + j0 + jj;
#pragma unroll 4
        for (int k = 0; k < 128; ++k) { const float w = wp[(size_t)k * NIN]; const LAS f32x4* s4 = (const LAS f32x4*)(sc + (ks * 128 + k) * 16);
#pragma unroll
            for (int q = 0; q < 4; ++q) { const f32x4 sv = s4[q]; acc[4 * q] += sv[0] * w; acc[4 * q + 1] += sv[1] * w; acc[4 * q + 2] += sv[2] * w; acc[4 * q + 3] += sv[3] * w; } }
#pragma unroll
        for (int b = 0; b < 16; ++b) red[(ks * 16 + b) * 64 + jj] = acc[b];
        __syncthreads();
#pragma unroll
        for (int p = 0; p < 2; ++p) { const int o = F.tid + 512 * p, b = o >> 6, j = o & 63; float s = 0.f;
#pragma unroll
            for (int k2 = 0; k2 < 8; ++k2) s += red[(k2 * 16 + b) * 64 + j];
            ((GAS float*)(F.ws + WS_ADA))[((size_t)l * 16 + b) * NIN + j0 + j] = s + ((const GAS float*)a.in[3])[(size_t)l * NIN + j0 + j]; }
        __syncthreads();
    }
}

__device__ __forceinline__ void modulate0(const Frame& F, const Args& a) {
    const GAS float* ada = (const GAS float*)(F.ws + WS_ADA); GAS unsigned char* H = (GAS unsigned char*)(F.ws + B_H8);
    const size_t NG = (size_t)T * D / 8;
    for (size_t i = (size_t)F.vcu * 512 + F.tid; i < NG; i += (size_t)F.G * 512) {
        const size_t t = i >> 7; const int c = (int)(i & 127) * 8; const int b = (int)(t >> 12);
        const GAS float* xp = ((const GAS float*)a.in[0]) + t * D + c; const f32x4 x0 = *(const GAS f32x4*)xp, x1 = *(const GAS f32x4*)(xp + 4);
        const GAS float* sh = ada + (size_t)b * NIN + c; const f32x4 h0 = *(const GAS f32x4*)sh, h1 = *(const GAS f32x4*)(sh + 4), s0 = *(const GAS f32x4*)(sh + D), s1 = *(const GAS f32x4*)(sh + D + 4);
        const f32x4 r0 = (x0 * (s0 + 1.0f) + h0) * SC_H, r1 = (x1 * (s1 + 1.0f) + h1) * SC_H;
        u32x2 o; o.x = pk4_fp8(r0[0], r0[1], r0[2], r0[3]); o.y = pk4_fp8(r1[0], r1[1], r1[2], r1[3]);
        *(GAS u32x2*)(H + t * D + c) = o;
    }
}


__device__ __forceinline__ void vstats_phase(const Frame& F) {
    const GAS unsigned char* V = (const GAS unsigned char*)(F.ws + B_V); GAS f32x2* vs = (GAS f32x2*)(F.ws + WS_VSTAT);
    const int gw = F.vcu * NWAVES + F.wave, NGW = F.G * NWAVES;
    for (int row = gw; row < T; row += NGW) {
        const u32x4 rw = *(const GAS u32x4*)(V + (size_t)row * D + 16 * F.lane); float f[16];
        { float t8[8]; unpack8_fp8((u32x2){rw.x, rw.y}, t8);
#pragma unroll
          for (int j = 0; j < 8; ++j) f[j] = t8[j] * (1.0f / SC_Z);
          unpack8_fp8((u32x2){rw.z, rw.w}, t8);
#pragma unroll
          for (int j = 0; j < 8; ++j) f[8 + j] = t8[j] * (1.0f / SC_Z); }
        float s = 0.f;
#pragma unroll
        for (int j = 0; j < 16; ++j) s += f[j];
        const float mean = wave_sum(s) * (1.0f / D); float q = 0.f;
#pragma unroll
        for (int j = 0; j < 16; ++j) { const float d = f[j] - mean; q += d * d; }
        const float rstd = rsqrtf(wave_sum(q) * (1.0f / D) + LN_EPS);
        if (F.lane == 0) vs[row] = (f32x2){mean, rstd};
    }
}

__device__ __forceinline__ void vstat_row(const u32x4 rw, GAS f32x2* dst, int lane) {
    float f[16];
    { float t8[8]; unpack8_fp8((u32x2){rw.x, rw.y}, t8);
#pragma unroll
      for (int j = 0; j < 8; ++j) f[j] = t8[j] * (1.0f / SC_Z);
      unpack8_fp8((u32x2){rw.z, rw.w}, t8);
#pragma unroll
      for (int j = 0; j < 8; ++j) f[8 + j] = t8[j] * (1.0f / SC_Z); }
    float s = 0.f;
#pragma unroll
    for (int j = 0; j < 16; ++j) s += f[j];
    const float mean = wave_sum(s) * (1.0f / D); float q = 0.f;
#pragma unroll
    for (int j = 0; j < 16; ++j) { const float d = f[j] - mean; q += d * d; }
    const float rstd = rsqrtf(wave_sum(q) * (1.0f / D) + LN_EPS);
    if (lane == 0) *dst = (f32x2){mean, rstd};
}
__device__ __forceinline__ void rg_phase(const Frame& F, const Args& a, int l) {
    LAS unsigned char* lds = F.lds; const int tid0 = F.tid, wid = F.wave, wr = wid >> 2, wc = wid & 3;
    GAS unsigned char* ws = F.ws;
    const int hd = F.vcu & 7, g0 = F.vcu >> 3, gstep = F.G >> 3;
    const GAS bf16_t* RI = (const GAS bf16_t*)(ws + B_RI);
    GAS bf16_t* HL = (GAS bf16_t*)(ws + B_HL); GAS bf16_t* CA = (GAS bf16_t*)(ws + B_CA);
    LAS unsigned char* At = lds;
    LAS float* CST = (LAS float*)(lds + 143360);
    const int c0 = hd * 128 + (tid0 & 15) * 8;
    __syncthreads();
    for (int i = tid0; i < 8 * 128; i += 512) { const int r = i >> 7, c = hd * 128 + (i & 127); float v;
        if (r < 4) v = ((const GAS float*)a.in[9])[((size_t)l * 4 + r) * D + c] * (1.0f / SC_Z); else if (r == 4) v = ((const GAS float*)a.in[10])[(size_t)l * D + c];
        else if (r == 5) v = ((const GAS float*)a.in[12])[(size_t)l * D + c]; else if (r == 6) v = ((const GAS float*)a.in[14])[(size_t)l * D + c]; else v = ((const GAS float*)(ws + WS_MISC))[c];
        CST[i] = v; }
    bf16x8 ba[2][4], bx[2][4];
#pragma unroll
    for (int n = 0; n < 2; ++n)
#pragma unroll
        for (int kk = 0; kk < 4; ++kk) { const size_t o = ((size_t)hd * 128 + wc * 32 + n * 16 + (tid0 & 15)) * 128 + kk * 32 + ((tid0 & 63) >> 4) * 8;
            ba[n][kk] = *(const GAS bf16x8*)((const GAS bf16_t*)(ws + W_RGA) + o); bx[n][kk] = *(const GAS bf16x8*)((const GAS bf16_t*)(ws + W_RGX) + o); }
    __syncthreads();
    u32x2 rv[4][4];
    const __amdgpu_buffer_rsrc_t rsRI = __builtin_amdgcn_make_buffer_rsrc((void*)(a.ws + B_RI), 0, 0x4000000, 0x00020000);
    const __amdgpu_buffer_rsrc_t rsHL = __builtin_amdgcn_make_buffer_rsrc((void*)(a.ws + B_HL), 0, 0x8000000, 0x00020000);
    const __amdgpu_buffer_rsrc_t rsCA = __builtin_amdgcn_make_buffer_rsrc((void*)(a.ws + B_CA), 0, 0x8000000, 0x00020000);
    const int vo = ((tid0 >> 4) * D + c0) * 2;
#define RG_LOAD(gc_) do { const int _nch = (gc_) & 31; const int _t0 = (gc_) * 128; \
        _Pragma("unroll") for (int p = 0; p < 4; ++p) { const int t = (tid0 >> 4) + 32 * p; \
            _Pragma("unroll") for (int k = 0; k < 4; ++k) { const int tt = t - 3 + k; rv[p][k] = (u32x2){0u, 0u}; \
                if (tt >= 0 || _nch > 0) rv[p][k] = __builtin_amdgcn_raw_buffer_load_b64(rsRI, vo >> 1, (_t0 + 32 * p + k - 3) * D, 0); } } } while (0)
    if (g0 < 512) RG_LOAD(g0);
    for (int gc = g0; gc < 512; gc += gstep) {
        const size_t t0 = (size_t)gc * 128;
        int tq = tid0; asm volatile("" : "+v"(tq));
        const int tid = tq, lane = tq & 63, fr = lane & 15, fq = lane >> 4, cb = tq & 15;
        const int vit = (gc - g0) / gstep; const size_t vrow = (size_t)(F.vcu * NWAVES + wid) * 32 + 2 * vit;
        const u32x4 vsa = *(const GAS u32x4*)((const GAS unsigned char*)(ws + B_V) + vrow * D + 16 * lane), vsb = *(const GAS u32x4*)((const GAS unsigned char*)(ws + B_V) + (vrow + 1) * D + 16 * lane);
#pragma unroll
        for (int p = 0; p < 4; ++p) { const int t = (tid >> 4) + 32 * p; float r[8];
            { const f32x4 b0 = *(const LAS f32x4*)(CST + 4 * 128 + cb * 8), b1 = *(const LAS f32x4*)(CST + 4 * 128 + cb * 8 + 4);
#pragma unroll
              for (int j = 0; j < 4; ++j) { r[j] = b0[j]; r[4 + j] = b1[j]; } }
#pragma unroll
            for (int k = 0; k < 4; ++k) { float v[8]; unpack8_fp8(rv[p][k], v); const f32x4 w0 = *(const LAS f32x4*)(CST + k * 128 + cb * 8), w1 = *(const LAS f32x4*)(CST + k * 128 + cb * 8 + 4);
#pragma unroll
                for (int j = 0; j < 4; ++j) { r[j] += w0[j] * v[j]; r[4 + j] += w1[j] * v[4 + j]; } }
            *(LAS u32x4*)(At + t * 272 + cb * 16) = pack8(r); }
        __syncthreads();
        f32x4 ga[4][2], gx[4][2];
#pragma unroll
        for (int m = 0; m < 4; ++m)
#pragma unroll
            for (int n = 0; n < 2; ++n) { ga[m][n] = (f32x4){0.f, 0.f, 0.f, 0.f}; gx[m][n] = (f32x4){0.f, 0.f, 0.f, 0.f}; }
#pragma unroll
        for (int kk = 0; kk < 4; ++kk) { bf16x8 af[4];
#pragma unroll
            for (int m = 0; m < 4; ++m) af[m] = *(const LAS bf16x8*)(At + (wr * 64 + m * 16 + fr) * 272 + (kk * 32 + fq * 8) * 2);
#pragma unroll
            for (int m = 0; m < 4; ++m)
#pragma unroll
                for (int n = 0; n < 2; ++n) { ga[m][n] = __builtin_amdgcn_mfma_f32_16x16x32_bf16(ba[n][kk], af[m], ga[m][n], 0, 0, 0); gx[m][n] = __builtin_amdgcn_mfma_f32_16x16x32_bf16(bx[n][kk], af[m], gx[m][n], 0, 0, 0); } }
#pragma unroll
        for (int n = 0; n < 2; ++n) { const int j0 = wc * 32 + n * 16 + 4 * fq;
            const f32x4 bav = *(const LAS f32x4*)(CST + 5 * 128 + j0), bxv = *(const LAS f32x4*)(CST + 6 * 128 + j0), spv = *(const LAS f32x4*)(CST + 7 * 128 + j0);
#pragma unroll
            for (int m = 0; m < 4; ++m) { const int t = wr * 64 + m * 16 + fr; const u32x2 rw = *(const LAS u32x2*)(At + t * 272 + j0 * 2);
                const float rin[4] = {bf_lo(rw.x), bf_hi(rw.x), bf_lo(rw.y), bf_hi(rw.y)};
#pragma unroll
                for (int r = 0; r < 4; ++r) { const float rg = fsigmoid(ga[m][n][r] + bav[r]), ig = fsigmoid(gx[m][n][r] + bxv[r]);
                    const float av = __builtin_amdgcn_exp2f(-(spv[r] * LOG2E) * rg);
                    const float om = 1.0f - av * av;
                    ga[m][n][r] = av; gx[m][n][r] = sqrtf(fmaxf(om, 0.f)) * ig * rin[r]; } } }
        __syncthreads();
        LAS float* PA = (LAS float*)lds; LAS float* PI = (LAS float*)(lds + 67584);
#pragma unroll
        for (int m = 0; m < 4; ++m)
#pragma unroll
            for (int n = 0; n < 2; ++n) { const int t = wr * 64 + m * 16 + fr, j0 = wc * 32 + n * 16 + 4 * fq; *(LAS f32x4*)(PA + t * 132 + j0) = ga[m][n]; *(LAS f32x4*)(PI + t * 132 + j0) = gx[m][n]; }
        __syncthreads();
        vstat_row(vsa, (GAS f32x2*)(ws + WS_VSTAT) + vrow, lane); vstat_row(vsb, (GAS f32x2*)(ws + WS_VSTAT) + vrow + 1, lane);
        if (gc + gstep < 512) RG_LOAD(gc + gstep);
        LAS f32x2* SE = (LAS f32x2*)(lds + 135168); LAS float* CRC = (LAS float*)(lds + 135168 + 4096); LAS float* CRH = CRC + 512;
        const int c = tid & 127, seg = tid >> 7; float h = 0.f, cum = 1.f;
#pragma unroll 8
        for (int tt = 0; tt < 32; ++tt) { const int t = seg * 32 + tt; const float av = PA[t * 132 + c], xv = PI[t * 132 + c]; h = av * h + xv; cum *= av; PI[t * 132 + c] = h; PA[t * 132 + c] = cum; }
        SE[seg * 128 + c] = (f32x2){cum, h};
        __syncthreads();
        { float ch = 0.f, cc = 1.f;
          for (int sg2 = 0; sg2 < seg; ++sg2) { const f32x2 e = SE[sg2 * 128 + c]; ch = e.x * ch + e.y; cc *= e.x; }
          CRC[seg * 128 + c] = cc; CRH[seg * 128 + c] = ch;
          if (seg == 3) { GAS float* cr = (GAS float*)(ws + WS_CARRY) + (size_t)gc * 2 * D + hd * 128 + c; cr[0] = cum * cc; cr[D] = h + cum * ch; } }
        __syncthreads();
#pragma unroll 1
        for (int p = 0; p < 4; ++p) { const int t = (tid >> 4) + 32 * p, sg = t >> 5; float oh[8], oc[8];
            { const f32x4 cu0 = *(const LAS f32x4*)(PA + t * 132 + cb * 8), cu1 = *(const LAS f32x4*)(PA + t * 132 + cb * 8 + 4), hv0 = *(const LAS f32x4*)(PI + t * 132 + cb * 8), hv1 = *(const LAS f32x4*)(PI + t * 132 + cb * 8 + 4);
              const f32x4 cc0 = *(const LAS f32x4*)(CRC + sg * 128 + cb * 8), cc1 = *(const LAS f32x4*)(CRC + sg * 128 + cb * 8 + 4), ch0 = *(const LAS f32x4*)(CRH + sg * 128 + cb * 8), ch1 = *(const LAS f32x4*)(CRH + sg * 128 + cb * 8 + 4);
              const f32x4 h0 = hv0 + cu0 * ch0, h1 = hv1 + cu1 * ch1, c0v = cu0 * cc0, c1v = cu1 * cc1;
#pragma unroll
              for (int j = 0; j < 4; ++j) { oh[j] = h0[j]; oh[4 + j] = h1[j]; oc[j] = c0v[j]; oc[4 + j] = c1v[j]; } }
            { u32x2 wh8, wc8; wh8.x = pk4_fp8(oh[0] * SC_HL, oh[1] * SC_HL, oh[2] * SC_HL, oh[3] * SC_HL); wh8.y = pk4_fp8(oh[4] * SC_HL, oh[5] * SC_HL, oh[6] * SC_HL, oh[7] * SC_HL);
              wc8.x = pk4_fp8(oc[0] * SC_CA, oc[1] * SC_CA, oc[2] * SC_CA, oc[3] * SC_CA); wc8.y = pk4_fp8(oc[4] * SC_CA, oc[5] * SC_CA, oc[6] * SC_CA, oc[7] * SC_CA);
              __builtin_amdgcn_raw_buffer_store_b64(wh8, rsHL, vo >> 1, ((int)t0 + 32 * p) * D, 0); __builtin_amdgcn_raw_buffer_store_b64(wc8, rsCA, vo >> 1, ((int)t0 + 32 * p) * D, 0); } }
        __syncthreads();
    }
#undef RG_LOAD
}

__device__ __forceinline__ void sgu_phase(const Frame& F, const Args& a, int l) {
    LAS unsigned char* lds = F.lds; const int tid0 = F.tid, wid = F.wave, wr = wid >> 2, wc = wid & 3;
    GAS unsigned char* ws = F.ws;
    const int g = F.vcu & 7, g0 = F.vcu >> 3, gstep = F.G >> 3;
    const GAS unsigned char* U = (const GAS unsigned char*)(ws + B_U); GAS unsigned char* YA = (GAS unsigned char*)(ws + B_YA8); const GAS unsigned char* V = (const GAS unsigned char*)(ws + B_V); const GAS f32x2* vs = (const GAS f32x2*)(ws + WS_VSTAT);
    LAS unsigned char* Wt = lds; LAS unsigned char* Vs = lds + 34816;
    float gam[8], bet[8], bsr[4];
    { const int cb0 = tid0 & 15, c00 = g * 128 + cb0 * 8;
      const GAS float* p = ((const GAS float*)a.in[5]) + (size_t)l * D + c00; const f32x4 w0 = *(const GAS f32x4*)p, w1 = *(const GAS f32x4*)(p + 4); const GAS float* q = ((const GAS float*)a.in[6]) + (size_t)l * D + c00; const f32x4 b0 = *(const GAS f32x4*)q, b1 = *(const GAS f32x4*)(q + 4);
#pragma unroll
      for (int j = 0; j < 4; ++j) { gam[j] = w0[j] * (1.0f / SC_Z); gam[4 + j] = w1[j] * (1.0f / SC_Z); bet[j] = b0[j]; bet[4 + j] = b1[j]; }
#pragma unroll
      for (int m = 0; m < 4; ++m) bsr[m] = ((const GAS float*)a.in[8])[((size_t)l * 8 + g) * 128 + wr * 64 + m * 16 + (tid0 & 15)];
      __syncthreads();
#pragma unroll
      for (int p2 = 0; p2 < 4; ++p2) { const int row = (tid0 >> 4) + 32 * p2;
        *(LAS u32x4*)(Wt + row * 272 + cb0 * 16) = *(const GAS u32x4*)((const GAS bf16_t*)(ws + W_SG) + ((size_t)g * 128 + row) * 128 + cb0 * 8); } }
    u32x2 vraw[4]; f32x2 stv[4]; u32x2 uraw[4];
#define SG_LOAD(gc_) do { const size_t _t0 = (size_t)(gc_) * 128; \
        _Pragma("unroll") for (int p2 = 0; p2 < 4; ++p2) { const int row = (tid0 >> 4) + 32 * p2; vraw[p2] = *(const GAS u32x2*)(V + (_t0 + row) * D + g * 128 + (tid0 & 15) * 8); stv[p2] = vs[_t0 + row]; } \
        _Pragma("unroll") for (int m = 0; m < 4; ++m) uraw[m] = *(const GAS u32x2*)(U + (_t0 + wr * 64 + m * 16 + (tid0 & 15)) * D + g * 128 + wc * 32 + 8 * ((tid0 & 63) >> 4)); } while (0)
    if (g0 < 512) SG_LOAD(g0);
    for (int gc = g0; gc < 512; gc += gstep) {
        const size_t t0 = (size_t)gc * 128;
        int tq = tid0; asm volatile("" : "+v"(tq));
        const int lane = tq & 63, fr = lane & 15, fq = lane >> 4, cb = tq & 15;
#pragma unroll
        for (int p2 = 0; p2 < 4; ++p2) { const int row = (tq >> 4) + 32 * p2; float v[8]; unpack8_fp8(vraw[p2], v); const float ms = stv[p2].x * SC_Z, rs = stv[p2].y;
#pragma unroll
            for (int j = 0; j < 8; ++j) v[j] = (v[j] - ms) * rs * gam[j] + bet[j];
            const u32x4 o = pack8(v); *(LAS u32x2*)(Vs + row * 264 + cb * 16) = (u32x2){o.x, o.y}; *(LAS u32x2*)(Vs + row * 264 + cb * 16 + 8) = (u32x2){o.z, o.w}; }
        u32x2 ucur[4];
#pragma unroll
        for (int m = 0; m < 4; ++m) ucur[m] = uraw[m];
        __syncthreads();
        if (gc + gstep < 512) SG_LOAD(gc + gstep);
        f32x4 acc[4][2];
#pragma unroll
        for (int m = 0; m < 4; ++m)
#pragma unroll
            for (int n = 0; n < 2; ++n) acc[m][n] = (f32x4){0.f, 0.f, 0.f, 0.f};
        u32x2 tr[4][2][2];
        { const unsigned va = (unsigned)(size_t)Vs + (unsigned)((fq * 8 + (fr >> 2)) * 264 + (wc * 32 + 8 * (fr & 3)) * 2);
#define SG_TR4(kk_) asm volatile("ds_read_b64_tr_b16 %0, %4 offset:%5\n\tds_read_b64_tr_b16 %1, %4 offset:%6\n\tds_read_b64_tr_b16 %2, %4 offset:%7\n\tds_read_b64_tr_b16 %3, %4 offset:%8" \
            : "=&v"(tr[kk_][0][0]), "=&v"(tr[kk_][0][1]), "=&v"(tr[kk_][1][0]), "=&v"(tr[kk_][1][1]) : "v"(va), "i"((kk_) * 32 * 264), "i"((kk_) * 32 * 264 + 4 * 264), "i"((kk_) * 32 * 264 + 8), "i"((kk_) * 32 * 264 + 4 * 264 + 8) : "memory")
          SG_TR4(0); SG_TR4(1); SG_TR4(2); SG_TR4(3);
#undef SG_TR4
          asm volatile("s_waitcnt lgkmcnt(0)" ::: "memory"); }
#pragma unroll
        for (int kk = 0; kk < 4; ++kk) {
            bf16x8 af[4], bfr[2];
#pragma unroll
            for (int m = 0; m < 4; ++m) af[m] = *(const LAS bf16x8*)(Wt + (wr * 64 + m * 16 + fr) * 272 + (kk * 32 + fq * 8) * 2);
#pragma unroll
            for (int n = 0; n < 2; ++n) { const u32x4 w = (u32x4){tr[kk][n][0].x, tr[kk][n][0].y, tr[kk][n][1].x, tr[kk][n][1].y}; bfr[n] = __builtin_bit_cast(bf16x8, w); }
#pragma unroll
            for (int m = 0; m < 4; ++m)
#pragma unroll
                for (int n = 0; n < 2; ++n) acc[m][n] = __builtin_amdgcn_mfma_f32_16x16x32_bf16(bfr[n], af[m], acc[m][n], 0, 0, 0);
        }
#pragma unroll
        for (int m = 0; m < 4; ++m) { const int t = wr * 64 + m * 16 + fr; const float bs = bsr[m]; const size_t eo = (t0 + t) * D + g * 128 + wc * 32 + 8 * fq; float uf[8]; unpack8_fp8(ucur[m], uf);
            u32x2 o; o.x = pk4_fp8(uf[0] * (acc[m][0][0] + bs) * (SC_Y / SC_Z), uf[1] * (acc[m][0][1] + bs) * (SC_Y / SC_Z), uf[2] * (acc[m][0][2] + bs) * (SC_Y / SC_Z), uf[3] * (acc[m][0][3] + bs) * (SC_Y / SC_Z));
            o.y = pk4_fp8(uf[4] * (acc[m][1][0] + bs) * (SC_Y / SC_Z), uf[5] * (acc[m][1][1] + bs) * (SC_Y / SC_Z), uf[6] * (acc[m][1][2] + bs) * (SC_Y / SC_Z), uf[7] * (acc[m][1][3] + bs) * (SC_Y / SC_Z));
            *(GAS u32x2*)(YA + eo) = o; }
        __syncthreads();
    }
#undef SG_LOAD
}

__device__ __forceinline__ void scanfix_unit(const Frame& F, int gc) {
    GAS unsigned char* ws = F.ws; const int tid = F.tid;
    const GAS unsigned char* RG = (const GAS unsigned char*)(ws + B_RG); GAS unsigned char* YB = (GAS unsigned char*)(ws + B_YB8); const GAS unsigned char* HL = (const GAS unsigned char*)(ws + B_HL); const GAS unsigned char* CA = (const GAS unsigned char*)(ws + B_CA);
    LAS float* hin = (LAS float*)F.lds;
    const int nch = gc & 31, cbk = tid & 63, tseg = tid >> 6;
    if (tid < 128) { float h[8];
#pragma unroll
        for (int j = 0; j < 8; ++j) h[j] = 0.f;
        const GAS float* cr = (const GAS float*)(ws + WS_CARRY) + (size_t)(gc - nch) * 2 * D + tid * 8;
        for (int n = 0; n < nch; ++n) { const f32x4 p0 = *(const GAS f32x4*)(cr + (size_t)n * 2 * D), p1 = *(const GAS f32x4*)(cr + (size_t)n * 2 * D + 4), h0 = *(const GAS f32x4*)(cr + (size_t)n * 2 * D + D), h1 = *(const GAS f32x4*)(cr + (size_t)n * 2 * D + D + 4);
#pragma unroll
            for (int j = 0; j < 4; ++j) { h[j] = p0[j] * h[j] + h0[j]; h[4 + j] = p1[j] * h[4 + j] + h1[j]; } }
#pragma unroll
        for (int j = 0; j < 8; ++j) hin[tid * 8 + j] = h[j] * (1.0f / SC_CA); }
    __syncthreads();
    float hi[16];
#pragma unroll
    for (int j = 0; j < 16; ++j) hi[j] = hin[cbk * 16 + j];
    const size_t base = ((size_t)gc * 128 + tseg * 16) * D + cbk * 16;
    u32x4 rg[4], hl[4], ca[4];
#define SF_LOAD(t0_) do { _Pragma("unroll") for (int q = 0; q < 4; ++q) { const size_t o = base + (size_t)((t0_) + q) * D; rg[q] = *(const GAS u32x4*)(RG + o); hl[q] = *(const GAS u32x4*)(HL + o); ca[q] = *(const GAS u32x4*)(CA + o); } } while (0)
    SF_LOAD(0);
    for (int tb = 0; tb < 16; tb += 4) {
        u32x4 w[4];
#pragma unroll
        for (int q = 0; q < 4; ++q) { float g[16], h[16], c[16]; unpack16_fp8(rg[q], g); unpack16_fp8(hl[q], h); unpack16_fp8(ca[q], c);
#pragma unroll
            for (int j = 0; j < 16; ++j) g[j] = g[j] * (h[j] * (1.0f / SC_HL) + c[j] * hi[j]) * (SC_Y / SC_Z);
            w[q].x = pk4_fp8(g[0], g[1], g[2], g[3]); w[q].y = pk4_fp8(g[4], g[5], g[6], g[7]); w[q].z = pk4_fp8(g[8], g[9], g[10], g[11]); w[q].w = pk4_fp8(g[12], g[13], g[14], g[15]); }
        if (tb + 4 < 16) SF_LOAD(tb + 4);
#pragma unroll
        for (int q = 0; q < 4; ++q) *(GAS u32x4*)(YB + base + (size_t)(tb + q) * D) = w[q];
    }
#undef SF_LOAD
    __syncthreads();
}

__device__ __forceinline__ void ln1_route_phase(const Frame& F, const Args& a, int l) {
    LAS unsigned char* lds = F.lds; const int tid = F.tid, lane = F.lane, wid = F.wave, fr = lane & 15, fq = lane >> 4;
    GAS unsigned char* ws = F.ws;
    LAS float* VEC = (LAS float*)lds;
    LAS float* LG = (LAS float*)(lds + 16384);
    LAS float* ST = (LAS float*)(lds + 49664);
    LAS float* RB = (LAS float*)(lds + 50688);
    LAS int* LCNT = (LAS int*)(lds + 50944);
    LAS int* GBS = (LAS int*)(lds + 51200);
    LAS int* AE = (LAS int*)(lds + 51456);
    LAS int* AR = (LAS int*)(lds + 55552);
    LAS float* AW = (LAS float*)(lds + 59648);
    LAS float* STG = (LAS float*)(lds + 65536);
    const __amdgpu_buffer_rsrc_t rsX = __builtin_amdgcn_make_buffer_rsrc((void*)a.out, 0, T * D * 2, 0x00020000);
    const __amdgpu_buffer_rsrc_t rsXO = __builtin_amdgcn_make_buffer_rsrc(l == DEPTH - 1 ? (void*)(a.ws + B_XL) : (void*)a.out, 0, T * D * 2, 0x00020000);
    const __amdgpu_buffer_rsrc_t rsH = __builtin_amdgcn_make_buffer_rsrc((void*)(a.ws + B_H8), 0, T * D, 0x00020000);
    bf16x8 wh[4][4], wl[4][4];
#pragma unroll
    for (int kq = 0; kq < 4; ++kq)
#pragma unroll
        for (int n = 0; n < 4; ++n) { const size_t o = (size_t)(n * 16 + fr) * D + wid * 128 + kq * 32 + fq * 8;
            wh[kq][n] = *(const GAS bf16x8*)((const GAS bf16_t*)(ws + W_RH) + o); wl[kq][n] = *(const GAS bf16x8*)((const GAS bf16_t*)(ws + W_RL) + o); }
    for (int unit = F.vcu; unit < T / 128; unit += F.G) {
    const int r0 = unit * 128, b = r0 >> 12, slab = r0 / SLAB_T;
    int tq = tid; asm volatile("" : "+v"(tq));
    const GAS float* ada = (const GAS float*)(ws + WS_ADA) + ((size_t)l * 16 + b) * NIN;
    __syncthreads();
    for (int i = tq; i < D; i += 512) { VEC[i] = ((const GAS float*)a.in[19])[(size_t)l * D + i]; VEC[D + i] = ((const GAS float*)a.in[20])[(size_t)l * D + i]; VEC[2 * D + i] = 1.0f + ada[4 * D + i]; VEC[3 * D + i] = ada[3 * D + i]; }
    if (tq < 64) { RB[tq] = ((const GAS float*)a.in[22])[(size_t)l * 64 + tq]; LCNT[tq] = 0; }
    if (tq < 128) { const GAS f32x4* ps = (const GAS f32x4*)((const GAS float*)(ws + WS_PSTAT) + (size_t)(r0 + tq) * 32); float sm = 0.f, q = 0.f;
#pragma unroll
        for (int j = 0; j < 8; ++j) { const f32x4 p4 = ps[j]; sm += p4[0] + p4[2]; q += p4[1] + p4[3]; }
        const float mean = sm * (1.0f / D), var = fmaxf(q * (1.0f / D) - mean * mean, 0.f); ST[2 * tq] = mean; ST[2 * tq + 1] = rsqrtf(var + LN_EPS); }
    __syncthreads();
    {
        const int vo = ((r0 + fr) * D + wid * 128 + fq * 8) * 2, ho = (r0 + fr) * D + wid * 128 + fq * 8;
#define T6_LD(dst, st_) do { const int _s = (st_) < 32 ? (st_) : 31; dst = __builtin_amdgcn_raw_buffer_load_b128(rsX, vo, ((_s >> 2) * 16 * D + (_s & 3) * 32) * 2, 0); } while (0)
#define T6_STEP(st_, xr_) do { const int rt_ = (st_) >> 2, kq_ = (st_) & 3; const int c = wid * 128 + kq_ * 32 + fq * 8; \
        const float mean = ST[2 * (rt_ * 16 + fr)], rstd = ST[2 * (rt_ * 16 + fr) + 1]; \
        const f32x4 g0 = *(const LAS f32x4*)(VEC + c), g1 = *(const LAS f32x4*)(VEC + c + 4), b0 = *(const LAS f32x4*)(VEC + D + c), b1 = *(const LAS f32x4*)(VEC + D + c + 4); \
        const f32x4 s0 = *(const LAS f32x4*)(VEC + 2 * D + c), s1 = *(const LAS f32x4*)(VEC + 2 * D + c + 4), h0 = *(const LAS f32x4*)(VEC + 3 * D + c), h1 = *(const LAS f32x4*)(VEC + 3 * D + c + 4); \
        float xf_[8]; unpack8(xr_, xf_); const f32x4 xq0 = (f32x4){xf_[0], xf_[1], xf_[2], xf_[3]}, xq1 = (f32x4){xf_[4], xf_[5], xf_[6], xf_[7]}; \
        const f32x4 n0 = (xq0 - mean) * rstd * g0 + b0, n1 = (xq1 - mean) * rstd * g1 + b1; \
        { u32x4 xw; xw.x = cvt_pk_bf16(n0[0], n0[1]); xw.y = cvt_pk_bf16(n0[2], n0[3]); xw.z = cvt_pk_bf16(n1[0], n1[1]); xw.w = cvt_pk_bf16(n1[2], n1[3]); __builtin_amdgcn_raw_buffer_store_b128(xw, rsXO, vo, (rt_ * 16 * D + kq_ * 32) * 2, 0); } \
        const f32x4 f0 = n0 * s0 + h0, f1 = n1 * s1 + h1; \
        u32x4 hi; hi.x = cvt_pk_bf16(f0[0], f0[1]); hi.y = cvt_pk_bf16(f0[2], f0[3]); hi.z = cvt_pk_bf16(f1[0], f1[1]); hi.w = cvt_pk_bf16(f1[2], f1[3]); \
        { u32x2 h8; h8.x = pk4_fp8(f0[0] * SC_H, f0[1] * SC_H, f0[2] * SC_H, f0[3] * SC_H); h8.y = pk4_fp8(f1[0] * SC_H, f1[1] * SC_H, f1[2] * SC_H, f1[3] * SC_H); __builtin_amdgcn_raw_buffer_store_b64(h8, rsH, ho, rt_ * 16 * D + kq_ * 32, 0); } \
        u32x4 lo; lo.x = cvt_pk_bf16(f0[0] - bf_lo(hi.x), f0[1] - bf_hi(hi.x)); lo.y = cvt_pk_bf16(f0[2] - bf_lo(hi.y), f0[3] - bf_hi(hi.y)); \
        lo.z = cvt_pk_bf16(f1[0] - bf_lo(hi.z), f1[1] - bf_hi(hi.z)); lo.w = cvt_pk_bf16(f1[2] - bf_lo(hi.w), f1[3] - bf_hi(hi.w)); \
        const bf16x8 ah = __builtin_bit_cast(bf16x8, hi), al = __builtin_bit_cast(bf16x8, lo); \
        _Pragma("unroll") for (int n = 0; n < 4; ++n) { \
            acc[n] = __builtin_amdgcn_mfma_f32_16x16x32_bf16(wh[kq_][n], ah, acc[n], 0, 0, 0); \
            acc[n] = __builtin_amdgcn_mfma_f32_16x16x32_bf16(wl[kq_][n], ah, acc[n], 0, 0, 0); \
            acc[n] = __builtin_amdgcn_mfma_f32_16x16x32_bf16(wh[kq_][n], al, acc[n], 0, 0, 0); } } while (0)
        u32x4 xa, xb, xc, xd;
        for (int rt = 0; rt < 8; ++rt) {
            f32x4 acc[4];
#pragma unroll
            for (int n = 0; n < 4; ++n) acc[n] = (f32x4){0.f, 0.f, 0.f, 0.f};
            T6_LD(xa, rt * 4 + 0); T6_LD(xb, rt * 4 + 1); T6_LD(xc, rt * 4 + 2); T6_LD(xd, rt * 4 + 3);
            T6_STEP(rt * 4 + 0, xa); T6_STEP(rt * 4 + 1, xb); T6_STEP(rt * 4 + 2, xc); T6_STEP(rt * 4 + 3, xd);
            { LAS float* sg = STG + ((rt & 1) * 8 + wid) * (16 * 68) + fr * 68 + 4 * fq;
#pragma unroll
              for (int n = 0; n < 4; ++n) *(LAS f32x4*)(sg + 16 * n) = acc[n]; }
            __syncthreads();
#pragma unroll
            for (int p2 = 0; p2 < 2; ++p2) { const int o = tid + 512 * p2, r = o >> 6, e = o & 63; const LAS float* sp = STG + (rt & 1) * 8 * (16 * 68) + r * 68 + e; float sum = 0.f;
#pragma unroll
                for (int w = 0; w < 8; ++w) sum += sp[w * (16 * 68)];
                LG[(rt * 16 + r) * 65 + e] = sum; }
        }
#undef T6_LD
#undef T6_STEP
    }
    __syncthreads();
    {
        const int ti = lane >> 2, sub = lane & 3, tokl = wid * 16 + ti; const LAS float* lg = LG + tokl * 65 + 16 * sub;
        float bsv[16]; float g0a = -INFINITY, g0b = -INFINITY, g1a = -INFINITY, g1b = -INFINITY;
#pragma unroll
        for (int j = 0; j < 16; ++j) { const float v = fsigmoid(lg[j]) + RB[16 * sub + j]; bsv[j] = v;
            if (j < 8) { if (v > g0a) { g0b = g0a; g0a = v; } else if (v > g0b) g0b = v; } else { if (v > g1a) { g1b = g1a; g1a = v; } else if (v > g1b) g1b = v; } }
        const float gsa = g0a + g0b, gsb = g1a + g1b;
        float gs[8];
        gs[0] = dpp_f<0x00>(gsa); gs[1] = dpp_f<0x00>(gsb); gs[2] = dpp_f<0x55>(gsa); gs[3] = dpp_f<0x55>(gsb);
        gs[4] = dpp_f<0xAA>(gsa); gs[5] = dpp_f<0xAA>(gsb); gs[6] = dpp_f<0xFF>(gsa); gs[7] = dpp_f<0xFF>(gsb);
        unsigned keep = 0u;
#pragma unroll
        for (int it = 0; it < 4; ++it) { float best = -INFINITY; int bi = 0;
#pragma unroll
            for (int g = 0; g < 8; ++g) { const bool ok = !((keep >> g) & 1u) && (gs[g] > best); best = ok ? gs[g] : best; bi = ok ? g : bi; }
            keep |= 1u << bi; }
        unsigned avail = (((keep >> (2 * sub)) & 1u) ? 0x00ffu : 0u) | (((keep >> (2 * sub + 1)) & 1u) ? 0xff00u : 0u);
        float ssum = 0.f;
#pragma unroll 1
        for (int k = 0; k < 8; ++k) { float best = -INFINITY; int bi = 1 << 20;
#pragma unroll
            for (int j = 0; j < 16; ++j) { const bool ok = ((avail >> j) & 1u) && (bsv[j] > best); best = ok ? bsv[j] : best; bi = ok ? (16 * sub + j) : bi; }
            { const float ov = dpp_f<0xB1>(best); const int oi = dpp_i<0xB1>(bi); const bool tk = (ov > best) || (ov == best && oi < bi); best = tk ? ov : best; bi = tk ? oi : bi; }
            { const float ov = dpp_f<0x4E>(best); const int oi = dpp_i<0x4E>(bi); const bool tk = (ov > best) || (ov == best && oi < bi); best = tk ? ov : best; bi = tk ? oi : bi; }
            bi &= 63;
            if ((bi >> 4) == sub) avail &= ~(1u << (bi & 15));
            const float sc = fsigmoid(LG[tokl * 65 + bi]); ssum += sc;
            if (sub == 0) { AE[tokl * 8 + k] = bi; AW[tokl * 8 + k] = sc; } }
        LDS_WAIT(); asm volatile("" ::: "memory");
        const float inv = 2.5f / ssum;
#pragma unroll
        for (int kk2 = 0; kk2 < 2; ++kk2) { const int k = sub + 4 * kk2; const int e = AE[tokl * 8 + k]; AW[tokl * 8 + k] *= inv; AR[tokl * 8 + k] = __hip_atomic_fetch_add(LCNT + e, 1, __ATOMIC_RELAXED, __HIP_MEMORY_SCOPE_WORKGROUP); }
    }
    __syncthreads();
    if (tq < 64) { const int cl = LCNT[tq]; int base = 0;
        if (cl > 0) base = (int)__hip_atomic_fetch_add((GAS unsigned*)(ws + WS_CTL) + CW_CNT + (l * NSLAB + slab) * 64 + tq, (unsigned)cl, __ATOMIC_RELAXED, __HIP_MEMORY_SCOPE_AGENT);
        GBS[tq] = base; }
    __syncthreads();
#pragma unroll
    for (int p = 0; p < 2; ++p) { const int i = tq + 512 * p, tokl = i >> 3; const int e = AE[i], pos = GBS[e] + AR[i]; const int t = r0 + tokl;
        ((GAS unsigned*)(ws + WS_TOKE))[((size_t)slab * 64 + e) * ECAP + pos] = (unsigned)(t - slab * SLAB_T);
        ((GAS float*)(ws + WS_WTE))[((size_t)slab * 64 + e) * ECAP + pos] = AW[i];
        ((GAS unsigned*)(ws + WS_POS))[(size_t)t * 8 + (i & 7)] = ((unsigned)e << 16) | (unsigned)pos; }
    __syncthreads();
    }
}

__device__ __forceinline__ int moe_setup(const Frame& F, int l, int slab) {
    LAS int* TB = (LAS int*)(F.lds + L_TBASE); LAS int* CN = (LAS int*)(F.lds + L_CNT); LAS unsigned short* TM = (LAS unsigned short*)(F.lds + L_TMAP);
    __syncthreads();
    if (F.wave == 0) {
        const int e = F.lane; const int cnt = (int)__hip_atomic_load((GAS unsigned*)(F.ws + WS_CTL) + CW_CNT + (l * NSLAB + slab) * 64 + e, __ATOMIC_RELAXED, __HIP_MEMORY_SCOPE_AGENT);
        const int ntl = (cnt + 255) >> 8; int incl = ntl;
#pragma unroll
        for (int o = 1; o < 64; o <<= 1) { const int v = __shfl_up(incl, o); if (e >= o) incl += v; }
        const int excl = incl - ntl; TB[e] = excl; CN[e] = cnt;
        const int total = __shfl(incl, 63);
        if (e == 0) { TB[64] = total; TB[65] = total + SLAB_T / 256; CN[64] = SLAB_T; }
        for (int i = excl; i < incl; ++i) TM[i] = (unsigned short)e;
        for (int i = e; i < SLAB_T / 256; i += 64) TM[total + i] = (unsigned short)64;
    }
    __syncthreads();
    return TB[65];
}

__device__ __forceinline__ void combine_phase(const Frame& F, const Args& a, int l, int slab) {
    GAS unsigned char* ws = F.ws; const LAS int* TB = (const LAS int*)(F.lds + L_TBASE);
    const GAS unsigned char* Y = (const GAS unsigned char*)(ws + B_Y);
    const GAS bf16_t* XI = (l == DEPTH - 1) ? (const GAS bf16_t*)(ws + B_XL) : (const GAS bf16_t*)a.out;
    GAS unsigned char* H = (GAS unsigned char*)(ws + B_H8);
    constexpr int TPW = SLAB_T / 2048;
    const int gw = F.vcu * NWAVES + F.wave; const int tl0 = gw * TPW; if (tl0 >= SLAB_T) return;
    const int b = (slab * SLAB_T + tl0) >> 12; const int cl = 16 * F.lane;
    const GAS float* ada = (const GAS float*)(ws + WS_ADA) + ((size_t)l * 16 + b) * NIN;
    const GAS float* adan = (const GAS float*)(ws + WS_ADA) + ((size_t)(l < DEPTH - 1 ? l + 1 : l) * 16 + b) * NIN;
    f32x4 g2[4], gm[4], bt[4], sc[4], sh[4];
#pragma unroll
    for (int j = 0; j < 4; ++j) { const int c = cl + 4 * j; g2[j] = *(const GAS f32x4*)(ada + 5 * D + c) * (1.0f / SC_YO); gm[j] = *(const GAS f32x4*)(((const GAS float*)a.in[29]) + (size_t)l * D + c); bt[j] = *(const GAS f32x4*)(((const GAS float*)a.in[30]) + (size_t)l * D + c);
        sc[j] = (*(const GAS f32x4*)(adan + D + c) + 1.0f) * SC_H; sh[j] = *(const GAS f32x4*)(adan + c) * SC_H; }
    const int shbase = TB[64] * 256;
    for (int i = 0; i < TPW; ++i) { const int tl = tl0 + i; const size_t t = (size_t)slab * SLAB_T + tl;
        const GAS unsigned* pp = (const GAS unsigned*)(ws + WS_POS) + t * 8;
        u32x4 yv[9];
#pragma unroll
        for (int k = 0; k < 9; ++k) { size_t rowi;
            if (k < 8) { const unsigned pk = (unsigned)__builtin_amdgcn_readfirstlane((int)pp[k]); rowi = (size_t)TB[pk >> 16] * 256 + (pk & 0xffffu); } else rowi = (size_t)shbase + tl;
            yv[k] = *(const GAS u32x4*)(Y + rowi * D + cl); }
        const u32x4 xr0 = *(const GAS u32x4*)(XI + t * D + cl), xr1 = *(const GAS u32x4*)(XI + t * D + cl + 8);
        f32x4 acc[4];
#pragma unroll
        for (int j = 0; j < 4; ++j) acc[j] = (f32x4){0.f, 0.f, 0.f, 0.f};
#pragma unroll
        for (int k = 0; k < 9; ++k) { const unsigned w[4] = {yv[k].x, yv[k].y, yv[k].z, yv[k].w};
#pragma unroll
            for (int j = 0; j < 4; ++j) { const f32x2 lo = __builtin_amdgcn_cvt_pk_f32_fp8((int)w[j], false), hi = __builtin_amdgcn_cvt_pk_f32_fp8((int)w[j], true); acc[j] += (f32x4){lo.x, lo.y, hi.x, hi.y}; } }
        float xf[16]; { float t8[8]; unpack8(xr0, t8);
#pragma unroll
          for (int j = 0; j < 8; ++j) xf[j] = t8[j];
          unpack8(xr1, t8);
#pragma unroll
          for (int j = 0; j < 8; ++j) xf[8 + j] = t8[j]; }
        f32x4 pre[4]; float s = 0.f;
#pragma unroll
        for (int j = 0; j < 4; ++j) { const f32x4 xv = (f32x4){xf[4 * j], xf[4 * j + 1], xf[4 * j + 2], xf[4 * j + 3]}; pre[j] = xv * ALPHA + g2[j] * acc[j]; s += (pre[j][0] + pre[j][1]) + (pre[j][2] + pre[j][3]); }
        const float mean = wave_sum(s) * (1.0f / D); float q = 0.f;
#pragma unroll
        for (int j = 0; j < 4; ++j) { pre[j] = pre[j] - mean; q += (pre[j][0] * pre[j][0] + pre[j][1] * pre[j][1]) + (pre[j][2] * pre[j][2] + pre[j][3] * pre[j][3]); }
        const float rstd = rsqrtf(wave_sum(q) * (1.0f / D) + LN_EPS);
        f32x4 xn[4];
#pragma unroll
        for (int j = 0; j < 4; ++j) xn[j] = pre[j] * rstd * gm[j] + bt[j];
        if (l == DEPTH - 1) { GAS float* O = (GAS float*)a.out + t * D + cl;
#pragma unroll
            for (int j = 0; j < 4; ++j) *(GAS f32x4*)(O + 4 * j) = xn[j];
        } else { GAS bf16_t* O = (GAS bf16_t*)a.out + t * D + cl;
            u32x4 w0, w1; w0.x = cvt_pk_bf16(xn[0][0], xn[0][1]); w0.y = cvt_pk_bf16(xn[0][2], xn[0][3]); w0.z = cvt_pk_bf16(xn[1][0], xn[1][1]); w0.w = cvt_pk_bf16(xn[1][2], xn[1][3]);
            w1.x = cvt_pk_bf16(xn[2][0], xn[2][1]); w1.y = cvt_pk_bf16(xn[2][2], xn[2][3]); w1.z = cvt_pk_bf16(xn[3][0], xn[3][1]); w1.w = cvt_pk_bf16(xn[3][2], xn[3][3]);
            *(GAS u32x4*)O = w0; *(GAS u32x4*)(O + 8) = w1;
            u32x4 h8;
            { const f32x4 h0 = xn[0] * sc[0] + sh[0], h1 = xn[1] * sc[1] + sh[1], h2 = xn[2] * sc[2] + sh[2], h3 = xn[3] * sc[3] + sh[3];
              h8.x = pk4_fp8(h0[0], h0[1], h0[2], h0[3]); h8.y = pk4_fp8(h1[0], h1[1], h1[2], h1[3]); h8.z = pk4_fp8(h2[0], h2[1], h2[2], h2[3]); h8.w = pk4_fp8(h3[0], h3[1], h3[2], h3[3]); }
            *(GAS u32x4*)(H + t * D + cl) = h8; }
    }
}

template <class Tp> __device__ __forceinline__ Tp* launder(Tp* p) { asm volatile("" : "+s"(p)); return p; }
#define IN(p) (lo <= (p) && (p) < hi)
#ifndef PH_MASK
#define PH_MASK 0xffff
#endif
#define PHM(k) ((PH_MASK >> (k)) & 1)
#define RELAUNDER() do { ws = launder(ws); F.ws = ws; { int _t = F.tid; asm volatile("" : "+v"(_t)); F.tid = _t; F.lane = _t & 63; F.wave = __builtin_amdgcn_readfirstlane(_t >> 6); } asm volatile("" : "+s"(F.vcu), "+s"(F.G), "+s"(bx)); } while (0)
#define SEAM(p) do { if (IN(p) && IN((p) + 1)) xcd_barrier(bar); } while (0)
template <int l> __device__ __forceinline__ void layer_body(Frame& F, const Args& args, const XcdBarrier& bar, GAS unsigned char*& ws, const int lo, const int hi, int& bx) {
        const int pb = 2 + PPL * l;
        if (PHM(2) && IN(pb + 0)) {
            RELAUNDER();
            pg8::ProbPlainT<123> P{(const GAS char*)(ws + B_H8), (const GAS char*)(ws + W_IN), D}; pg8::SchedStatic S{T / 256, NIN / 256, F.G, bx};
            pg8::EpiZ E{(GAS unsigned char*)(ws + B_U)};
            pg8::gemm_phase<11>(F.lds, F.tid, P, S, E);
        }
        SEAM(pb + 0); STAMP(2);
        if (PHM(3) && IN(pb + 1)) {
            RELAUNDER();
            rg_phase(F, args, l);
        }
        SEAM(pb + 1); STAMP(3);
        if (PHM(4) && IN(pb + 2)) {
            RELAUNDER();
            sgu_phase(F, args, l);
            for (int u = F.vcu; u < 512; u += F.G) scanfix_unit(F, u);
        }
        SEAM(pb + 2); STAMP(4);
        if (PHM(5) && IN(pb + 3)) {
            RELAUNDER();
            pg8::ProbPair P{(const GAS char*)(ws + B_YA8), (const GAS char*)(ws + B_YB8), (const GAS char*)(ws + W_A), (const GAS char*)(ws + W_B), D};
            pg8::SchedPair S{T / 256, D / 256, F.G, bx};
            pg8::EpiPair E{(const GAS unsigned char*)(ws + B_GA), (const GAS unsigned char*)(ws + B_GB), (GAS unsigned char*)(ws + B_MG8)};
            pg8::gemm_phase(F.lds, F.tid, P, S, E);
        }
        SEAM(pb + 3); STAMP(5);
        if (PHM(6) && IN(pb + 4)) {
            RELAUNDER();
            pg8::ProbPlainT<122> P{(const GAS char*)(ws + B_MG8), (const GAS char*)(ws + W_O), D}; pg8::SchedStatic S{T / 256, D / 256, F.G, bx};
            if (l == 0) { pg8::EpiOutT<true> E{(const GAS void*)args.in[0], (GAS bf16_t*)args.out, (const GAS float*)(ws + WS_ADA) + (size_t)l * 16 * NIN, (GAS float*)(ws + WS_PSTAT)}; pg8::gemm_phase(F.lds, F.tid, P, S, E); }
            else { pg8::EpiOutT<false> E{(const GAS void*)args.out, (GAS bf16_t*)args.out, (const GAS float*)(ws + WS_ADA) + (size_t)l * 16 * NIN, (GAS float*)(ws + WS_PSTAT)}; pg8::gemm_phase(F.lds, F.tid, P, S, E); }
        }
        SEAM(pb + 4); STAMP(6);
        if (PHM(7) && IN(pb + 5)) { RELAUNDER(); ln1_route_phase(F, args, l); }
        SEAM(pb + 5); STAMP(7);
#pragma unroll
        for (int s = 0; s < NSLAB; ++s) {
            const int ps = pb + 6 + 3 * s;
            int ntiles = 0;
            RELAUNDER();
            if (IN(ps) || IN(ps + 1) || IN(ps + 2)) ntiles = moe_setup(F, l, s);
            GAS unsigned char* hid = (GAS unsigned char*)(ws + B_HID8); GAS unsigned char* yb = (GAS unsigned char*)(ws + B_Y);
            const LAS int* CN = (const LAS int*)(F.lds + L_CNT); const LAS int* TB = (const LAS int*)(F.lds + L_TBASE); const LAS unsigned short* TM = (const LAS unsigned short*)(F.lds + L_TMAP);
            if (PHM(8) && IN(ps)) {
                RELAUNDER();
                pg8::ProbMoe1 P{(const GAS char*)(ws + B_H8) + (size_t)s * SLAB_T * D, (const GAS char*)(ws + W_E13), (const GAS unsigned*)(ws + WS_TOKE) + (size_t)s * 64 * ECAP, CN, D};
                pg8::SchedMoe<2> S{ntiles, F.G, F.vcu, TM, TB};
                pg8::EpiMoe1 E{hid, (const GAS float*)(ws + WS_WTE) + (size_t)s * 64 * ECAP, CN};
                pg8::gemm_phase<13>(F.lds, F.tid, P, S, E);
            }
            SEAM(ps); STAMP(8);
            if (PHM(9) && IN(ps + 1)) {
                RELAUNDER();
                pg8::ProbMoe2 P{(const GAS char*)hid, (const GAS char*)(ws + W_E2), DE};
                pg8::SchedMoe<4> S{ntiles, F.G, F.vcu, TM, TB};
                pg8::EpiMoe2 E{yb};
                pg8::gemm_phase<15>(F.lds, F.tid, P, S, E);
            }
            SEAM(ps + 1); STAMP(9);
            if (PHM(10) && IN(ps + 2)) {
                RELAUNDER();
                combine_phase(F, args, l, s);
                if (s == NSLAB - 1 && l < DEPTH - 1) { __syncthreads(); convert_layer(F, args, l + 1); }
            }
            if (ps + 2 < NPH - 1) SEAM(ps + 2);
            STAMP(10);
        }
}
__global__ void __launch_bounds__(512, 2) mk_fwd(Args args) {
    extern __shared__ __attribute__((aligned(16))) unsigned char lds_raw[];
    Frame F;
    F.lds = (LAS unsigned char*)lds_raw; F.tid = threadIdx.x; F.lane = F.tid & 63; F.wave = __builtin_amdgcn_readfirstlane(F.tid >> 6);
    F.G = gridDim.x; { const int bx = blockIdx.x; F.vcu = (F.G % 8 == 0) ? (bx % 8) * (F.G / 8) + bx / 8 : bx; }
    F.ws = (GAS unsigned char*)args.ws;
    GAS unsigned char* ws = (GAS unsigned char*)args.ws;
    volatile LAS unsigned* MISC = (volatile LAS unsigned*)(F.lds + L_MISC);
    if (F.tid < 32) MISC[F.tid] = 0u;
    __syncthreads();
    XcdBarrier bar = xcd_barrier_post((GAS unsigned*)(ws + WS_CTL) + CW_BAR, MISC + 8);
    const int lo = args.ph_lo, hi = args.ph_hi;
    int bx = (int)blockIdx.x;
    if (PROBE_SET != 0 && blockIdx.x == 0 && threadIdx.x == 0) { volatile LAS unsigned long long* _m = (volatile LAS unsigned long long*)(F.lds + L_MISC + 64); _m[0] = __builtin_amdgcn_s_memrealtime(); _m[1] = 0ull; }

    if (PHM(0) && IN(0)) { RELAUNDER(); ada_phase(F, args); __syncthreads(); convert_layer(F, args, 0); }
    SEAM(0); STAMP(0);
    if (PHM(1) && IN(1)) { RELAUNDER(); modulate0(F, args); }
    SEAM(1); STAMP(1);

    layer_body<0>(F, args, bar, ws, lo, hi, bx); layer_body<1>(F, args, bar, ws, lo, hi, bx); layer_body<2>(F, args, bar, ws, lo, hi, bx); layer_body<3>(F, args, bar, ws, lo, hi, bx);
    if (PROBE_SET != 0 && blockIdx.x == 0 && threadIdx.x == 0) { volatile LAS unsigned long long* _m = (volatile LAS unsigned long long*)(F.lds + L_MISC + 64); const unsigned long long t0 = __builtin_amdgcn_s_memrealtime(), w = _m[1] * PROBE_MUL;
        while (__builtin_amdgcn_s_memrealtime() - t0 < w) __builtin_amdgcn_s_sleep(8); }
#undef IN
#undef SEAM
}

extern "C" void kernel_launch(void* const* d_in, const int* in_sizes, int n_in, void* d_out, int out_size, void* d_ws, size_t ws_size, hipStream_t stream) {
    static int grid = 0;
    if (grid == 0) {
        if (n_in != 31 || out_size != T * D || ws_size < WS_END) { fprintf(stderr, "kernel_launch: unexpected shapes (n_in %d, out %d, ws %zu < %zu)\n", n_in, out_size, ws_size, (size_t)WS_END); grid = -1; return; }
        int dev = 0, cus = 0, per_cu = 0;
        if (hipGetDevice(&dev) != hipSuccess || hipDeviceGetAttribute(&cus, hipDeviceAttributeMultiprocessorCount, dev) != hipSuccess) { grid = -1; return; }
        if (hipFuncSetAttribute((const void*)mk_fwd, hipFuncAttributeMaxDynamicSharedMemorySize, LDS_BYTES) != hipSuccess) { fprintf(stderr, "kernel_launch: hipFuncSetAttribute failed\n"); grid = -1; return; }
        if (hipOccupancyMaxActiveBlocksPerMultiprocessor(&per_cu, (const void*)mk_fwd, 512, LDS_BYTES) != hipSuccess || per_cu < 1) { fprintf(stderr, "kernel_launch: occupancy query says %d\n", per_cu); }
        (void)hipGetLastError();
        if (cus != 256) { fprintf(stderr, "kernel_launch: built for a 256-CU device (got %d CUs); nothing launched\n", cus); grid = -1; return; }
        grid = cus;
    }
    if (grid < 0) return;
    (void)in_sizes;
    hipMemsetAsync((char*)d_ws + WS_CTL, 0, CTL_BYTES, stream);
    Args a{};
    for (int i = 0; i < 31; ++i) a.in[i] = (const float*)d_in[i];
    a.out = (float*)d_out; a.ws = (unsigned char*)d_ws;
#if MK_MULTI
    for (int p = 0; p < NPH; ++p) { a.ph_lo = p; a.ph_hi = p + 1; hipLaunchKernelGGL(mk_fwd, dim3(grid), dim3(512), LDS_BYTES, stream, a); }
#else
    a.ph_lo = 0; a.ph_hi = NPH;
    hipLaunchKernelGGL(mk_fwd, dim3(grid), dim3(512), LDS_BYTES, stream, a);
#endif
}
```
